# Optimizing an MI355X kernel written in HIP

```python
import math, functools
import jax
import jax.numpy as jnp
from jax import lax
import numpy as np

D_MODEL = 2048
BATCH = 4
SEQ = 4096
DEPTH = 2

GRID_W = 64
CTX_LEN = 256
Q_BLOCK = 128
ROPE_BASE = 10000.0
NORM_EPS = 1e-6

R_HEADS = 12
R_HEAD = 64
R_WIDTH = R_HEADS * R_HEAD
R_DECAY_RANK = 64
R_ICLR_RANK = 64
R_VRES_RANK = 32
R_GATE_RANK = 128
R_LN_EPS = 64e-5

G_HEADS = 6
G_KV_HEADS = 2
G_GROUP = G_HEADS // G_KV_HEADS
G_HEAD = 128
G_WIDTH = G_HEADS * G_HEAD
G_KV_WIDTH = G_KV_HEADS * G_HEAD

DF_HEADS = 6
DF_QK_HEAD = 64
DF_V_HEAD = 2 * DF_QK_HEAD
DF_QK_WIDTH = DF_HEADS * 2 * DF_QK_HEAD
DF_WIDTH = DF_HEADS * DF_V_HEAD
DF_SUBLN_EPS = 1e-5

N_BRANCH = 3
D_FF = 5504
CONV_W = 3

R_COLS = 3 * R_WIDTH + R_DECAY_RANK + R_ICLR_RANK + R_GATE_RANK
G_COLS = G_WIDTH + 2 * G_KV_WIDTH
DF_COLS = 2 * DF_QK_WIDTH + DF_WIDTH
GATE_COLS = N_BRANCH * D_MODEL
IN_COLS = R_COLS + G_COLS + DF_COLS + GATE_COLS
IN_SPLITS = (R_COLS, R_COLS + G_COLS, R_COLS + G_COLS + DF_COLS)
R_SPLITS = (R_WIDTH, 2 * R_WIDTH, 3 * R_WIDTH, 3 * R_WIDTH + R_DECAY_RANK,
            3 * R_WIDTH + R_DECAY_RANK + R_ICLR_RANK)

kernel_name = 'hybrid_rwkv7_gqa_diffattn_dit_block'


def rms_norm(x, gain, eps=NORM_EPS):
    xf = x.astype(jnp.float32)
    y = xf * lax.rsqrt(jnp.mean(xf * xf, axis=-1, keepdims=True) + eps)
    return (y * gain.astype(jnp.float32)).astype(x.dtype)


def ada_params(cond, w, bias):
    m = jax.nn.silu(cond) @ w + bias
    return jnp.split(m[..., None, :], 6, axis=-1)


def seg_neighbours(x):
    zero = jnp.zeros_like(x[:, :1])
    prev = jnp.concatenate([zero, x[:, :-1]], axis=1)
    nxt = jnp.concatenate([x[:, 1:], zero], axis=1)
    return prev, nxt


def centred_dwconv(x, w, bias):
    prev, nxt = seg_neighbours(x)
    return prev * w[0] + x * w[1] + nxt * w[2] + bias


def axial_rope_tables(row_idx, col_idx, head_dim):
    quarter = head_dim // 4
    inv = ROPE_BASE ** (-jnp.arange(quarter, dtype=jnp.float32) / quarter)
    ang_r = row_idx.astype(jnp.float32)[:, None] * inv
    ang_c = col_idx.astype(jnp.float32)[:, None] * inv
    return (jnp.cos(ang_r), jnp.sin(ang_r), jnp.cos(ang_c), jnp.sin(ang_c))


def _rotate_half(x, cos, sin):
    x1, x2 = jnp.split(x, 2, axis=-1)
    return jnp.concatenate([x1 * cos - x2 * sin, x1 * sin + x2 * cos], axis=-1)


def apply_axial_rope(x, tables):
    shape = lambda t: t.reshape((t.shape[0],) + (1,) * (x.ndim - 3) + (t.shape[1],)).astype(x.dtype)
    cos_r, sin_r, cos_c, sin_c = (shape(t) for t in tables)
    half = x.shape[-1] // 2
    return jnp.concatenate([_rotate_half(x[..., :half], cos_r, sin_r),
                            _rotate_half(x[..., half:], cos_c, sin_c)], axis=-1)


def sweep_query_blocks(block_fn, q):
    bsz, heads, groups, s, d = q.shape
    nb = s // Q_BLOCK
    qb = q.reshape(bsz, heads, groups, nb, Q_BLOCK, d).transpose(3, 0, 1, 2, 4, 5)
    ob = lax.map(block_fn, qb)
    return ob.transpose(1, 2, 3, 0, 4, 5).reshape(bsz, heads, ob.shape[3], s, ob.shape[-1])


def gqa_attend(q, k, v):
    s = jnp.einsum('bhgqd,bhkd->bhgqk', q, k).astype(jnp.float32) * (q.shape[-1] ** -0.5)
    p = jax.nn.softmax(s, axis=-1).astype(v.dtype)
    return jnp.einsum('bhgqk,bhkd->bhgqd', p, v)


def diff_attend(q, k, v, lam):
    s = jnp.einsum('bhmqd,bhmkd->bhmqk', q, k).astype(jnp.float32) * (q.shape[-1] ** -0.5)
    p = jax.nn.softmax(s, axis=-1)
    w = (p[:, :, 0] - lam * p[:, :, 1]).astype(v.dtype)
    return jnp.einsum('bhqk,bhkv->bhqv', w, v)[:, :, None]


def wkv7_scan(state0, r, w, k, v, a, b):
    def step(state, inp):
        r_t, w_t, k_t, v_t, a_t, b_t = inp
        sa = jnp.einsum('bhij,bhj->bhi', state, a_t)
        state = (state * w_t[:, :, None, :] + sa[..., None] * b_t[:, :, None, :]
                 + v_t[..., None] * k_t[:, :, None, :])
        return state, jnp.einsum('bhij,bhj->bhi', state, r_t)
    xs = tuple(u.astype(jnp.float32).transpose(1, 0, 2, 3) for u in (r, w, k, v, a, b))
    state, y = lax.scan(step, state0, xs)
    return y.transpose(1, 0, 2, 3), state


def rwkv_branch(pr, states, vres, mu, w0, w2, a0, a2, k_k, k_a, r_k, g2, ln_w, ln_b, need_out=True):
    f32 = jnp.float32
    bsz, t, _ = pr.shape
    heads = lambda u: u.reshape(bsz, t, R_HEADS, R_HEAD)
    prev, nxt = seg_neighbours(pr)
    pr = pr + mu * (0.5 * (prev + nxt) - pr)
    r, k, v, w_lo, a_lo, g_lo = jnp.split(pr, list(R_SPLITS), axis=-1)
    if vres is not None:
        v_first, v0, v1, v2 = vres
        v = v + (v_first - v) * jax.nn.sigmoid(v0 + (v @ v1) @ v2)
    kk = heads(k * k_k).astype(f32)
    kk = kk / jnp.maximum(jnp.sqrt(jnp.sum(kk * kk, axis=-1, keepdims=True)), 1e-12)
    rh, vh = heads(r.astype(f32)), heads(v.astype(f32))
    tw = jnp.tanh(w_lo)
    ys, k_dirs, finals = [], [], []
    for d in range(2):
        w_log = -jax.nn.softplus(-(w0[d] + tw @ w2[d]).astype(f32)) - 0.5
        decay = jnp.exp(-jnp.exp(w_log))
        a = jax.nn.sigmoid((a0[d] + a_lo @ a2[d]).astype(f32))
        k_d = heads(k.astype(f32) * (1.0 + (a - 1.0) * k_a.astype(f32)))
        ins = (rh, heads(decay), k_d, vh, -kk, kk * heads(a))
        if d == 1:
            ins = tuple(jnp.flip(u, axis=1) for u in ins)
        y_d, s_d = wkv7_scan(states[d], *ins)
        ys.append(y_d if d == 0 else jnp.flip(y_d, axis=1))
        k_dirs.append(k_d)
        finals.append(s_d)
    final_states = (finals[0], finals[1])
    if not need_out:
        return None, v, final_states
    y = ys[0] + ys[1]
    mean = jnp.mean(y, axis=-1, keepdims=True)
    var = jnp.mean(jnp.square(y - mean), axis=-1, keepdims=True)
    yn = ((y - mean) * lax.rsqrt(var + R_LN_EPS)).reshape(bsz, t, R_WIDTH)
    yn = yn * ln_w.astype(f32) + ln_b.astype(f32)
    bonus = jnp.sum(rh * (k_dirs[0] + k_dirs[1]) * r_k.astype(f32), axis=-1, keepdims=True) * vh
    g = jax.nn.sigmoid(g_lo) @ g2
    y = (yn + bonus.reshape(bsz, t, R_WIDTH)) * g
    return y.astype(pr.dtype), v, final_states


def gqa_heads(pg, q_gain, k_gain):
    bsz, t, _ = pg.shape
    q, k, v = jnp.split(pg, [G_WIDTH, G_WIDTH + G_KV_WIDTH], axis=-1)
    q = rms_norm(q.reshape(bsz, t, G_HEADS, G_HEAD), q_gain)
    k = rms_norm(k.reshape(bsz, t, G_KV_HEADS, G_HEAD), k_gain)
    return q, k, v.reshape(bsz, t, G_KV_HEADS, G_HEAD)


def gqa_q_layout(q):
    bsz, t = q.shape[:2]
    return q.reshape(bsz, t, G_KV_HEADS, G_GROUP, G_HEAD).transpose(0, 2, 3, 1, 4)


def gqa_out_layout(o):
    bsz, t = o.shape[0], o.shape[3]
    return o.transpose(0, 3, 1, 2, 4).reshape(bsz, t, G_WIDTH)


def diff_heads(pd):
    bsz, t, _ = pd.shape
    q, k, v = jnp.split(pd, [DF_QK_WIDTH, 2 * DF_QK_WIDTH], axis=-1)
    q = q.reshape(bsz, t, DF_HEADS, 2, DF_QK_HEAD)
    k = k.reshape(bsz, t, DF_HEADS, 2, DF_QK_HEAD)
    return q, k, v.reshape(bsz, t, DF_HEADS, DF_V_HEAD)


def diff_out(o, gain, lam_init):
    bsz, t = o.shape[0], o.shape[3]
    o = rms_norm(o[:, :, 0], gain, DF_SUBLN_EPS) * (1.0 - lam_init)
    return o.transpose(0, 2, 1, 3).reshape(bsz, t, DF_WIDTH)


def kv_layout(u):
    return jnp.swapaxes(u, 1, 2)


def gated_merge(gate_logits, y_r, y_g, y_d, wb_r, wb_g, wb_d, w_o):
    g_r, g_g, g_d = jnp.split(gate_logits, 3, axis=-1)
    m = (jax.nn.sigmoid(g_r) * (y_r @ wb_r) + jax.nn.sigmoid(g_g) * (y_g @ wb_g)
         + jax.nn.sigmoid(g_d) * (y_d @ wb_d))
    return m @ w_o


def conv_ffn(h, w_up, conv_w, conv_b, w_down):
    u = centred_dwconv(h @ w_up, conv_w, conv_b)
    val, gate = jnp.split(u, 2, axis=-1)
    return (val * jax.nn.silu(gate)) @ w_down


def setup_inputs(seed: int = 0) -> dict:
    key = jax.random.key(seed)
    keys = jax.random.split(key, 48)
    counter = [0]

    def nk():
        counter[0] += 1
        return keys[counter[0] - 1]

    f32 = jnp.float32
    nrm = lambda shape, scale: jax.random.normal(nk(), shape, f32) * scale
    uni = lambda shape: jax.random.uniform(nk(), shape, f32)
    gain = lambda shape: 1.0 + nrm(shape, 0.02)
    L, D = DEPTH, D_MODEL
    return {
        'x': nrm((BATCH, SEQ, D), 1.0),
        'c': nrm((BATCH, D), 1.0),
        'ctx': nrm((BATCH, CTX_LEN, D), 1.0),
        'c_ctx': nrm((D,), 1.0),
        'w_mod': nrm((L, D, 6 * D), 0.5 * D ** -0.5),
        'b_mod': nrm((L, 6 * D), 0.02),
        'norm1': gain((L, D)),
        'w_in': nrm((L, D, IN_COLS), D ** -0.5),
        'rwkv_mu': uni((L, R_COLS)),
        'rwkv_w0': -6.5 + 5.0 * uni((L, 2, R_WIDTH)),
        'rwkv_w2': nrm((L, 2, R_DECAY_RANK, R_WIDTH), 0.5 * R_DECAY_RANK ** -0.5),
        'rwkv_a0': nrm((L, 2, R_WIDTH), 0.1),
        'rwkv_a2': nrm((L, 2, R_ICLR_RANK, R_WIDTH), R_ICLR_RANK ** -0.5),
        'rwkv_k_k': 0.85 + nrm((L, R_WIDTH), 0.05),
        'rwkv_k_a': 1.0 + nrm((L, R_WIDTH), 0.05),
        'rwkv_r_k': nrm((L, R_HEADS, R_HEAD), 0.1),
        'rwkv_g2': nrm((L, R_GATE_RANK, R_WIDTH), R_GATE_RANK ** -0.5),
        'rwkv_ln_w': gain((L, R_WIDTH)),
        'rwkv_ln_b': nrm((L, R_WIDTH), 0.02),
        'rwkv_v0': nrm((L - 1, R_WIDTH), 0.1),
        'rwkv_v1': nrm((L - 1, R_WIDTH, R_VRES_RANK), R_WIDTH ** -0.5),
        'rwkv_v2': nrm((L - 1, R_VRES_RANK, R_WIDTH), R_VRES_RANK ** -0.5),
        'gqa_q_norm': gain((L, G_HEAD)),
        'gqa_k_norm': gain((L, G_HEAD)),
        'diff_lq1': nrm((L, DF_QK_HEAD), 0.1),
        'diff_lk1': nrm((L, DF_QK_HEAD), 0.1),
        'diff_lq2': nrm((L, DF_QK_HEAD), 0.1),
        'diff_lk2': nrm((L, DF_QK_HEAD), 0.1),
        'diff_subln': gain((L, DF_V_HEAD)),
        'w_branch_r': nrm((L, R_WIDTH, D), R_WIDTH ** -0.5),
        'w_branch_g': nrm((L, G_WIDTH, D), G_WIDTH ** -0.5),
        'w_branch_d': nrm((L, DF_WIDTH, D), DF_WIDTH ** -0.5),
        'w_out': nrm((L, D, D), D ** -0.5),
        'norm2': gain((L, D)),
        'ffn_up': nrm((L, D, 2 * D_FF), D ** -0.5),
        'ffn_conv_w': nrm((L, CONV_W, 2 * D_FF), CONV_W ** -0.5),
        'ffn_conv_b': nrm((L, 2 * D_FF), 0.02),
        'ffn_down': nrm((L, D_FF, D), D_FF ** -0.5),
        'final_norm': gain((D,)),
    }


def reference(x, c, ctx, c_ctx, w_mod, b_mod, norm1, w_in, rwkv_mu, rwkv_w0, rwkv_w2, rwkv_a0, rwkv_a2,
              rwkv_k_k, rwkv_k_a, rwkv_r_k, rwkv_g2, rwkv_ln_w, rwkv_ln_b, rwkv_v0, rwkv_v1, rwkv_v2,
              gqa_q_norm, gqa_k_norm, diff_lq1, diff_lk1, diff_lq2, diff_lk2, diff_subln,
              w_branch_r, w_branch_g, w_branch_d, w_out, norm2, ffn_up, ffn_conv_w, ffn_conv_b, ffn_down,
              final_norm):
    bsz, s, _ = x.shape
    rows = s // GRID_W
    row_idx = jnp.repeat(jnp.arange(rows, dtype=jnp.int32), GRID_W)
    col_idx = jnp.tile(jnp.arange(GRID_W, dtype=jnp.int32), rows)
    rope_g = axial_rope_tables(row_idx, col_idx, G_HEAD)
    rope_d = axial_rope_tables(row_idx, col_idx, DF_QK_HEAD)
    zero_state = jnp.zeros((ctx.shape[0], R_HEADS, R_HEAD, R_HEAD), jnp.float32)

    xc = ctx
    v_first, v_first_c = None, None
    for i in range(DEPTH):
        last = i == DEPTH - 1
        sh1, sc1, g1, sh2, sc2, g2 = ada_params(c, w_mod[i], b_mod[i])
        sh1c, sc1c, g1c, sh2c, sc2c, g2c = ada_params(c_ctx[None], w_mod[i], b_mod[i])

        h = rms_norm(x, norm1[i]) * (1.0 + sc1) + sh1
        hc = rms_norm(xc, norm1[i]) * (1.0 + sc1c) + sh1c
        p_r, p_g, p_d, p_gate = jnp.split(h @ w_in[i], list(IN_SPLITS), axis=-1)
        pc_r, pc_g, pc_d, pc_gate = jnp.split(hc @ w_in[i], list(IN_SPLITS), axis=-1)

        rw = (rwkv_mu[i], rwkv_w0[i], rwkv_w2[i], rwkv_a0[i], rwkv_a2[i], rwkv_k_k[i], rwkv_k_a[i],
              rwkv_r_k[i], rwkv_g2[i], rwkv_ln_w[i], rwkv_ln_b[i])
        vres = None if i == 0 else (v_first, rwkv_v0[i - 1], rwkv_v1[i - 1], rwkv_v2[i - 1])
        vres_c = None if i == 0 else (v_first_c, rwkv_v0[i - 1], rwkv_v1[i - 1], rwkv_v2[i - 1])
        y_rc, v_c, ctx_states = rwkv_branch(pc_r, (zero_state, zero_state), vres_c, *rw, need_out=not last)
        y_r, v_l, _ = rwkv_branch(p_r, ctx_states, vres, *rw)
        if i == 0:
            v_first, v_first_c = v_l, v_c

        q, k, v = gqa_heads(p_g, gqa_q_norm[i], gqa_k_norm[i])
        qc, kc, vc = gqa_heads(pc_g, gqa_q_norm[i], gqa_k_norm[i])
        q, k = apply_axial_rope(q, rope_g), apply_axial_rope(k, rope_g)
        k_all = jnp.concatenate([kv_layout(kc), kv_layout(k)], axis=2)
        v_all = jnp.concatenate([kv_layout(vc), kv_layout(v)], axis=2)
        y_g = gqa_out_layout(sweep_query_blocks(functools.partial(gqa_attend, k=k_all, v=v_all),
                                                gqa_q_layout(q)))

        lam_init = 0.8 - 0.6 * math.exp(-0.3 * i)
        lam = (jnp.exp(jnp.sum(diff_lq1[i].astype(jnp.float32) * diff_lk1[i].astype(jnp.float32)))
               - jnp.exp(jnp.sum(diff_lq2[i].astype(jnp.float32) * diff_lk2[i].astype(jnp.float32)))
               + lam_init)
        dq, dk, dv = diff_heads(p_d)
        dqc, dkc, dvc = diff_heads(pc_d)
        dq, dk = apply_axial_rope(dq, rope_d), apply_axial_rope(dk, rope_d)
        dk_all = jnp.concatenate([dkc.transpose(0, 2, 3, 1, 4), dk.transpose(0, 2, 3, 1, 4)], axis=3)
        dv_all = jnp.concatenate([kv_layout(dvc), kv_layout(dv)], axis=2)
        y_d = diff_out(sweep_query_blocks(functools.partial(diff_attend, k=dk_all, v=dv_all, lam=lam),
                                          dq.transpose(0, 2, 3, 1, 4)), diff_subln[i], lam_init)

        x = x + g1 * gated_merge(p_gate, y_r, y_g, y_d, w_branch_r[i], w_branch_g[i], w_branch_d[i], w_out[i])
        h2 = rms_norm(x, norm2[i]) * (1.0 + sc2) + sh2
        x = x + g2 * conv_ffn(h2, ffn_up[i], ffn_conv_w[i], ffn_conv_b[i], ffn_down[i])

        if not last:
            y_gc = gqa_out_layout(gqa_attend(gqa_q_layout(qc), kv_layout(kc), kv_layout(vc)))
            y_dc = diff_out(diff_attend(dqc.transpose(0, 2, 3, 1, 4), dkc.transpose(0, 2, 3, 1, 4),
                                        kv_layout(dvc), lam), diff_subln[i], lam_init)
            xc = xc + g1c * gated_merge(pc_gate, y_rc, y_gc, y_dc, w_branch_r[i], w_branch_g[i],
                                        w_branch_d[i], w_out[i])
            h2c = rms_norm(xc, norm2[i]) * (1.0 + sc2c) + sh2c
            xc = xc + g2c * conv_ffn(h2c, ffn_up[i], ffn_conv_w[i], ffn_conv_b[i], ffn_down[i])

    return rms_norm(x, final_norm)
```

```cpp
#include <hip/hip_runtime.h>
#include <hip/hip_cooperative_groups.h>
#include <cstdio>
#include <cstdint>
namespace cg = cooperative_groups;
#ifndef MK_ONE_LAUNCH
#define MK_ONE_LAUNCH 1
#endif
__device__ __forceinline__ int lthread() { int t = threadIdx.x; asm volatile("" : "+v"(t)); return t; }
namespace pg8 {
#define PG8_LAS __attribute__((address_space(3)))
typedef unsigned short bf16_t;
typedef short bf16x8 __attribute__((ext_vector_type(8)));
typedef float f32x4 __attribute__((ext_vector_type(4)));
typedef unsigned u32x4 __attribute__((ext_vector_type(4)));
constexpr int BM = 256, BK = 64, HALF = 128, HTB = HALF * BK * 2  , STAGE_BYTES = 8 * HTB, NXCD = 8, WGM = 8;

__host__ __device__ __forceinline__ int lds_byte(int r, int c) { const int st = (r >> 4) * 2 + (c >> 5), rr = r & 15, cc = c & 31, ob = rr * 64 + cc * 2; return st * 1024 + (ob ^ (((ob >> 9) & 1) << 5)); }
__host__ __device__ __forceinline__ void stage_rc(int b, int& R, int& C) { const int st = b / 1024, sb = b % 1024, swz = sb ^ (((sb >> 9) & 1) << 5); R = (st >> 1) * 16 + swz / 64; C = (st & 1) * 32 + (swz % 64) / 2; }
__host__ __device__ __forceinline__ int perm32(int rho) { const int n = rho >> 4, i = rho & 15; return 8 * (i >> 2) + 4 * n + (i & 3); }

struct Unit { int pm, pn; };
struct Gemm { const bf16_t* A; const bf16_t* Bt; int M, N, K; };

struct StaticOrder {
    int nM, nN, nwg, G, c;
    __host__ __device__ void init(int M, int N, int G_, int c_) { nM = M / BM; nN = N / BM; nwg = nM * nN; G = G_; c = c_; }
    __host__ __device__ bool next(int i, Unit& u) const {
        const long L = (long)i * G + c; if (L >= nwg) return false;
        int wgid = (int)L; { const int q = nwg / NXCD, r = nwg % NXCD, xcd = wgid % NXCD, off = wgid / NXCD; wgid = (xcd < r ? xcd * (q + 1) : r * (q + 1) + (xcd - r) * q) + off; }
        const int nig = WGM * nN, gid = wgid / nig, fm = gid * WGM, gsz = (nM - fm) < WGM ? (nM - fm) : WGM;
        u.pm = fm + ((wgid % nig) % gsz); u.pn = (wgid % nig) / gsz; return true;
    }
    __device__ __forceinline__ void a_ready(const Unit&) const {}
    __device__ __forceinline__ void done(const Unit&) const {}
};

template <class Epi, class Sched, bool ALIGN_EPI = false, bool SP2 = false>
__device__ __forceinline__ void gemm_phase(PG8_LAS unsigned char* lds, const Gemm g, const Sched& S, const Epi& E) {
    const int tid = lthread(), wid = __builtin_amdgcn_readfirstlane(tid >> 6), lane = tid & 63, wr = wid >> 2, wc = wid & 3, fr = lane & 15, fq = lane >> 4;
    const int K = g.K, nt = K / BK;
    unsigned voffA[2], voffB[2];
#pragma unroll
    for (int i = 0; i < 2; ++i) { int R, C; stage_rc(tid * 16 + i * 8192, R, C); const int Rb = Epi::PERM ? ((R & ~31) + perm32(R & 31)) : R;
        voffA[i] = (unsigned)(R * K + C) * 2u; voffB[i] = (unsigned)(Rb * K + C) * 2u; }
    const size_t kstep = (size_t)(BK * 2);
    const size_t hstep = (size_t)HALF * K * 2;
    const size_t tstep = 2 * hstep;
    const unsigned ldsw = (unsigned)wid * 1024u;
    const int aoff = lds_byte(wr * 64 + fr, fq * 8), boff = lds_byte(wc * 32 + fr, fq * 8);
#define PG8_SA(b, h) (((b) * 2 + (h)) * HTB)
#define PG8_SB(b, h) ((4 + (b) * 2 + (h)) * HTB)
#define PG8_STAGE(bufoff, gbase, voff) do { _Pragma("unroll") for (int _i = 0; _i < 2; ++_i) \
        __builtin_amdgcn_global_load_lds((const unsigned*)((const char*)(gbase) + (voff)[_i]), (PG8_LAS unsigned*)(lds + (bufoff) + ldsw + _i * 8192), 16, 0, 0); } while (0)
#define PG8_LDA(dst, b, h) do { _Pragma("unroll") for (int m = 0; m < 4; ++m) _Pragma("unroll") for (int k = 0; k < 2; ++k) dst[m][k] = *(const PG8_LAS bf16x8*)(lds + PG8_SA(b, h) + aoff + m * 2048 + k * 1024); } while (0)
#define PG8_LDB(dst, b, h) do { _Pragma("unroll") for (int n = 0; n < 2; ++n) _Pragma("unroll") for (int k = 0; k < 2; ++k) dst[n][k] = *(const PG8_LAS bf16x8*)(lds + PG8_SB(b, h) + boff + n * 2048 + k * 1024); } while (0)
#define PG8_MMA(ai, bj, At, Bt) do { __builtin_amdgcn_s_setprio(1); _Pragma("unroll") for (int m = 0; m < 4; ++m) _Pragma("unroll") for (int n = 0; n < 2; ++n) _Pragma("unroll") for (int k = 0; k < 2; ++k) \
        acc[ai][bj][m][n] = __builtin_amdgcn_mfma_f32_16x16x32_bf16(Bt[n][k], At[m][k], acc[ai][bj][m][n], 0, 0, 0); __builtin_amdgcn_s_setprio(0); } while (0)
#define PG8_WAIT_V(n) asm volatile("s_waitcnt vmcnt(" #n ")" ::: "memory")
#define PG8_WAIT_L(n) asm volatile("s_waitcnt lgkmcnt(" #n ")" ::: "memory")
#define PG8_BAR __builtin_amdgcn_s_barrier()
#define PG8_SCHED __builtin_amdgcn_sched_barrier(0)
    Unit cur, nxt; int ui = 0;
    if (!S.next(0, cur)) return;
    f32x4 acc[2][2][4][2];
#pragma unroll
    for (int a = 0; a < 2; ++a)
#pragma unroll
        for (int b = 0; b < 2; ++b)
#pragma unroll
            for (int m = 0; m < 4; ++m)
#pragma unroll
                for (int n = 0; n < 2; ++n) acc[a][b][m][n] = (f32x4){0.f, 0.f, 0.f, 0.f};
    bf16x8 At[4][2], B0[2][2], B1[2][2];
    const char* cA = (const char*)g.A + (size_t)cur.pm * tstep; const char* cB = (const char*)g.Bt + (size_t)cur.pn * tstep;
    S.a_ready(cur);
    if constexpr (SP2) {
        PG8_STAGE(PG8_SB(0, 0), cB, voffB); PG8_STAGE(PG8_SB(0, 1), cB + hstep, voffB); PG8_STAGE(PG8_SA(0, 0), cA, voffA); PG8_STAGE(PG8_SA(0, 1), cA + hstep, voffA);
        if (wr == 1) PG8_BAR;
        PG8_WAIT_V(2); PG8_BAR;
        PG8_STAGE(PG8_SB(1, 0), cB + kstep, voffB); PG8_STAGE(PG8_SA(1, 0), cA + kstep, voffA); PG8_STAGE(PG8_SB(1, 1), cB + hstep + kstep, voffB);
        PG8_WAIT_V(6); PG8_BAR;
    } else {
        PG8_STAGE(PG8_SB(0, 0), cB, voffB); PG8_STAGE(PG8_SA(0, 0), cA, voffA); PG8_STAGE(PG8_SB(0, 1), cB + hstep, voffB); PG8_STAGE(PG8_SA(0, 1), cA + hstep, voffA);
        if (wr == 1) PG8_BAR;
        PG8_WAIT_V(4); PG8_BAR;
        PG8_STAGE(PG8_SB(1, 0), cB + kstep, voffB); PG8_STAGE(PG8_SA(1, 0), cA + kstep, voffA); PG8_STAGE(PG8_SB(1, 1), cB + hstep + kstep, voffB);
        PG8_WAIT_V(6); PG8_BAR;
    }
    for (;;) {
        const bool has_next = S.next(ui + 1, nxt);
        const char* nA = has_next ? (const char*)g.A + (size_t)nxt.pm * tstep : cA; const char* nB = has_next ? (const char*)g.Bt + (size_t)nxt.pn * tstep : cB;
        for (int t = 0; t < nt; t += 2) {
            const bool last = (t == nt - 2);
            const char* a1 = cA + (size_t)(t + 1) * kstep;
            const char* a2 = last ? nA : cA + (size_t)(t + 2) * kstep; const char* b2 = last ? nB : cB + (size_t)(t + 2) * kstep;
            const char* a3 = a2 + kstep; const char* b3 = b2 + kstep;
            if (last && has_next) S.a_ready(nxt);
            if constexpr (SP2) {
            PG8_LDB(B0, 0, 0); PG8_LDB(B1, 0, 1); PG8_SCHED; PG8_LDA(At, 0, 0); PG8_STAGE(PG8_SA(1, 1), a1 + hstep, voffA);
            PG8_WAIT_V(8); PG8_WAIT_L(0); PG8_BAR; PG8_MMA(0, 0, At, B0); PG8_MMA(0, 1, At, B1); PG8_BAR; PG8_SCHED;
            PG8_LDA(At, 0, 1); PG8_STAGE(PG8_SB(0, 0), b2, voffB); PG8_STAGE(PG8_SB(0, 1), b2 + hstep, voffB); PG8_STAGE(PG8_SA(0, 0), a2, voffA);
            PG8_WAIT_V(8); PG8_WAIT_L(0); PG8_BAR; PG8_MMA(1, 0, At, B0); PG8_MMA(1, 1, At, B1); PG8_BAR; PG8_SCHED;
            PG8_LDB(B0, 1, 0); PG8_LDB(B1, 1, 1); PG8_SCHED; PG8_LDA(At, 1, 0); PG8_STAGE(PG8_SA(0, 1), a2 + hstep, voffA);
            PG8_WAIT_V(8); PG8_WAIT_L(0); PG8_BAR; PG8_MMA(0, 0, At, B0); PG8_MMA(0, 1, At, B1); PG8_BAR; PG8_SCHED;
            PG8_LDA(At, 1, 1); PG8_STAGE(PG8_SB(1, 0), b3, voffB); PG8_STAGE(PG8_SB(1, 1), b3 + hstep, voffB); PG8_STAGE(PG8_SA(1, 0), a3, voffA);
            PG8_WAIT_V(8); PG8_WAIT_L(0); PG8_BAR; PG8_MMA(1, 0, At, B0); PG8_MMA(1, 1, At, B1); PG8_BAR; PG8_SCHED;
            } else {
            PG8_LDB(B0, 0, 0); PG8_SCHED; PG8_LDA(At, 0, 0); PG8_STAGE(PG8_SA(1, 1), a1 + hstep, voffA);
            PG8_WAIT_L(8); PG8_BAR; PG8_WAIT_L(0); PG8_MMA(0, 0, At, B0); PG8_BAR; PG8_SCHED;
            PG8_LDB(B1, 0, 1); PG8_STAGE(PG8_SB(0, 0), b2, voffB);
            PG8_BAR; PG8_WAIT_L(0); PG8_MMA(0, 1, At, B1); PG8_BAR;
            PG8_LDA(At, 0, 1); PG8_STAGE(PG8_SA(0, 0), a2, voffA);
            PG8_BAR; PG8_WAIT_L(0); PG8_MMA(1, 0, At, B0); PG8_BAR; PG8_SCHED;
            PG8_STAGE(PG8_SB(0, 1), b2 + hstep, voffB);
            PG8_WAIT_V(6); PG8_BAR; PG8_MMA(1, 1, At, B1); PG8_BAR;
            PG8_LDB(B0, 1, 0); PG8_SCHED; PG8_LDA(At, 1, 0); PG8_STAGE(PG8_SA(0, 1), a2 + hstep, voffA);
            PG8_WAIT_L(8); PG8_BAR; PG8_WAIT_L(0); PG8_MMA(0, 0, At, B0); PG8_BAR; PG8_SCHED;
            PG8_LDB(B1, 1, 1); PG8_STAGE(PG8_SB(1, 0), b3, voffB);
            PG8_BAR; PG8_WAIT_L(0); PG8_MMA(0, 1, At, B1); PG8_BAR;
            PG8_LDA(At, 1, 1); PG8_STAGE(PG8_SA(1, 0), a3, voffA);
            PG8_BAR; PG8_WAIT_L(0); PG8_MMA(1, 0, At, B0); PG8_BAR; PG8_SCHED;
            PG8_STAGE(PG8_SB(1, 1), b3 + hstep, voffB);
            PG8_WAIT_V(6); PG8_BAR; PG8_MMA(1, 1, At, B1); PG8_BAR;
            }
        }
        if constexpr (ALIGN_EPI) { if (wr == 0) PG8_BAR; }
        if constexpr (!Epi::AFTER_DRAIN) { E(acc, cur, wr, wc, fr, fq); S.done(cur); }
        if (!has_next) break;
#pragma unroll
        for (int a = 0; a < 2; ++a)
#pragma unroll
            for (int b = 0; b < 2; ++b)
#pragma unroll
                for (int m = 0; m < 4; ++m)
#pragma unroll
                    for (int n = 0; n < 2; ++n) acc[a][b][m][n] = (f32x4){0.f, 0.f, 0.f, 0.f};
        cur = nxt; cA = nA; cB = nB; ++ui;
        if constexpr (ALIGN_EPI) { if (wr == 1) PG8_BAR; }
    }
    PG8_WAIT_V(0);
    if constexpr (!ALIGN_EPI) { if (wr == 0) PG8_BAR; }
    PG8_BAR;
    if constexpr (Epi::AFTER_DRAIN) { E.fused(acc, cur, wr, wc, fr, fq, lds, wid, lane); S.done(cur); }
#undef PG8_SA
#undef PG8_SB
#undef PG8_STAGE
#undef PG8_LDA
#undef PG8_LDB
#undef PG8_MMA
#undef PG8_WAIT_V
#undef PG8_WAIT_L
#undef PG8_BAR
#undef PG8_SCHED
}
}

#define LAS __attribute__((address_space(3)))
typedef unsigned short bf16_t;
typedef float f32x4 __attribute__((ext_vector_type(4)));
typedef float f32x2 __attribute__((ext_vector_type(2)));
typedef unsigned u32x4 __attribute__((ext_vector_type(4)));
typedef unsigned u32x2 __attribute__((ext_vector_type(2)));
typedef short bf16x8 __attribute__((ext_vector_type(8)));

constexpr int DM = 2048, NB = 4, SEQ = 4096, CTX = 256, TL = NB * SEQ, TC = NB * CTX, TT = TL + TC, KVS = CTX + SEQ;
constexpr int RW = 768, RCOLS = 2560, FF = 5504, FF2 = 11008, MODW = 12288;
constexpr int NTHREADS = 512, NWAVES = 8;

enum { I_X = 0, I_C, I_CTX, I_CCTX, I_WMOD, I_BMOD, I_NORM1, I_WIN, I_MU, I_W0, I_W2, I_A0, I_A2, I_KK, I_KA, I_RK, I_G2, I_LNW, I_LNB,
       I_V0, I_V1, I_V2, I_QN, I_KN, I_LQ1, I_LK1, I_LQ2, I_LK2, I_SUBLN, I_WBR, I_WBG, I_WBD, I_WOUT, I_NORM2, I_UP, I_CW, I_CB, I_DOWN, I_FN, N_IN };

#define XB_TMO      128
#define XB_XCNT(j)  (256  + 64 * (j))
#define XB_XSUB(j)  (1280 + 64 * (j))
#define XB_XGEN(j)  (2304 + 64 * (j))
#define XB_TOP      3328
#define XB_TOPGEN   3392
#define XCD_BAR_WORDS 3456
#define XB_SPIN_CAP (1u << 18)

__device__ __forceinline__ unsigned xb_ld(unsigned* p)              { return __hip_atomic_load(p, __ATOMIC_RELAXED, __HIP_MEMORY_SCOPE_AGENT); }
__device__ __forceinline__ unsigned xb_add(unsigned* p, unsigned v) { return __hip_atomic_fetch_add(p, v, __ATOMIC_RELAXED, __HIP_MEMORY_SCOPE_AGENT); }
__device__ __forceinline__ unsigned xb_xcc_id() { return (unsigned)__builtin_amdgcn_s_getreg((3 << 11) | 20) & 0xFu; }
#define XB_SPIN(cond, bar) do { unsigned _sp = 0; while (cond) { __builtin_amdgcn_s_sleep(1); \
    if ((++_sp & 255u) == 0u) { if (xb_ld(&(bar)[XB_TMO])) break; if (_sp > XB_SPIN_CAP) { atomicAdd(&(bar)[XB_TMO], 1u); break; } } } } while (0)

struct XcdBarrier {
    unsigned* bar; unsigned x;
    volatile LAS unsigned* st;
};

__device__ __forceinline__ XcdBarrier xcd_barrier_post(unsigned* bar, volatile LAS unsigned* st) {
    XcdBarrier b; b.bar = bar; b.x = xb_xcc_id(); b.st = st;
    if (threadIdx.x == 0) (void)xb_add(&bar[XB_XCNT(b.x)], 1u);
    return b;
}
__device__ __forceinline__ void xcd_barrier_complete(unsigned* bar, unsigned x, unsigned& nloc, unsigned& nx) {
    const unsigned G = gridDim.x * gridDim.y * gridDim.z;
    unsigned sum, cnt, mine, sp = 0u;
    for (;;) {
        sum = 0u; cnt = 0u; mine = 0u;
#pragma unroll
        for (unsigned j = 0; j < 16; ++j) { const unsigned c = xb_ld(&bar[XB_XCNT(j)]); sum += c; cnt += (c > 0u) ? 1u : 0u; mine = (j == x) ? c : mine; }
        if (sum == G) break;
        __builtin_amdgcn_s_sleep(1);
        if ((++sp & 255u) == 0u) { if (xb_ld(&bar[XB_TMO])) break; if (sp > XB_SPIN_CAP) { atomicAdd(&bar[XB_TMO], 1u); break; } }
    }
    nloc = mine > 0u ? mine : 1u; nx = cnt > 0u ? cnt : 1u;
}

__device__ __forceinline__ void xcd_barrier(const XcdBarrier& b) {
    asm volatile("s_waitcnt vmcnt(0)" ::: "memory");
    __syncthreads();
    if (threadIdx.x == 0) {
        unsigned* bar = b.bar;
        __builtin_amdgcn_s_waitcnt(0);
        unsigned nloc = b.st[0], nx = b.st[1];
        if (nloc == 0u) { xcd_barrier_complete(bar, b.x, nloc, nx); b.st[0] = nloc; b.st[1] = nx; }
        const unsigned old = xb_add(&bar[XB_XSUB(b.x)], 1u);
        const unsigned gen = old / nloc;
        if (old + 1u == (gen + 1u) * nloc) {
            __builtin_amdgcn_fence(__ATOMIC_RELEASE, "agent");
            asm volatile("s_waitcnt vmcnt(0)" ::: "memory");
            const unsigned og = xb_add(&bar[XB_TOP], 1u);
            const unsigned tg = og / nx;
            if (og + 1u == (tg + 1u) * nx) xb_add(&bar[XB_TOPGEN], 1u);
            else XB_SPIN(xb_ld(&bar[XB_TOPGEN]) == tg, bar);
            __builtin_amdgcn_fence(__ATOMIC_ACQUIRE, "agent");
            xb_add(&bar[XB_XGEN(b.x)], 1u);
            asm volatile("s_waitcnt vmcnt(0)" ::: "memory");
        } else {
            XB_SPIN(xb_ld(&bar[XB_XGEN(b.x)]) == gen, bar);
            __builtin_amdgcn_fence(__ATOMIC_ACQUIRE, "agent");
            asm volatile("s_waitcnt vmcnt(0)" ::: "memory");
        }
    }
    __syncthreads();
}

constexpr size_t MiB = 1u << 20, HMiB = 1u << 19;
constexpr size_t O_CTL = 0, CTL_BYTES = 65536, O_MOD = 1 * MiB, O_XC = 2 * MiB;
constexpr size_t W_IN = 10 * MiB, W_BR = W_IN + 48 * MiB, W_OUT = W_BR + 9 * MiB, W_UP = W_OUT + 8 * MiB, W_DOWN = W_UP + 43 * MiB,
                 W_LR = W_DOWN + 22 * MiB, W_V12 = W_LR + (size_t)3840 * 256 * 2;
constexpr size_t O_H = 143 * MiB, O_VF = 211 * MiB, O_AR = 237 * MiB;
static_assert(W_V12 + (size_t)768 * 768 * 2 == O_H, "weight map");
constexpr size_t A_QG = O_AR, A_KG = O_AR + 51 * HMiB, A_VG = O_AR + 68 * HMiB, A_DQ = O_AR + 85 * HMiB, A_DK = O_AR + 136 * HMiB, A_DV = O_AR + 187 * HMiB;
constexpr size_t A_PR = O_AR + 238 * HMiB, A_EW = A_PR, A_AS = O_AR + 340 * HMiB, A_G = O_AR + 442 * HMiB;
constexpr size_t A_R = O_AR + 493 * HMiB, A_K = O_AR + 544 * HMiB, A_V = O_AR + 595 * HMiB, A_KKN = O_AR + 646 * HMiB;
constexpr size_t A_LR = O_AR + 697 * HMiB, A_T1 = O_AR + 714 * HMiB;
constexpr size_t A_YS = O_AR + 731 * HMiB, A_OD = O_AR + 935 * HMiB, A_YG = O_AR + 1139 * HMiB, A_END1 = O_AR + 1190 * HMiB;
constexpr size_t A_YR = O_AR, A_YD = O_AR + 51 * HMiB, A_GATES = A_PR;
constexpr size_t A_U = O_AR, A_ACT = O_AR + 731 * HMiB;
constexpr size_t WS_NEED = A_END1;
static_assert((size_t)TT * 768 * 2 == 51 * HMiB && (size_t)TT * 2048 * 2 == 68 * MiB && (size_t)TT * FF2 * 2 == 731 * HMiB, "sizes");
static_assert(A_ACT + (size_t)TT * FF * 2 <= A_END1 && A_GATES + (size_t)TT * 6144 * 2 <= A_KKN, "overlays");

__device__ __forceinline__ float bf2f(unsigned v) { return __uint_as_float(v << 16); }
__device__ __forceinline__ unsigned cvt_pk_bf16(float lo, float hi) { unsigned r; asm volatile("v_cvt_pk_bf16_f32 %0, %1, %2" : "=v"(r) : "v"(lo), "v"(hi)); return r; }
__device__ __forceinline__ unsigned f2bf(float f) { return cvt_pk_bf16(f, 0.f) & 0xffffu; }
__device__ __forceinline__ float wave_sum(float v) {
    v += __int_as_float(__builtin_amdgcn_update_dpp(0, __float_as_int(v), 0xB1, 0xF, 0xF, true));
    v += __int_as_float(__builtin_amdgcn_update_dpp(0, __float_as_int(v), 0x4E, 0xF, 0xF, true));
    v += __int_as_float(__builtin_amdgcn_update_dpp(0, __float_as_int(v), 0x141, 0xF, 0xF, true));
    v += __int_as_float(__builtin_amdgcn_update_dpp(0, __float_as_int(v), 0x140, 0xF, 0xF, true));
    { auto r16 = __builtin_amdgcn_permlane16_swap(__float_as_uint(v), __float_as_uint(v), false, false); v = __uint_as_float(r16[0]) + __uint_as_float(r16[1]); }
    { auto r32 = __builtin_amdgcn_permlane32_swap(__float_as_uint(v), __float_as_uint(v), false, false); v = __uint_as_float(r32[0]) + __uint_as_float(r32[1]); }
    return v;
}
__device__ __forceinline__ float sigmoidf_(float x) { return 1.f / (1.f + __expf(-x)); }
__device__ __forceinline__ void unpack8(u32x4 w, float* f) {
    f[0] = bf2f(w.x & 0xffffu); f[1] = __uint_as_float(w.x & 0xffff0000u); f[2] = bf2f(w.y & 0xffffu); f[3] = __uint_as_float(w.y & 0xffff0000u);
    f[4] = bf2f(w.z & 0xffffu); f[5] = __uint_as_float(w.z & 0xffff0000u); f[6] = bf2f(w.w & 0xffffu); f[7] = __uint_as_float(w.w & 0xffff0000u);
}
__device__ __forceinline__ u32x4 pack8(const float* f) { u32x4 w; w.x = cvt_pk_bf16(f[0], f[1]); w.y = cvt_pk_bf16(f[2], f[3]); w.z = cvt_pk_bf16(f[4], f[5]); w.w = cvt_pk_bf16(f[6], f[7]); return w; }

enum { EM_ROUTE = 0, EM_BF16, EM_SIGMOID, EM_LR, EM_VRES, EM_MERGE, EM_RESID };
struct Epi {
    static constexpr bool PERM = true, AFTER_DRAIN = false;
    int mode, ldc, aux, layer;
    unsigned char* ws; bf16_t* O; const float* p0; const float* p1;
    const float* xin_l; const float* xin_c; float* xout_l; float* xout_c; const float* gmod;
    __device__ __forceinline__ void operator()(const f32x4 (&acc)[2][2][4][2], const pg8::Unit& u, int wr, int wc, int fr, int fq) const {
        int fr_ = fr, fq_ = fq; asm volatile("" : "+v"(fr_), "+v"(fq_));
        size_t zoff_ = 0; asm volatile("" : "+s"(zoff_)); unsigned char* ws = this->ws + zoff_;
        const int rt = wr * 64 + fr_, ct = wc * 32 + 8 * fq_;
        if (mode == EM_ROUTE) {
            const int pn = u.pn, pm = u.pm;
            const int kvrow = pm < 64 ? ((pm >> 4) * KVS + CTX + (pm & 15) * 256) : ((pm - 64) * KVS);
            const int nat = pm * 256;
            size_t off; int ld, rowbase, colb;
            if (pn < 10) { off = A_PR; ld = 2560; rowbase = nat; colb = pn * 256; }
            else if (pn < 13) { off = A_QG; ld = 768; rowbase = nat; colb = (pn - 10) * 256; }
            else if (pn == 13) { off = A_KG; ld = 256; rowbase = kvrow; colb = 0; }
            else if (pn == 14) { off = A_VG; ld = 256; rowbase = kvrow; colb = 0; }
            else if (pn < 18) { off = A_DQ; ld = 768; rowbase = nat; colb = (pn - 15) * 256; }
            else if (pn < 21) { off = A_DK; ld = 768; rowbase = kvrow; colb = (pn - 18) * 256; }
            else { off = A_DV; ld = 768; rowbase = kvrow; colb = (pn - 21) * 256; }
            bf16_t* base = (bf16_t*)(ws + off) + (size_t)(rowbase + rt) * ld + colb + ct;
#pragma unroll
            for (int ai = 0; ai < 2; ++ai)
#pragma unroll
                for (int m = 0; m < 4; ++m) { bf16_t* rp = base + (size_t)(ai * 128 + m * 16) * ld;
#pragma unroll
                    for (int bj = 0; bj < 2; ++bj) { const f32x4 v0 = acc[ai][bj][m][0], v1 = acc[ai][bj][m][1]; u32x4 w;
                        w.x = cvt_pk_bf16(v0[0], v0[1]); w.y = cvt_pk_bf16(v0[2], v0[3]); w.z = cvt_pk_bf16(v1[0], v1[1]); w.w = cvt_pk_bf16(v1[2], v1[3]);
                        *(u32x4*)(rp + bj * 128) = w; } }
        } else if (mode == EM_BF16 || mode == EM_SIGMOID) {
            bf16_t* base = O + (size_t)(u.pm * 256 + rt) * ldc + u.pn * 256 + ct;
            const bool sg = mode == EM_SIGMOID;
#pragma unroll
            for (int ai = 0; ai < 2; ++ai)
#pragma unroll
                for (int m = 0; m < 4; ++m) { bf16_t* rp = base + (size_t)(ai * 128 + m * 16) * ldc;
#pragma unroll
                    for (int bj = 0; bj < 2; ++bj) { f32x4 v0 = acc[ai][bj][m][0], v1 = acc[ai][bj][m][1];
                        if (sg) {
#pragma unroll
                            for (int e = 0; e < 4; ++e) { v0[e] = sigmoidf_(v0[e]); v1[e] = sigmoidf_(v1[e]); } }
                        u32x4 w; w.x = cvt_pk_bf16(v0[0], v0[1]); w.y = cvt_pk_bf16(v0[2], v0[3]); w.z = cvt_pk_bf16(v1[0], v1[1]); w.w = cvt_pk_bf16(v1[2], v1[3]);
                        *(u32x4*)(rp + bj * 128) = w; } }
        } else if (mode == EM_LR) {
            const int seg = u.pn / 3, c768 = (u.pn % 3) * 256 + ct;
            const float* par = seg < 2 ? (p0 + seg * 768) : (seg < 4 ? (p1 + (seg - 2) * 768) : nullptr);
            bf16_t* base = (bf16_t*)(ws + (seg < 2 ? A_EW + (size_t)seg * TT * 768 * 2 : (seg < 4 ? A_AS + (size_t)(seg - 2) * TT * 768 * 2 : A_G))) + (size_t)(u.pm * 256 + rt) * 768 + c768;
            const float mul = seg < 2 ? 0.60653065971263342f : 1.f;
#pragma unroll
            for (int bj = 0; bj < 2; ++bj) {
                f32x4 pa = {0.f, 0.f, 0.f, 0.f}, pb = pa;
                if (par) { pa = *(const f32x4*)(par + c768 + bj * 128); pb = *(const f32x4*)(par + c768 + bj * 128 + 4); }
#pragma unroll
                for (int ai = 0; ai < 2; ++ai)
#pragma unroll
                    for (int m = 0; m < 4; ++m) { f32x4 v0 = acc[ai][bj][m][0] + pa, v1 = acc[ai][bj][m][1] + pb;
                        if (par) {
#pragma unroll
                            for (int e = 0; e < 4; ++e) { v0[e] = mul * sigmoidf_(v0[e]); v1[e] = mul * sigmoidf_(v1[e]); } }
                        u32x4 w; w.x = cvt_pk_bf16(v0[0], v0[1]); w.y = cvt_pk_bf16(v0[2], v0[3]); w.z = cvt_pk_bf16(v1[0], v1[1]); w.w = cvt_pk_bf16(v1[2], v1[3]);
                        *(u32x4*)(base + (size_t)(ai * 128 + m * 16) * 768 + bj * 128) = w; } }
        } else if (mode == EM_VRES) {
            const int c0 = u.pn * 256 + ct;
            bf16_t* V = (bf16_t*)(ws + A_V); const bf16_t* VS = (const bf16_t*)(ws + A_YS); const bf16_t* VF = (const bf16_t*)(ws + O_VF);
#pragma unroll
            for (int bj = 0; bj < 2; ++bj) {
                const f32x4 pa = *(const f32x4*)(p0 + c0 + bj * 128), pb = *(const f32x4*)(p0 + c0 + bj * 128 + 4);
#pragma unroll
                for (int ai = 0; ai < 2; ++ai)
#pragma unroll
                    for (int m = 0; m < 4; ++m) { const size_t o = (size_t)(u.pm * 256 + rt + ai * 128 + m * 16) * 768 + c0 + bj * 128;
                        float vs[8], vf[8], r[8]; unpack8(*(const u32x4*)(VS + o), vs); unpack8(*(const u32x4*)(VF + o), vf);
                        const f32x4 v0 = acc[ai][bj][m][0] + pa, v1 = acc[ai][bj][m][1] + pb;
#pragma unroll
                        for (int e = 0; e < 4; ++e) { r[e] = vs[e] + (vf[e] - vs[e]) * sigmoidf_(v0[e]); r[4 + e] = vs[4 + e] + (vf[4 + e] - vs[4 + e]) * sigmoidf_(v1[e]); }
                        *(u32x4*)(V + o) = pack8(r); } }
        } else if (mode == EM_MERGE) {
            const bf16_t* GT = (const bf16_t*)(ws + A_GATES); bf16_t* Mb = (bf16_t*)(ws + O_H);
            const int c0 = u.pn * 256 + ct;
#pragma unroll
            for (int ai = 0; ai < 2; ++ai) {
                u32x4 gv[4][2], mv[4][2];
#pragma unroll
                for (int m = 0; m < 4; ++m)
#pragma unroll
                    for (int bj = 0; bj < 2; ++bj) { const size_t row = (size_t)(u.pm * 256 + rt + ai * 128 + m * 16); const int c = c0 + bj * 128;
                        gv[m][bj] = *(const u32x4*)(GT + row * 6144 + aux * 2048 + c);
                        if (aux > 0) mv[m][bj] = *(const u32x4*)(Mb + row * 2048 + c); else mv[m][bj] = (u32x4){0u, 0u, 0u, 0u}; }
                asm volatile("" ::: "memory");
#pragma unroll
                for (int m = 0; m < 4; ++m)
#pragma unroll
                    for (int bj = 0; bj < 2; ++bj) { const size_t row = (size_t)(u.pm * 256 + rt + ai * 128 + m * 16); const int c = c0 + bj * 128;
                        float g[8], o[8], r[8]; unpack8(gv[m][bj], g); unpack8(mv[m][bj], o);
                        const f32x4 v0 = acc[ai][bj][m][0], v1 = acc[ai][bj][m][1];
#pragma unroll
                        for (int e2 = 0; e2 < 4; ++e2) { r[e2] = g[e2] * v0[e2] + o[e2]; r[4 + e2] = g[4 + e2] * v1[e2] + o[4 + e2]; }
                        *(u32x4*)(Mb + row * 2048 + c) = pack8(r); }
                asm volatile("" ::: "memory");
            }
        } else {
            const int c0 = u.pn * 256 + ct;
            const bool lat = u.pm < 64;
            const int cond = lat ? (u.pm >> 4) : 4;
            const float* gp = gmod + (size_t)cond * MODW + aux + c0;
            const float* xi = lat ? xin_l + (size_t)(u.pm * 256) * DM : xin_c + (size_t)((u.pm - 64) * 256) * DM;
            float* xo = lat ? xout_l + (size_t)(u.pm * 256) * DM : xout_c + (size_t)((u.pm - 64) * 256) * DM;
            f32x4 ga[2], gb[2];
#pragma unroll
            for (int bj = 0; bj < 2; ++bj) { ga[bj] = *(const f32x4*)(gp + bj * 128); gb[bj] = *(const f32x4*)(gp + bj * 128 + 4); }
#pragma unroll
            for (int ai = 0; ai < 2; ++ai) {
                f32x4 xa[4][2], xb[4][2];
#pragma unroll
                for (int m = 0; m < 4; ++m)
#pragma unroll
                    for (int bj = 0; bj < 2; ++bj) { const size_t o = (size_t)(rt + ai * 128 + m * 16) * DM + c0 + bj * 128; xa[m][bj] = *(const f32x4*)(xi + o); xb[m][bj] = *(const f32x4*)(xi + o + 4); }
                asm volatile("" ::: "memory");
#pragma unroll
                for (int m = 0; m < 4; ++m)
#pragma unroll
                    for (int bj = 0; bj < 2; ++bj) { const size_t o = (size_t)(rt + ai * 128 + m * 16) * DM + c0 + bj * 128;
                        *(f32x4*)(xo + o) = xa[m][bj] + ga[bj] * acc[ai][bj][m][0]; *(f32x4*)(xo + o + 4) = xb[m][bj] + gb[bj] * acc[ai][bj][m][1]; }
                asm volatile("" ::: "memory");
            }
        }
    }
};

namespace att {
using s16x4 = __attribute__((ext_vector_type(4))) short;
using f32x16 = __attribute__((ext_vector_type(16))) float;
constexpr int NW = 8, QBLK = 32, KVBLK = 64;
constexpr float THR = 8.f;
#ifndef ATT_SDEPTH
#define ATT_SDEPTH 1
#endif
constexpr int SDEPTH = ATT_SDEPTH;
constexpr size_t SHM_V = KVBLK * 128 * 2, SHM_KMAX = KVBLK * 128 * 2, SHM_ATTN = 2 * SHM_V + 2 * SHM_KMAX + NW * 64 * 4;
#define SBAR() __builtin_amdgcn_sched_barrier(0)
template <int DQK> __device__ __forceinline__ int kswz(int row, int colB) { return row * (DQK * 2) + (colB ^ ((DQK == 128 ? (row & 15) : ((row >> 1) & 7)) << 4)); }
__device__ __forceinline__ int crow(int r, int hi) { return (r & 3) + 8 * (r >> 2) + 4 * hi; }
__device__ __forceinline__ void partialSM(f32x16& p0, f32x16& p1, float& m_reg, float& mn, float& alpha, const float C, const float thr_raw) {
    float pmax = p0[0];
#pragma unroll
    for (int r = 1; r < 16; ++r) pmax = fmaxf(pmax, p0[r]);
#pragma unroll
    for (int r = 0; r < 16; ++r) pmax = fmaxf(pmax, p1[r]);
    { auto rr = __builtin_amdgcn_permlane32_swap(__float_as_uint(pmax), __float_as_uint(pmax), false, false);
      pmax = fmaxf(__uint_as_float(rr[0]), __uint_as_float(rr[1])); }
    if (__builtin_expect(__all(pmax - m_reg <= thr_raw), 1)) { mn = m_reg; alpha = 1.f; }
    else { mn = fmaxf(m_reg, pmax); alpha = __builtin_amdgcn_exp2f((m_reg - mn) * C); m_reg = mn; }
    const float mnC = -mn * C;
#pragma unroll
    for (int r = 0; r < 16; ++r) p0[r] = fmaf(p0[r], C, mnC);
#pragma unroll
    for (int r = 0; r < 16; ++r) p1[r] = fmaf(p1[r], C, mnC);
#pragma unroll
    for (int r = 0; r < 16; ++r) p0[r] = __builtin_amdgcn_exp2f(p0[r]);
}
__device__ __forceinline__ void finishSM(f32x16& p0, f32x16& p1, float alpha, float& l_reg, bf16x8& pa0, bf16x8& pa1, bf16x8& pa2, bf16x8& pa3) {
#pragma unroll
    for (int r = 0; r < 16; ++r) p1[r] = __builtin_amdgcn_exp2f(p1[r]);
    float ps = 0;
#pragma unroll
    for (int r = 0; r < 16; ++r) ps += p0[r];
#pragma unroll
    for (int r = 0; r < 16; ++r) ps += p1[r];
    { auto rr = __builtin_amdgcn_permlane32_swap(__float_as_uint(ps), __float_as_uint(ps), false, false);
      ps = __uint_as_float(rr[0]) + __uint_as_float(rr[1]); }
    l_reg = l_reg * alpha + ps;
#define PK4(P, BASE, OUT) do { unsigned a0 = cvt_pk_bf16(P[BASE + 0], P[BASE + 1]), a1 = cvt_pk_bf16(P[BASE + 2], P[BASE + 3]);   \
    unsigned b0 = cvt_pk_bf16(P[BASE + 4], P[BASE + 5]), b1 = cvt_pk_bf16(P[BASE + 6], P[BASE + 7]);                              \
    auto r0 = __builtin_amdgcn_permlane32_swap(a0, b0, false, false); auto r1 = __builtin_amdgcn_permlane32_swap(a1, b1, false, false); \
    u32x4 w = {r0[0], r1[0], r0[1], r1[1]}; OUT = *reinterpret_cast<bf16x8*>(&w); } while (0)
    PK4(p0, 0, pa0); PK4(p0, 8, pa1); PK4(p1, 0, pa2); PK4(p1, 8, pa3);
#undef PK4
}
template <int DQK> __device__ __forceinline__ void qkt(f32x16& p0, f32x16& p1, const char* Ks, const bf16x8* qr, int r32, int hi) {
    p0 = f32x16{}; p1 = f32x16{};
#pragma unroll
    for (int d0 = 0; d0 < DQK / 16; ++d0) { const int cb = (d0 * 16 + hi * 8) * 2;
        const bf16x8 b0 = *reinterpret_cast<const bf16x8*>(Ks + kswz<DQK>(r32, cb));
        const bf16x8 b1 = *reinterpret_cast<const bf16x8*>(Ks + kswz<DQK>(32 + r32, cb));
        p0 = __builtin_amdgcn_mfma_f32_32x32x16_bf16(b0, qr[d0], p0, 0, 0, 0);
        p1 = __builtin_amdgcn_mfma_f32_32x32x16_bf16(b1, qr[d0], p1, 0, 0, 0); }
}
__device__ __forceinline__ int v_st(int k, int c) { const int kk = (k & ~0xC) | ((k & 4) << 1) | ((k & 8) >> 1); return ((kk >> 3) * 4 + (c >> 5)) * 512 + ((kk & 7) * 32 + (c & 31)) * 2; }
__device__ __forceinline__ int v_rd_base(int lane) { return ((lane & 3) << 3) | (((lane >> 2) & 3) << 6) | (((lane >> 4) & 1) << 5) | (((lane >> 5) & 1) << 8); }
constexpr int v_rd_off(int d0, int ks, int half) { return d0 * 512 + ks * 4096 + half * 2048; }
template <int OFF> __device__ __forceinline__ s16x4 tr_read(int vb) {
    s16x4 r; asm volatile("ds_read_b64_tr_b16 %0, %1 offset:%2" : "=&v"(r) : "v"(vb), "i"(OFF) : "memory"); return r;
}
template <int D0> __device__ __forceinline__ void pv_one(f32x16& od, int vb, bf16x8 pa0, bf16x8 pa1, bf16x8 pa2, bf16x8 pa3) {
    const s16x4 l0 = tr_read<v_rd_off(D0, 0, 0)>(vb), h0 = tr_read<v_rd_off(D0, 0, 1)>(vb), l1 = tr_read<v_rd_off(D0, 1, 0)>(vb), h1 = tr_read<v_rd_off(D0, 1, 1)>(vb);
    const s16x4 l2 = tr_read<v_rd_off(D0, 2, 0)>(vb), h2 = tr_read<v_rd_off(D0, 2, 1)>(vb), l3 = tr_read<v_rd_off(D0, 3, 0)>(vb), h3 = tr_read<v_rd_off(D0, 3, 1)>(vb);
    asm volatile("s_waitcnt lgkmcnt(0)" ::: "memory"); SBAR();
#define PK(L, H) (bf16x8){L[0], L[1], L[2], L[3], H[0], H[1], H[2], H[3]}
    od = __builtin_amdgcn_mfma_f32_32x32x16_bf16(pa0, PK(l0, h0), od, 0, 0, 0);
    od = __builtin_amdgcn_mfma_f32_32x32x16_bf16(pa1, PK(l1, h1), od, 0, 0, 0);
    od = __builtin_amdgcn_mfma_f32_32x32x16_bf16(pa2, PK(l2, h2), od, 0, 0, 0);
    od = __builtin_amdgcn_mfma_f32_32x32x16_bf16(pa3, PK(l3, h3), od, 0, 0, 0);
#undef PK
}
__device__ __forceinline__ void pv_d0(f32x16* o, int vb, bf16x8 pa0, bf16x8 pa1, bf16x8 pa2, bf16x8 pa3) {
    pv_one<0>(o[0], vb, pa0, pa1, pa2, pa3); pv_one<1>(o[1], vb, pa0, pa1, pa2, pa3); pv_one<2>(o[2], vb, pa0, pa1, pa2, pa3); pv_one<3>(o[3], vb, pa0, pa1, pa2, pa3);
}
__device__ __forceinline__ void store_o(float* p, float v) { *p = v; }
__device__ __forceinline__ void store_o(bf16_t* p, float v) { *p = (bf16_t)f2bf(v); }

template <int DQK, int LDKV, typename TO>
__device__ __forceinline__ void attn_body(const bf16_t* __restrict__ Qb, const bf16_t* __restrict__ Kh, const bf16_t* __restrict__ Vh,
                                          TO* __restrict__ Ob, int seq, float scale, char* lds) {
    constexpr int ldq = 768, ldo = 768, ldk = LDKV, ldv = LDKV;
    constexpr size_t SHM_K = KVBLK * DQK * 2;
    const int tid = lthread(), wid = tid >> 6, lane = tid & 63, r32 = lane & 31, hi = lane >> 5;
    char* V_lds = lds; char* K_lds = lds + 2 * SHM_V;
    float* ws = (float*)(lds + 2 * SHM_V + 2 * SHM_KMAX) + wid * 64; float* li_l = ws; float* al_l = ws + 32;
    const float C = scale * 1.4426950408889634f, thr_raw = THR / scale;
    float m_reg = -1e30f, l_reg = 0; f32x16 o[4] = {}; bf16x8 qr[DQK / 16];
    const bf16_t* Qw = Qb + (long)(wid * QBLK + r32) * ldq + hi * 8;
#pragma unroll
    for (int d0 = 0; d0 < DQK / 16; ++d0) qr[d0] = *reinterpret_cast<const bf16x8*>(Qw + d0 * 16);
    const int sr = tid >> 4, sc = (tid & 15) * 8, vst0 = v_st(sr, sc), vst1 = v_st(32 + sr, sc);
    const int ksr = DQK == 128 ? sr : (tid >> 3), ksc = DQK == 128 ? sc : (tid & 7) * 8;
    const int vb0 = (int)(uintptr_t)V_lds + v_rd_base(lane);
    struct { bf16x8 vs0, vs1, ks0, ks1; } sr_[SDEPTH];
#define SLOAD(i, k0) do { sr_[i].vs0 = *reinterpret_cast<const bf16x8*>(&Vh[(long)((k0) + sr) * ldv + sc]); sr_[i].vs1 = *reinterpret_cast<const bf16x8*>(&Vh[(long)((k0) + 32 + sr) * ldv + sc]); \
    sr_[i].ks0 = *reinterpret_cast<const bf16x8*>(&Kh[(long)((k0) + ksr) * ldk + ksc]); \
    if (DQK == 128) sr_[i].ks1 = *reinterpret_cast<const bf16x8*>(&Kh[(long)((k0) + 32 + ksr) * ldk + ksc]); } while (0)
#define SWRITE(b, i) do { *(bf16x8*)(V_lds + (b) * SHM_V + vst0) = sr_[i].vs0;          \
    *(bf16x8*)(V_lds + (b) * SHM_V + vst1) = sr_[i].vs1; const int kc = ksc * 2;               \
    *(bf16x8*)(K_lds + (b) * SHM_K + kswz<DQK>(ksr, kc)) = sr_[i].ks0;                       \
    if (DQK == 128) *(bf16x8*)(K_lds + (b) * SHM_K + kswz<DQK>(32 + ksr, kc)) = sr_[i].ks1; } while (0)
#define SWAIT() do { if (SDEPTH == 1) asm volatile("s_waitcnt vmcnt(0)" ::: "memory"); else if (DQK == 128) asm volatile("s_waitcnt vmcnt(4)" ::: "memory"); else asm volatile("s_waitcnt vmcnt(3)" ::: "memory"); } while (0)
#define RESC(a) do { if (__any((a) < 1.f)) { if (hi == 0) al_l[r32] = (a); asm volatile("s_waitcnt lgkmcnt(0)" ::: "memory"); \
    _Pragma("unroll") for (int d = 0; d < 4; ++d) _Pragma("unroll") for (int r = 0; r < 16; ++r) o[d][r] *= al_l[crow(r, hi)]; } } while (0)
    f32x16 pA0, pA1, pB0, pB1; float mnA, mnB, alA, alB; bf16x8 pa0, pa1, pa2, pa3; const int NT = seq / KVBLK;
    constexpr int SE = 0, SO = SDEPTH - 1;
    SLOAD(SE, 0); asm volatile("s_waitcnt vmcnt(0)" ::: "memory"); SWRITE(0, SE); __syncthreads();
    qkt<DQK>(pA0, pA1, K_lds, qr, r32, hi); partialSM(pA0, pA1, m_reg, mnA, alA, C, thr_raw);
    SLOAD(SO, KVBLK); if (SDEPTH == 2) { if (2 < NT) SLOAD(SE, 2 * KVBLK); }
    SWAIT(); SWRITE(1, SO); __syncthreads();
    for (int j = 1; j + 1 < NT; j += 2) {
        SBAR(); qkt<DQK>(pB0, pB1, K_lds + SHM_K, qr, r32, hi);
        finishSM(pA0, pA1, alA, l_reg, pa0, pa1, pa2, pa3); SBAR();
        SLOAD(SO, (j + SDEPTH) * KVBLK); SBAR();
        pv_d0(o, vb0, pa0, pa1, pa2, pa3); partialSM(pB0, pB1, m_reg, mnB, alB, C, thr_raw);
        __syncthreads(); SWAIT(); SWRITE(0, SE);
        RESC(alB); __syncthreads();
        SBAR(); qkt<DQK>(pA0, pA1, K_lds, qr, r32, hi);
        finishSM(pB0, pB1, alB, l_reg, pa0, pa1, pa2, pa3); SBAR();
        if (SDEPTH == 1 || j + 3 < NT) SLOAD(SE, (j + 1 + SDEPTH) * KVBLK); SBAR();
        pv_d0(o, vb0 + (int)SHM_V, pa0, pa1, pa2, pa3); partialSM(pA0, pA1, m_reg, mnA, alA, C, thr_raw);
        __syncthreads(); SWAIT(); SWRITE(1, SO);
        RESC(alA); __syncthreads();
    }
    SBAR(); qkt<DQK>(pB0, pB1, K_lds + SHM_K, qr, r32, hi);
    finishSM(pA0, pA1, alA, l_reg, pa0, pa1, pa2, pa3); SBAR();
    pv_d0(o, vb0, pa0, pa1, pa2, pa3); partialSM(pB0, pB1, m_reg, mnB, alB, C, thr_raw);
    __syncthreads(); RESC(alB);
    finishSM(pB0, pB1, alB, l_reg, pa0, pa1, pa2, pa3); SBAR();
    pv_d0(o, vb0 + (int)SHM_V, pa0, pa1, pa2, pa3);
    if (hi == 0) li_l[r32] = l_reg; asm volatile("s_waitcnt lgkmcnt(0)" ::: "memory");
    float rli[16];
#pragma unroll
    for (int r = 0; r < 16; ++r) rli[r] = __builtin_amdgcn_rcpf(li_l[crow(r, hi)]);
    __syncthreads();
    bf16_t* stg = (bf16_t*)(lds + wid * 8192);
#pragma unroll
    for (int r = 0; r < 16; ++r) { const int orow = crow(r, hi);
#pragma unroll
        for (int d0 = 0; d0 < 4; ++d0) stg[orow * 128 + d0 * 32 + r32] = (bf16_t)f2bf(o[d0][r] * rli[r]); }
    asm volatile("s_waitcnt lgkmcnt(0)" ::: "memory");
    TO* Ow = Ob + (long)(wid * QBLK) * ldo;
#pragma unroll
    for (int i = 0; i < 8; ++i) { const int row = i * 4 + (lane >> 4), ch = lane & 15;
        const u32x4 v = *(const u32x4*)(stg + row * 128 + ch * 8); *(u32x4*)(Ow + (long)row * ldo + ch * 8) = v; }
#undef SLOAD
#undef SWRITE
#undef SWAIT
#undef RESC
}
#undef SBAR
}

struct Args { const float* in[N_IN]; float* out; unsigned char* ws; int ph_lo, ph_hi; };

constexpr int RING_BYTES = 131072, MISC_OFF = RING_BYTES, LDS_BYTES = 147456;

struct Frame {
    const Args* a; unsigned char* ws; char* lds; int tid, lane, wave, gw, ngw;
};

__device__ __forceinline__ void transpose_item(const float* W, int N, bf16_t* WT, int ldk, float* scr, int item, int lane) {
    const int nblk = N / 32, kb = item / nblk, nb = item % nblk, k0 = 64 * kb, n0 = 32 * nb;
    float tv[32];
#pragma unroll
    for (int i = 0; i < 32; ++i) { const int kk = 2 * i + (lane >> 5); tv[i] = W[(size_t)(k0 + kk) * N + n0 + (lane & 31)]; }
#pragma unroll
    for (int i = 0; i < 32; ++i) { const int kk = 2 * i + (lane >> 5); scr[kk * 33 + (lane & 31)] = tv[i]; }
    asm volatile("s_waitcnt lgkmcnt(0)" ::: "memory");
    const int c = lane & 7;
#pragma unroll
    for (int j = 0; j < 4; ++j) { const int n = (lane >> 3) + 8 * j; const float* s = scr + (8 * c) * 33 + n;
        u32x4 o; o.x = cvt_pk_bf16(s[0 * 33], s[1 * 33]); o.y = cvt_pk_bf16(s[2 * 33], s[3 * 33]); o.z = cvt_pk_bf16(s[4 * 33], s[5 * 33]); o.w = cvt_pk_bf16(s[6 * 33], s[7 * 33]);
        *(u32x4*)(WT + (size_t)(n0 + n) * ldk + k0 + 8 * c) = o; }
    asm volatile("s_waitcnt lgkmcnt(0)" ::: "memory");
}
__device__ __forceinline__ void convert_weights(const Frame& F, int layer) {
    float* scr = (float*)(F.lds + F.wave * 16384);
    const Args& A = *F.a;
    constexpr int I_IN = (2048 / 64) * (12288 / 32), I_BRX = (768 / 64) * (2048 / 32), I_OUT = (2048 / 64) * (2048 / 32), I_UPX = (2048 / 64) * (FF2 / 32), I_DN = (FF / 64) * (2048 / 32);
    constexpr int NITEMS = I_IN + 3 * I_BRX + I_OUT + I_UPX + I_DN;
    for (int it = F.gw; it < NITEMS; it += F.ngw) {
        int r = it;
        if (r < I_IN) { transpose_item(A.in[I_WIN] + (size_t)layer * 2048 * 12288, 12288, (bf16_t*)(F.ws + W_IN), 2048, scr, r, F.lane); continue; } r -= I_IN;
        if (r < I_BRX) { transpose_item(A.in[I_WBR] + (size_t)layer * 768 * 2048, 2048, (bf16_t*)(F.ws + W_BR), 768, scr, r, F.lane); continue; } r -= I_BRX;
        if (r < I_BRX) { transpose_item(A.in[I_WBG] + (size_t)layer * 768 * 2048, 2048, (bf16_t*)(F.ws + W_BR) + 2048 * 768, 768, scr, r, F.lane); continue; } r -= I_BRX;
        if (r < I_BRX) { transpose_item(A.in[I_WBD] + (size_t)layer * 768 * 2048, 2048, (bf16_t*)(F.ws + W_BR) + 2 * 2048 * 768, 768, scr, r, F.lane); continue; } r -= I_BRX;
        if (r < I_OUT) { transpose_item(A.in[I_WOUT] + (size_t)layer * 2048 * 2048, 2048, (bf16_t*)(F.ws + W_OUT), 2048, scr, r, F.lane); continue; } r -= I_OUT;
        if (r < I_UPX) { transpose_item(A.in[I_UP] + (size_t)layer * 2048 * FF2, FF2, (bf16_t*)(F.ws + W_UP), 2048, scr, r, F.lane); continue; } r -= I_UPX;
        transpose_item(A.in[I_DOWN] + (size_t)layer * FF * 2048, 2048, (bf16_t*)(F.ws + W_DOWN), FF, scr, r, F.lane);
    }
    const float* w2 = A.in[I_W2] + (size_t)layer * 2 * 64 * 768; const float* a2 = A.in[I_A2] + (size_t)layer * 2 * 64 * 768; const float* g2 = A.in[I_G2] + (size_t)layer * 128 * 768;
    for (int n = F.gw; n < 3840 + (layer == 1 ? 768 * 12 : 0); n += F.ngw) {
        if (n < 3840) {
            const int seg = n / 768, c = n % 768; bf16_t* dst = (bf16_t*)(F.ws + W_LR) + (size_t)n * 256;
#pragma unroll
            for (int j = 0; j < 4; ++j) { const int k = j * 64 + F.lane; float v = 0.f;
                if (seg < 2) { if (k < 64) v = w2[((size_t)seg * 64 + k) * 768 + c]; }
                else if (seg < 4) { if (k >= 64 && k < 128) v = a2[((size_t)(seg - 2) * 64 + (k - 64)) * 768 + c]; }
                else { if (k >= 128) v = g2[(size_t)(k - 128) * 768 + c]; }
                dst[k] = (bf16_t)f2bf(v); }
        } else {
            const int q_ = n - 3840, nn = q_ / 12, k = (q_ % 12) * 64 + F.lane;
            const float* v1r = A.in[I_V1] + (size_t)k * 32; const float* v2p = A.in[I_V2] + nn;
            f32x4 a[8]; float b[32];
#pragma unroll
            for (int r4 = 0; r4 < 8; ++r4) a[r4] = *(const f32x4*)(v1r + 4 * r4);
#pragma unroll
            for (int r = 0; r < 32; ++r) b[r] = v2p[(size_t)r * 768];
            float s = 0.f;
#pragma unroll
            for (int r4 = 0; r4 < 8; ++r4) s += a[r4].x * b[4 * r4] + a[r4].y * b[4 * r4 + 1] + a[r4].z * b[4 * r4 + 2] + a[r4].w * b[4 * r4 + 3];
            ((bf16_t*)(F.ws + W_V12))[(size_t)nn * 768 + k] = (bf16_t)f2bf(s);
        }
    }
}
__device__ __forceinline__ void adaln(const Frame& F) {
    const Args& A = *F.a;
    float* sc = (float*)F.lds;
    float* red = (float*)(F.lds + 40960);
    for (int i = F.tid; i < 5 * 2048; i += NTHREADS) { const int cnd = i >> 11, k = i & 2047; const float v = cnd < 4 ? A.in[I_C][cnd * 2048 + k] : A.in[I_CCTX][k]; sc[i] = v / (1.f + __expf(-v)); }
    __syncthreads();
    float* MOD = (float*)(F.ws + O_MOD);
    for (int slab = blockIdx.x; slab < 256; slab += gridDim.x) {
        const int col0 = slab * 96, layer = col0 / MODW, cc = col0 % MODW;
        const float* W = A.in[I_WMOD] + (size_t)layer * 2048 * MODW + cc;
        float a0[5] = {0.f, 0.f, 0.f, 0.f, 0.f}, a1[5] = {0.f, 0.f, 0.f, 0.f, 0.f};
        const int kb = F.wave * 256;
#pragma unroll 8
        for (int k = kb; k < kb + 256; ++k) {
            const float w0 = W[(size_t)k * MODW + F.lane]; const float w1 = F.lane < 32 ? W[(size_t)k * MODW + 64 + F.lane] : 0.f;
#pragma unroll
            for (int c = 0; c < 5; ++c) { const float s = sc[c * 2048 + k]; a0[c] += s * w0; a1[c] += s * w1; }
        }
#pragma unroll
        for (int c = 0; c < 5; ++c) { red[(F.wave * 10 + c * 2) * 64 + F.lane] = a0[c]; red[(F.wave * 10 + c * 2 + 1) * 64 + F.lane] = a1[c]; }
        __syncthreads();
        if (F.tid < 480) { const int c = F.tid / 96, j = F.tid % 96; float s = A.in[I_BMOD][layer * MODW + cc + j];
#pragma unroll
            for (int w = 0; w < 8; ++w) s += red[(w * 10 + c * 2 + (j >> 6)) * 64 + (j & 63)];
            MOD[((size_t)layer * 5 + c) * MODW + cc + j] = s; }
        __syncthreads();
    }
}
__device__ __forceinline__ void norm_rows(const Frame& F, const float* xl, const float* xc, const float* gain, const float* mod  , int sh_off, int sc_off, int nrows) {
    bf16_t* H = (bf16_t*)(F.ws + O_H);
    for (int m = F.gw; m < nrows; m += F.ngw) {
        const bool lat = m < TL; const int cond = lat ? (m >> 12) : 4;
        const float* xr = lat ? xl + (size_t)m * DM : xc + (size_t)(m - TL) * DM;
        f32x4 v[8]; float s = 0.f;
#pragma unroll
        for (int j = 0; j < 8; ++j) { v[j] = *(const f32x4*)(xr + j * 256 + F.lane * 4); s += v[j].x * v[j].x + v[j].y * v[j].y + v[j].z * v[j].z + v[j].w * v[j].w; }
        const float rs = rsqrtf(wave_sum(s) * (1.f / DM) + 1e-6f);
        const float* mp = mod + (size_t)cond * MODW;
#pragma unroll
        for (int j = 0; j < 8; ++j) { const int c = j * 256 + F.lane * 4;
            const f32x4 g = *(const f32x4*)(gain + c), sh = *(const f32x4*)(mp + sh_off + c), sc = *(const f32x4*)(mp + sc_off + c);
            const f32x4 y = v[j] * rs * g * (sc + 1.f) + sh;
            u32x2 w; w.x = cvt_pk_bf16(y.x, y.y); w.y = cvt_pk_bf16(y.z, y.w); *(u32x2*)(H + (size_t)m * DM + c) = w; }
    }
}
__device__ __forceinline__ void final_norm(const Frame& F) {
    float* X = F.a->out; const float* gain = F.a->in[I_FN];
    for (int m = F.gw; m < TL; m += F.ngw) {
        float* xr = X + (size_t)m * DM; f32x4 v[8]; float s = 0.f;
#pragma unroll
        for (int j = 0; j < 8; ++j) { v[j] = *(const f32x4*)(xr + j * 256 + F.lane * 4); s += v[j].x * v[j].x + v[j].y * v[j].y + v[j].z * v[j].z + v[j].w * v[j].w; }
        const float rs = rsqrtf(wave_sum(s) * (1.f / DM) + 1e-6f);
#pragma unroll
        for (int j = 0; j < 8; ++j) { const int c = j * 256 + F.lane * 4; *(f32x4*)(xr + c) = v[j] * rs * *(const f32x4*)(gain + c); }
    }
}
__device__ __forceinline__ float row16_sum_p(float v) {
    v += __int_as_float(__builtin_amdgcn_update_dpp(0, __float_as_int(v), 0xB1, 0xF, 0xF, true));
    v += __int_as_float(__builtin_amdgcn_update_dpp(0, __float_as_int(v), 0x4E, 0xF, 0xF, true));
    v += __int_as_float(__builtin_amdgcn_update_dpp(0, __float_as_int(v), 0x141, 0xF, 0xF, true));
    v += __int_as_float(__builtin_amdgcn_update_dpp(0, __float_as_int(v), 0x140, 0xF, 0xF, true));
    return v;
}
__device__ __forceinline__ f32x4 unpack4p(u32x2 w) { return (f32x4){bf2f(w.x & 0xffffu), __uint_as_float(w.x & 0xffff0000u), bf2f(w.y & 0xffffu), __uint_as_float(w.y & 0xffff0000u)}; }
__device__ __forceinline__ u32x2 pack4p(f32x4 v) { u32x2 w; w.x = cvt_pk_bf16(v.x, v.y); w.y = cvt_pk_bf16(v.z, v.w); return w; }
__device__ __forceinline__ void rwkv_prep(const Frame& F, int layer) {
    const Args& A = *F.a;
    const bf16_t* PR = (const bf16_t*)(F.ws + A_PR);
    bf16_t* R = (bf16_t*)(F.ws + A_R); bf16_t* K = (bf16_t*)(F.ws + A_K); bf16_t* V = (bf16_t*)(F.ws + (layer == 0 ? O_VF : A_YS));
    bf16_t* KKo = (bf16_t*)(F.ws + A_KKN); bf16_t* LR = (bf16_t*)(F.ws + A_LR);
    const float* mu = A.in[I_MU] + layer * RCOLS; const float* kkw = A.in[I_KK] + layer * RW;
    const int l4 = F.lane * 4;
    for (int m = F.gw; m < TT; m += F.ngw) {
        const bool lat = m < TL; const int t = lat ? (m & 4095) : ((m - TL) & 255), len = lat ? SEQ : CTX;
        const bool hp = t > 0, hn = t < len - 1;
        const bf16_t* p = PR + (size_t)m * RCOLS;
        const u32x2 z2 = {0u, 0u};
        u32x2 rc[10], rp[10], rn[10]; f32x4 rm[10], rk3[3];
#pragma unroll
        for (int it = 0; it < 10; ++it) { const int c = it * 256 + l4;
            rc[it] = *(const u32x2*)(p + c); rp[it] = hp ? *(const u32x2*)(p + c - RCOLS) : z2; rn[it] = hn ? *(const u32x2*)(p + c + RCOLS) : z2; rm[it] = *(const f32x4*)(mu + c); }
#pragma unroll
        for (int j = 0; j < 3; ++j) rk3[j] = *(const f32x4*)(kkw + j * 256 + l4);
        asm volatile("" ::: "memory");
#pragma unroll
        for (int it = 0; it < 10; ++it) { const int c = it * 256 + l4;
            const f32x4 cur = unpack4p(rc[it]), pv = unpack4p(rp[it]), nx = unpack4p(rn[it]);
            const f32x4 xs = cur + rm[it] * ((pv + nx) * 0.5f - cur);
            if (it < 3) { *(u32x2*)(R + (size_t)m * RW + c) = pack4p(xs); }
            else if (it < 6) { const int ck = c - 768; *(u32x2*)(K + (size_t)m * RW + ck) = pack4p(xs);
                const f32x4 kk = xs * rk3[it - 3 < 0 ? 0 : (it - 3 > 2 ? 2 : it - 3)];
                const float ss = row16_sum_p((kk.x * kk.x + kk.y * kk.y) + (kk.z * kk.z + kk.w * kk.w));
                *(u32x2*)(KKo + (size_t)m * RW + ck) = pack4p(kk * (1.f / fmaxf(sqrtf(ss), 1e-12f))); }
            else if (it < 9) { *(u32x2*)(V + (size_t)m * RW + c - 1536) = pack4p(xs); }
            else { f32x4 o;
                if (F.lane < 16) o = (f32x4){tanhf(xs.x), tanhf(xs.y), tanhf(xs.z), tanhf(xs.w)};
                else if (F.lane < 32) o = xs;
                else o = (f32x4){sigmoidf_(xs.x), sigmoidf_(xs.y), sigmoidf_(xs.z), sigmoidf_(xs.w)};
                *(u32x2*)(LR + (size_t)m * 256 + l4) = pack4p(o); }
        }
        asm volatile("" ::: "memory");
    }
}
__device__ __forceinline__ void qk_prep(const Frame& F, int layer) {
    const Args& A = *F.a;
    bf16_t* QG = (bf16_t*)(F.ws + A_QG); bf16_t* KG = (bf16_t*)(F.ws + A_KG); bf16_t* DQ = (bf16_t*)(F.ws + A_DQ); bf16_t* DK = (bf16_t*)(F.ws + A_DK);
    float* TGc = (float*)F.lds; float* TGs = TGc + 2048; float* TDc = TGs + 2048; float* TDs = TDc + 1024;
    __syncthreads();
    for (int i = F.tid; i < 2048; i += NTHREADS) { float s_, c_; sincosf((float)(i >> 5) * powf(10000.f, -(float)(i & 31) / 32.f), &s_, &c_); TGc[i] = c_; TGs[i] = s_; }
    for (int i = F.tid; i < 1024; i += NTHREADS) { float s_, c_; sincosf((float)(i >> 4) * powf(10000.f, -(float)(i & 15) / 16.f), &s_, &c_); TDc[i] = c_; TDs[i] = s_; }
    __syncthreads();
    const int l = F.lane, sub = l & 15, hg = l >> 4, sub8 = l & 7;
    float gq[8], gk[8];
#pragma unroll
    for (int e = 0; e < 8; ++e) { gq[e] = A.in[I_QN][layer * 128 + sub * 8 + e]; gk[e] = A.in[I_KN][layer * 128 + sub * 8 + e]; }
    for (int m = F.gw; m < TT; m += F.ngw) {
        const bool lat = m < TL; const int b = lat ? (m >> 12) : ((m - TL) >> 8), t = lat ? (m & 4095) : ((m - TL) & 255);
        const size_t kvrow = (size_t)b * KVS + (lat ? CTX + t : t);
        const int ridx = t >> 6, cidx = t & 63;
        u32x4 qraw[2], draw[3];
#pragma unroll
        for (int ps = 0; ps < 2; ++ps) { const bool isk = ps == 1 && hg >= 2;
            qraw[ps] = *(const u32x4*)(isk ? KG + kvrow * 256 + (hg - 2) * 128 + sub * 8 : QG + (size_t)m * 768 + (ps * 4 + hg) * 128 + sub * 8); }
#pragma unroll
        for (int ps = 0; ps < 3; ++ps) { const int v = ps * 8 + (l >> 3);
            draw[ps] = lat ? *(const u32x4*)(v < 12 ? DQ + (size_t)m * 768 + v * 64 + sub8 * 8 : DK + kvrow * 768 + (v - 12) * 64 + sub8 * 8) : (u32x4){0u, 0u, 0u, 0u}; }
        asm volatile("" ::: "memory");
#pragma unroll
        for (int ps = 0; ps < 2; ++ps) {
            const bool isk = ps == 1 && hg >= 2;
            bf16_t* ptr = isk ? KG + kvrow * 256 + (hg - 2) * 128 + sub * 8 : QG + (size_t)m * 768 + (ps * 4 + hg) * 128 + sub * 8;
            float x[8]; unpack8(qraw[ps], x);
            float ss = 0.f;
#pragma unroll
            for (int e = 0; e < 8; ++e) ss += x[e] * x[e];
            const float rs = rsqrtf(row16_sum_p(ss) * (1.f / 128.f) + 1e-6f);
#pragma unroll
            for (int e = 0; e < 8; ++e) x[e] *= rs * (isk ? gk[e] : gq[e]);
            if (lat) {
                const int ti = (sub < 8 ? ridx : cidx) * 32 + (sub & 3) * 8; const bool up = (sub & 4) != 0;
                const f32x4 c0 = *(const f32x4*)(TGc + ti), c1 = *(const f32x4*)(TGc + ti + 4), s0 = *(const f32x4*)(TGs + ti), s1 = *(const f32x4*)(TGs + ti + 4);
#pragma unroll
                for (int e = 0; e < 8; ++e) { const float pl_ = __int_as_float(__builtin_amdgcn_update_dpp(0, __float_as_int(x[e]), 0x104, 0xF, 0xF, true)), pr_ = __int_as_float(__builtin_amdgcn_update_dpp(0, __float_as_int(x[e]), 0x114, 0xF, 0xF, true)); const float pz = up ? pr_ : pl_; const float cc = e < 4 ? c0[e & 3] : c1[e & 3], sn = e < 4 ? s0[e & 3] : s1[e & 3];
                    x[e] = up ? pz * sn + x[e] * cc : x[e] * cc - pz * sn; }
            }
            *(u32x4*)ptr = pack8(x);
        }
        if (lat) {
#pragma unroll
            for (int ps = 0; ps < 3; ++ps) { const int v = ps * 8 + (l >> 3);
                bf16_t* ptr = v < 12 ? DQ + (size_t)m * 768 + v * 64 + sub8 * 8 : DK + kvrow * 768 + (v - 12) * 64 + sub8 * 8;
                float x[8]; unpack8(draw[ps], x);
                const int ti = (sub8 < 4 ? ridx : cidx) * 16 + (sub8 & 1) * 8; const bool up = (sub8 & 2) != 0;
                const f32x4 c0 = *(const f32x4*)(TDc + ti), c1 = *(const f32x4*)(TDc + ti + 4), s0 = *(const f32x4*)(TDs + ti), s1 = *(const f32x4*)(TDs + ti + 4);
#pragma unroll
                for (int e = 0; e < 8; ++e) { const float pz = __int_as_float(__builtin_amdgcn_update_dpp(0, __float_as_int(x[e]), 0x4E, 0xF, 0xF, true));
                    const float cc = e < 4 ? c0[e & 3] : c1[e & 3], sn = e < 4 ? s0[e & 3] : s1[e & 3];
                    x[e] = up ? pz * sn + x[e] * cc : x[e] * cc - pz * sn; }
                *(u32x4*)ptr = pack8(x);
            }
        }
    }
}
__device__ __forceinline__ float quad_sum(float v) {
    v += __int_as_float(__builtin_amdgcn_update_dpp(0, __float_as_int(v), 0xB1, 0xF, 0xF, true));
    v += __int_as_float(__builtin_amdgcn_update_dpp(0, __float_as_int(v), 0x4E, 0xF, 0xF, true));
    return v;
}
struct ScanStep { f32x4 w[2], kd[2], kk[2], b[2], r[2]; f32x2 v; };
__device__ __forceinline__ ScanStep scan_ld(const float* cb, const float* vbp, int s) {
    ScanStep d; const float* rec = cb + s * 384;
#pragma unroll
    for (int jj = 0; jj < 2; ++jj) { d.w[jj] = *(const f32x4*)(rec + jj * 4); d.kd[jj] = *(const f32x4*)(rec + 64 + jj * 4); d.kk[jj] = *(const f32x4*)(rec + 128 + jj * 4);
        d.b[jj] = *(const f32x4*)(rec + 192 + jj * 4); d.r[jj] = *(const f32x4*)(rec + 256 + jj * 4); }
    d.v = *(const f32x2*)(vbp + s * 384);
    return d;
}
__device__ __forceinline__ float oct_sum(float v) {
    v += __int_as_float(__builtin_amdgcn_update_dpp(0, __float_as_int(v), 0xB1, 0xF, 0xF, true));
    v += __int_as_float(__builtin_amdgcn_update_dpp(0, __float_as_int(v), 0x4E, 0xF, 0xF, true));
    v += __int_as_float(__builtin_amdgcn_update_dpp(0, __float_as_int(v), 0x141, 0xF, 0xF, true));
    return v;
}
__device__ __forceinline__ int scan_rowof(int g, int b, int dir) { if (g < CTX) { const int tt = dir ? (CTX - 1 - g) : g; return TL + b * CTX + tt; } const int g2 = g - CTX; const int tt = dir ? (SEQ - 1 - g2) : g2; return b * SEQ + tt; }
__device__ __forceinline__ void scan_chain(const Frame& F, int layer, int chain) {
    const Args& A = *F.a;
    const int b = chain / 24, h = (chain >> 1) % 12, dir = chain & 1;
    float* buf = (float*)F.lds;
    float* ybuf = (float*)(F.lds + 49152);
    const bf16_t* R = (const bf16_t*)(F.ws + A_R); const bf16_t* K = (const bf16_t*)(F.ws + A_K); const bf16_t* V = (const bf16_t*)(F.ws + (layer == 0 ? O_VF : A_V));
    const bf16_t* KKp = (const bf16_t*)(F.ws + A_KKN); const bf16_t* EW = (const bf16_t*)(F.ws + A_EW) + (size_t)dir * TT * RW; const bf16_t* AS = (const bf16_t*)(F.ws + A_AS) + (size_t)dir * TT * RW;
    float* YS = (float*)(F.ws + A_YS) + (size_t)dir * TT * RW;
    const bool stager = F.wave >= 4;
    const int t8 = F.tid & 255, s_st = t8 >> 4, part = t8 & 15, seg = part & 7, hrole = part >> 3;
    const int colo = h * 64 + seg * 8;
    float ka[8];
#pragma unroll
    for (int e = 0; e < 8; ++e) ka[e] = A.in[I_KA][layer * RW + colo + e];
    constexpr int NCH = (CTX + SEQ) / 16;
#define rowof(g) scan_rowof((g), b, dir)
    u32x4 z4 = {0u, 0u, 0u, 0u};
    u32x4 a0A = z4, a1A = z4, a2A = z4, a3A = z4, a0B = z4, a1B = z4, a2B = z4, a3B = z4;
#define SC_LOAD(r0, r1, r2, r3, n) do { const size_t ro_ = (size_t)rowof((n) * 16 + s_st) * RW + colo; \
        if (hrole == 0) { r0 = *(const u32x4*)(EW + ro_); r1 = *(const u32x4*)(R + ro_); r2 = *(const u32x4*)(K + ro_); r3 = *(const u32x4*)(AS + ro_); } \
        else { r0 = *(const u32x4*)(KKp + ro_); r1 = *(const u32x4*)(AS + ro_); r2 = *(const u32x4*)(V + ro_); } } while (0)
#define SC_WRITE(r0, r1, r2, r3, bi) do { float* d_ = buf + (bi) * 6144 + s_st * 384 + seg * 8; float x_[8], y_[8]; \
        if (hrole == 0) { unpack8(r0, x_); unpack8(r1, y_); float o_[8]; \
            _Pragma("unroll") for (int e = 0; e < 8; ++e) o_[e] = __expf(-x_[e]); \
            *(f32x4*)(d_) = (f32x4){o_[0], o_[1], o_[2], o_[3]}; *(f32x4*)(d_ + 4) = (f32x4){o_[4], o_[5], o_[6], o_[7]}; \
            *(f32x4*)(d_ + 256) = (f32x4){y_[0], y_[1], y_[2], y_[3]}; *(f32x4*)(d_ + 260) = (f32x4){y_[4], y_[5], y_[6], y_[7]}; \
            unpack8(r2, x_); unpack8(r3, y_); \
            _Pragma("unroll") for (int e = 0; e < 8; ++e) o_[e] = x_[e] * (1.f + (y_[e] - 1.f) * ka[e]); \
            *(f32x4*)(d_ + 64) = (f32x4){o_[0], o_[1], o_[2], o_[3]}; *(f32x4*)(d_ + 68) = (f32x4){o_[4], o_[5], o_[6], o_[7]}; } \
        else { unpack8(r0, x_); unpack8(r1, y_); \
            *(f32x4*)(d_ + 128) = (f32x4){x_[0], x_[1], x_[2], x_[3]}; *(f32x4*)(d_ + 132) = (f32x4){x_[4], x_[5], x_[6], x_[7]}; \
            *(f32x4*)(d_ + 192) = (f32x4){x_[0] * y_[0], x_[1] * y_[1], x_[2] * y_[2], x_[3] * y_[3]}; *(f32x4*)(d_ + 196) = (f32x4){x_[4] * y_[4], x_[5] * y_[5], x_[6] * y_[6], x_[7] * y_[7]}; \
            unpack8(r2, x_); \
            *(f32x4*)(d_ + 320) = (f32x4){x_[0], x_[1], x_[2], x_[3]}; *(f32x4*)(d_ + 324) = (f32x4){x_[4], x_[5], x_[6], x_[7]}; } } while (0)
    const int row_i = (F.wave & 3) * 16 + (F.lane >> 3) * 2, q = F.lane & 7;
    f32x2 S0[4], S1[4];
#pragma unroll
    for (int j = 0; j < 4; ++j) { S0[j] = (f32x2){0.f, 0.f}; S1[j] = (f32x2){0.f, 0.f}; }
    if (stager) { SC_LOAD(a0A, a1A, a2A, a3A, 0); SC_WRITE(a0A, a1A, a2A, a3A, 0); SC_LOAD(a0B, a1B, a2B, a3B, 1); SC_LOAD(a0A, a1A, a2A, a3A, 2); }
    __syncthreads();
#define SC_ITER(n, r0, r1, r2, r3) do { \
        if (!stager) { const float* cb = buf + ((n) & 1) * 6144 + q * 8; const float* vbp = buf + ((n) & 1) * 6144 + 320 + row_i; float* yb = ybuf + ((n) & 1) * 8192 + ((F.wave & 3) * 64 + F.lane) * 2; \
          ScanStep cur = scan_ld(cb, vbp, 0); \
          _Pragma("unroll") for (int hs = 0; hs < 2; ++hs) { f32x2 yreg[8]; \
          _Pragma("unroll") for (int s8 = 0; s8 < 8; ++s8) { const int s = hs * 8 + s8; \
            const ScanStep nx = scan_ld(cb, vbp, s < 15 ? s + 1 : 15); \
            f32x2 a0 = S0[0] * cur.kk[0].xy, a1 = S0[1] * cur.kk[0].zw, c0 = S1[0] * cur.kk[0].xy, c1 = S1[1] * cur.kk[0].zw; \
            a0 += S0[2] * cur.kk[1].xy; a1 += S0[3] * cur.kk[1].zw; c0 += S1[2] * cur.kk[1].xy; c1 += S1[3] * cur.kk[1].zw; \
            a0 += a1; c0 += c1; \
            const float nsa0 = -oct_sum(a0.x + a0.y), nsa1 = -oct_sum(c0.x + c0.y); \
            const float v0 = cur.v.x, v1 = cur.v.y; \
            f32x2 y0 = {0.f, 0.f}, y1 = {0.f, 0.f}, z0 = {0.f, 0.f}, z1 = {0.f, 0.f}; \
            _Pragma("unroll") for (int jj = 0; jj < 2; ++jj) { \
                S0[2 * jj] = S0[2 * jj] * cur.w[jj].xy + (cur.kd[jj].xy * v0 + cur.b[jj].xy * nsa0); \
                S0[2 * jj + 1] = S0[2 * jj + 1] * cur.w[jj].zw + (cur.kd[jj].zw * v0 + cur.b[jj].zw * nsa0); \
                S1[2 * jj] = S1[2 * jj] * cur.w[jj].xy + (cur.kd[jj].xy * v1 + cur.b[jj].xy * nsa1); \
                S1[2 * jj + 1] = S1[2 * jj + 1] * cur.w[jj].zw + (cur.kd[jj].zw * v1 + cur.b[jj].zw * nsa1); \
                y0 += S0[2 * jj] * cur.r[jj].xy; y1 += S0[2 * jj + 1] * cur.r[jj].zw; \
                z0 += S1[2 * jj] * cur.r[jj].xy; z1 += S1[2 * jj + 1] * cur.r[jj].zw; } \
            y0 += y1; z0 += z1; \
            yreg[s8] = (f32x2){y0.x + y0.y, z0.x + z0.y}; \
            cur = nx; } \
          _Pragma("unroll") for (int s8 = 0; s8 < 8; ++s8) *(f32x2*)(yb + (hs * 8 + s8) * 512) = yreg[s8]; } } \
        else { if ((n) + 1 < NCH) SC_WRITE(r0, r1, r2, r3, ((n) + 1) & 1); \
               if ((n) + 3 < NCH) SC_LOAD(r0, r1, r2, r3, (n) + 3); } \
        __syncthreads(); \
        if (stager) { const int s = t8 >> 4, i4 = (t8 & 15) * 4; const float* yb = ybuf + ((n) & 1) * 8192 + s * 512 + (i4 >> 1) * 16; \
          f32x4 o_ = {0.f, 0.f, 0.f, 0.f}; \
          _Pragma("unroll") for (int qq = 0; qq < 4; ++qq) { const f32x4 pa_ = *(const f32x4*)(yb + qq * 4), pb_ = *(const f32x4*)(yb + 16 + qq * 4); \
            o_.x += pa_.x + pa_.z; o_.y += pa_.y + pa_.w; o_.z += pb_.x + pb_.z; o_.w += pb_.y + pb_.w; } \
          *(f32x4*)(YS + (size_t)rowof((n) * 16 + s) * RW + h * 64 + i4) = o_; } } while (0)
    for (int n = 0; n < NCH; n += 2) { SC_ITER(n, a0B, a1B, a2B, a3B); SC_ITER(n + 1, a0A, a1A, a2A, a3A); }
    __syncthreads();
#undef SC_ITER
#undef SC_LOAD
#undef SC_WRITE
#undef rowof
}
__device__ __forceinline__ void ph_mix(const Frame& F, int layer, int rep) {
#ifndef PROBE_SUB
#define PROBE_SUB 0
#endif
    if (!(rep == 1 && PROBE_SUB == 2))
    for (int ch = blockIdx.x; ch < 96; ch += gridDim.x) scan_chain(F, layer, ch);
    unsigned* qbase = (unsigned*)(F.ws + O_CTL) + 64 * (16 + (layer * 2 + rep) * 8);
    volatile unsigned* misc = (volatile unsigned*)(F.lds + MISC_OFF);
    const int NK = (rep == 1 && PROBE_SUB == 1) ? 0 : (layer == 0 ? 144 + 9 : 144);
    const bf16_t* QG = (const bf16_t*)(F.ws + A_QG); const bf16_t* KG = (const bf16_t*)(F.ws + A_KG); const bf16_t* VG = (const bf16_t*)(F.ws + A_VG);
    const bf16_t* DQ = (const bf16_t*)(F.ws + A_DQ); const bf16_t* DK = (const bf16_t*)(F.ws + A_DK); const bf16_t* DV = (const bf16_t*)(F.ws + A_DV);
    bf16_t* YG = (bf16_t*)(F.ws + A_YG); bf16_t* OD = (bf16_t*)(F.ws + A_OD);
    const int x0 = (int)(xb_xcc_id() & 7u);
    int qi = 0;
    for (;;) {
        __syncthreads();
        if (F.tid == 0) { int qq = qi; unsigned uu = 0xFFFFFFFFu;
            while (qq < 8) { const int x = (x0 + qq) & 7; const unsigned k = atomicAdd(qbase + 64 * x, 1u); if ((int)k < NK) { uu = ((unsigned)x << 16) | k; break; } ++qq; }
            misc[0] = uu; misc[1] = (unsigned)qq; }
        __syncthreads();
        const unsigned uu = misc[0]; qi = (int)misc[1];
        if (uu == 0xFFFFFFFFu) break;
        const int x = (int)(uu >> 16), k = (int)(uu & 0xFFFFu);
        const bool isctx = k >= 144;
        const int g = x + 8 * (isctx ? (k - 144) : (k >> 4)), qb = k & 15;
        const bf16_t *qp, *kp, *vp; size_t orow; int kind, seq, oh;
        if (g < 24) { const int b = g / 6, hq = g % 6; orow = isctx ? (size_t)TL + b * CTX : (size_t)b * SEQ + qb * 256; kind = 0; oh = hq;
            qp = QG + orow * 768 + hq * 128; kp = KG + (size_t)b * KVS * 256 + (hq / 3) * 128; vp = VG + (size_t)b * KVS * 256 + (hq / 3) * 128; }
        else { const int d = g - 24, b = d / 12, h = (d >> 1) % 6, mp = d & 1; orow = isctx ? (size_t)TL + b * CTX : (size_t)b * SEQ + qb * 256; kind = 1 + mp; oh = h;
            qp = DQ + orow * 768 + (h * 2 + mp) * 64; kp = DK + (size_t)b * KVS * 768 + (h * 2 + mp) * 64; vp = DV + (size_t)b * KVS * 768 + h * 128; }
        seq = isctx ? CTX : KVS;
        if (kind == 0) att::attn_body<128, 256, bf16_t>(qp, kp, vp, YG + orow * 768 + oh * 128, seq, 0.088388347648318440f, F.lds);
        if (kind != 0) att::attn_body<64, 768, bf16_t>(qp, kp, vp, OD + (size_t)(kind - 1) * TT * 768 + orow * 768 + oh * 128, seq, 0.125f, F.lds);
    }
}
__device__ __forceinline__ float row16_sum(float v) {
    v += __int_as_float(__builtin_amdgcn_update_dpp(0, __float_as_int(v), 0xB1, 0xF, 0xF, true));
    v += __int_as_float(__builtin_amdgcn_update_dpp(0, __float_as_int(v), 0x4E, 0xF, 0xF, true));
    v += __int_as_float(__builtin_amdgcn_update_dpp(0, __float_as_int(v), 0x141, 0xF, 0xF, true));
    v += __int_as_float(__builtin_amdgcn_update_dpp(0, __float_as_int(v), 0x140, 0xF, 0xF, true));
    return v;
}
__device__ __forceinline__ f32x4 unpack4(u32x2 w) { return (f32x4){bf2f(w.x & 0xffffu), __uint_as_float(w.x & 0xffff0000u), bf2f(w.y & 0xffffu), __uint_as_float(w.y & 0xffff0000u)}; }
__device__ __forceinline__ u32x2 pack4(f32x4 v) { u32x2 w; w.x = cvt_pk_bf16(v.x, v.y); w.y = cvt_pk_bf16(v.z, v.w); return w; }
__device__ __forceinline__ void ph_post(const Frame& F, int layer) {
    const Args& A = *F.a; const int l = F.lane;
    const int nrows = layer == 0 ? TT : TL;
    const bf16_t* R = (const bf16_t*)(F.ws + A_R); const bf16_t* K = (const bf16_t*)(F.ws + A_K); const bf16_t* V = (const bf16_t*)(F.ws + (layer == 0 ? O_VF : A_V));
    const bf16_t* AS0 = (const bf16_t*)(F.ws + A_AS); const bf16_t* AS1 = AS0 + (size_t)TT * RW; const bf16_t* G = (const bf16_t*)(F.ws + A_G);
    const float* YS0 = (const float*)(F.ws + A_YS); const float* YS1 = YS0 + (size_t)TT * RW;
    const bf16_t* OD0 = (const bf16_t*)(F.ws + A_OD); const bf16_t* OD1 = OD0 + (size_t)TT * 768;
    bf16_t* YR = (bf16_t*)(F.ws + A_YR); bf16_t* YD = (bf16_t*)(F.ws + A_YD);
    const float* lnw = A.in[I_LNW] + layer * RW; const float* lnb = A.in[I_LNB] + layer * RW; const float* kaw = A.in[I_KA] + layer * RW; const float* rk = A.in[I_RK] + layer * RW;
    const float lam_init = 0.8f - 0.6f * expf(-0.3f * (float)layer);
    const float s1 = wave_sum(A.in[I_LQ1][layer * 64 + l] * A.in[I_LK1][layer * 64 + l]), s2 = wave_sum(A.in[I_LQ2][layer * 64 + l] * A.in[I_LK2][layer * 64 + l]);
    const float lam = expf(s1) - expf(s2) + lam_init;
    const int sub = l & 15, hg = l >> 4;
    const f32x4 sg0 = *(const f32x4*)(A.in[I_SUBLN] + layer * 128 + sub * 8) * (1.f - lam_init), sg1 = *(const f32x4*)(A.in[I_SUBLN] + layer * 128 + sub * 8 + 4) * (1.f - lam_init);
    for (int m = F.gw; m < nrows; m += F.ngw) {
        const size_t ro = (size_t)m * RW;
#pragma unroll
        for (int it = 0; it < 3; ++it) { const int c = (it * 4 + hg) * 64 + sub * 4;
            const f32x4 y = *(const f32x4*)(YS0 + ro + c) + *(const f32x4*)(YS1 + ro + c);
            const f32x4 a0 = unpack4(*(const u32x2*)(AS0 + ro + c)), a1 = unpack4(*(const u32x2*)(AS1 + ro + c)), k = unpack4(*(const u32x2*)(K + ro + c)),
                        r = unpack4(*(const u32x2*)(R + ro + c)), v = unpack4(*(const u32x2*)(V + ro + c)), g = unpack4(*(const u32x2*)(G + ro + c));
            const f32x4 w4 = *(const f32x4*)(lnw + c), b4 = *(const f32x4*)(lnb + c), ka4 = *(const f32x4*)(kaw + c), rk4 = *(const f32x4*)(rk + c);
            const float mean = row16_sum((y.x + y.y) + (y.z + y.w)) * (1.f / 64.f);
            const f32x4 d = y - mean;
            const float var = row16_sum((d.x * d.x + d.y * d.y) + (d.z * d.z + d.w * d.w)) * (1.f / 64.f);
            const f32x4 yn = d * rsqrtf(var + 64e-5f) * w4 + b4;
            const f32x4 kd = k * ((a0 + a1 - 2.f) * ka4 + 2.f);
            const f32x4 pr = r * kd * rk4;
            const float bs = row16_sum((pr.x + pr.y) + (pr.z + pr.w));
            *(u32x2*)(YR + ro + c) = pack4((yn + v * bs) * g); }
#pragma unroll
        for (int ps = 0; ps < 2; ++ps) { const int head = ps * 4 + hg;
            if (head < 6) { const int c = head * 128 + sub * 8;
                float pa_[8], pb_[8]; unpack8(*(const u32x4*)(OD0 + ro + c), pa_); unpack8(*(const u32x4*)(OD1 + ro + c), pb_);
                const f32x4 o0 = (f32x4){pa_[0], pa_[1], pa_[2], pa_[3]} - (f32x4){pb_[0], pb_[1], pb_[2], pb_[3]} * lam, o1 = (f32x4){pa_[4], pa_[5], pa_[6], pa_[7]} - (f32x4){pb_[4], pb_[5], pb_[6], pb_[7]} * lam;
                const float ss = row16_sum(((o0.x * o0.x + o0.y * o0.y) + (o0.z * o0.z + o0.w * o0.w)) + ((o1.x * o1.x + o1.y * o1.y) + (o1.z * o1.z + o1.w * o1.w)));
                const float rs = rsqrtf(ss * (1.f / 128.f) + 1e-5f);
                const f32x4 r0 = o0 * rs * sg0, r1 = o1 * rs * sg1;
                u32x4 w; w.x = cvt_pk_bf16(r0.x, r0.y); w.y = cvt_pk_bf16(r0.z, r0.w); w.z = cvt_pk_bf16(r1.x, r1.y); w.w = cvt_pk_bf16(r1.z, r1.w);
                *(u32x4*)(YD + ro + c) = w; } }
    }
}
__device__ __forceinline__ void conv_act(const Frame& F, int layer, int nrows) {
    const Args& A = *F.a;
    const bf16_t* U = (const bf16_t*)(F.ws + A_U); bf16_t* ACT = (bf16_t*)(F.ws + A_ACT);
    const float* cw = A.in[I_CW] + (size_t)layer * 3 * FF2; const float* cbias = A.in[I_CB] + (size_t)layer * FF2;
    constexpr int NCK = FF / 8;
    const int nitems = (nrows / 16) * NCK;
    for (int it = blockIdx.x * NTHREADS + F.tid; it < nitems; it += gridDim.x * NTHREADS) {
        const int rg = it / NCK, ck = it % NCK, r0 = rg * 16, c = ck * 8;
        const bool lat = r0 < TL; const int t0 = lat ? (r0 & 4095) : ((r0 - TL) & 255), len = lat ? SEQ : CTX;
        float wv[3][8], wg[3][8], bv[8], bg[8];
#pragma unroll
        for (int e = 0; e < 8; ++e) { bv[e] = cbias[c + e]; bg[e] = cbias[FF + c + e];
#pragma unroll
            for (int k = 0; k < 3; ++k) { wv[k][e] = cw[(size_t)k * FF2 + c + e]; wg[k][e] = cw[(size_t)k * FF2 + FF + c + e]; } }
        float pv[8], pg[8], cv[8], cg[8], nv[8], ng[8];
        const bf16_t* up = U + (size_t)r0 * FF2 + c;
        if (t0 > 0) { unpack8(*(const u32x4*)(up - FF2), pv); unpack8(*(const u32x4*)(up - FF2 + FF), pg); }
        else {
#pragma unroll
            for (int e = 0; e < 8; ++e) { pv[e] = 0.f; pg[e] = 0.f; } }
        unpack8(*(const u32x4*)(up), cv); unpack8(*(const u32x4*)(up + FF), cg);
#pragma unroll 1
        for (int i = 0; i < 16; ++i) {
            if (t0 + i + 1 < len) { unpack8(*(const u32x4*)(up + (size_t)(i + 1) * FF2), nv); unpack8(*(const u32x4*)(up + (size_t)(i + 1) * FF2 + FF), ng); }
            else {
#pragma unroll
                for (int e = 0; e < 8; ++e) { nv[e] = 0.f; ng[e] = 0.f; } }
            float o[8];
#pragma unroll
            for (int e = 0; e < 8; ++e) { const float a = pv[e] * wv[0][e] + cv[e] * wv[1][e] + nv[e] * wv[2][e] + bv[e]; const float g = pg[e] * wg[0][e] + cg[e] * wg[1][e] + ng[e] * wg[2][e] + bg[e];
                o[e] = a * g * sigmoidf_(g); pv[e] = cv[e]; pg[e] = cg[e]; cv[e] = nv[e]; cg[e] = ng[e]; }
            *(u32x4*)(ACT + (size_t)(r0 + i) * FF + c) = pack8(o);
        }
    }
}

enum { S_INIT = 0, S_NORM1, S_IN, S_PREP, S_LR, S_VRES, S_MIX, S_POST, S_GATE, S_MERGE, S_OUT, S_NORM2, S_UP, S_CONV, S_DOWN, S_NEXT, S_FINAL };
constexpr int NPH = 28;
__host__ __device__ inline int phase_code(int p) {
    if (p < 2) return p;
    if (p < 15) { const int s = p - 2; return (s < 3 ? S_IN + s : S_MIX + (s - 3)); }
    { const int s = p - 15; return 256 | (s < 3 ? S_IN + s : S_MIX + (s - 3)); }
}

#ifndef PROBE_MASK
#define PROBE_MASK 0
#endif
__host__ __device__ inline int stage_of_phase(int b) { int code = phase_code(b); int st = code & 255; if ((code >> 8) == 1 && st == S_NEXT) st = S_FINAL; return st; }
__host__ __device__ inline int expand_phase(int p, int& rep) {
    if (PROBE_MASK == 0) { rep = 0; return p; }
    int q = 0;
    for (int b = 0; b < NPH; ++b) { const int n = ((PROBE_MASK >> stage_of_phase(b)) & 1) ? 2 : 1; if (p < q + n) { rep = p - q; return b; } q += n; }
    rep = 0; return NPH - 1;
}
__global__ void __launch_bounds__(NTHREADS, 2) mega_fwd(Args args) {
    extern __shared__ __attribute__((aligned(16))) unsigned char lds_raw[];
    const Args& A = args;
    volatile LAS unsigned* MISC = (volatile LAS unsigned*)((LAS unsigned char*)lds_raw + MISC_OFF);
    if (threadIdx.x < 32) MISC[threadIdx.x] = 0u;
    __syncthreads();
    if ((threadIdx.x & 63) == 0) MISC[16 + (threadIdx.x >> 6)] = (unsigned)__builtin_amdgcn_s_getreg((1 << 11) | (4 << 6) | 4) & 3u;
    __syncthreads();
    if (threadIdx.x == 0) {
        unsigned seen = 0u, nr = 0u;
        for (int w = 0; w < 8; ++w) { const unsigned sd = MISC[16 + w]; if (!((seen >> sd) & 1u) && nr < 4u) { seen |= 1u << sd; MISC[24 + w] = nr++; } else MISC[24 + w] = 0xFFFFFFFFu; }
        for (int w = 0; w < 8; ++w) if (MISC[24 + w] == 0xFFFFFFFFu && nr < 4u) MISC[24 + w] = nr++;
    }
    __syncthreads();
    XcdBarrier bar; bar.bar = (unsigned*)(args.ws + O_CTL) + 4096; bar.x = 0; bar.st = nullptr;
    if (args.ph_hi - args.ph_lo > 1) bar = xcd_barrier_post((unsigned*)(args.ws + O_CTL) + 4096, MISC + 8);
    for (int p = args.ph_lo; p < args.ph_hi; ++p) {
        int rep = 0; int code = phase_code(expand_phase(p, rep)); const int layer = code >> 8; int st = code & 255;
        if (layer == 1 && st == S_NEXT) st = S_FINAL;
        const bool last = layer == 1;
        const int Mrows = last ? TL : TT;
        const int tid_ = lthread();
        size_t zoff_ = 0; asm volatile("" : "+s"(zoff_)); unsigned char* ws_ = args.ws + zoff_;
        Frame F; F.a = &args; F.ws = ws_; F.lds = (char*)lds_raw; F.tid = tid_; F.lane = F.tid & 63; F.wave = __builtin_amdgcn_readfirstlane(F.tid >> 6);
        F.gw = blockIdx.x * NWAVES + F.wave; F.ngw = gridDim.x * NWAVES;
        float* XC = (float*)(F.ws + O_XC);
        const float* MODB = (const float*)(F.ws + O_MOD);
        const float* mod = MODB + (size_t)layer * 5 * MODW;
        int njobs = 0;
        switch (st) {
        case S_INIT: adaln(F); convert_weights(F, 0); break;
        case S_NORM1: norm_rows(F, A.in[I_X], A.in[I_CTX], A.in[I_NORM1], mod, 0, 2048, TT); break;
        case S_PREP: rwkv_prep(F, layer); qk_prep(F, layer); break;
        case S_MIX: ph_mix(F, layer, rep); break;
        case S_POST: ph_post(F, layer); break;
        case S_NORM2: norm_rows(F, A.out, XC, A.in[I_NORM2] + layer * DM, mod, 3 * 2048, 4 * 2048, Mrows); break;
        case S_CONV: conv_act(F, layer, Mrows); break;
        case S_NEXT: convert_weights(F, 1); norm_rows(F, A.out, XC, A.in[I_NORM1] + DM, MODB + (size_t)5 * MODW, 0, 2048, TT); break;
        case S_FINAL: final_norm(F); break;
        case S_LR: njobs = layer == 1 ? 2 : 1; break;
        case S_MERGE: njobs = 3; break;
        default: njobs = 1; break;
        }
        for (int j = 0; j < njobs; ++j) {
            pg8::Gemm g; Epi e{}; e.ws = F.ws; e.layer = layer;
            switch (st) {
            case S_IN: e.mode = EM_ROUTE; g = pg8::Gemm{(const bf16_t*)(F.ws + O_H), (const bf16_t*)(F.ws + W_IN), TT, 6144, 2048}; break;
            case S_LR:
                if (j == 0) { e.mode = EM_LR; e.p0 = A.in[I_W0] + layer * 2 * RW; e.p1 = A.in[I_A0] + layer * 2 * RW; g = pg8::Gemm{(const bf16_t*)(F.ws + A_LR), (const bf16_t*)(F.ws + W_LR), TT, 3840, 256}; }
                else { e.mode = EM_VRES; e.p0 = A.in[I_V0]; g = pg8::Gemm{(const bf16_t*)(F.ws + A_YS), (const bf16_t*)(F.ws + W_V12), TT, 768, 768}; }
                break;
            case S_GATE: e.mode = EM_SIGMOID; e.O = (bf16_t*)(F.ws + A_GATES); e.ldc = 6144;
                g = pg8::Gemm{(const bf16_t*)(F.ws + O_H), (const bf16_t*)(F.ws + W_IN) + (size_t)6144 * 2048, Mrows, 6144, 2048}; break;
            case S_MERGE: e.mode = EM_MERGE; e.aux = j;
                g = pg8::Gemm{(const bf16_t*)(F.ws + (j == 0 ? A_YR : (j == 1 ? A_YG : A_YD))), (const bf16_t*)(F.ws + W_BR) + (size_t)j * 2048 * 768, Mrows, 2048, 768}; break;
            case S_OUT: e.mode = EM_RESID; e.aux = 2 * 2048; e.gmod = mod;
                e.xin_l = layer == 0 ? A.in[I_X] : A.out; e.xin_c = layer == 0 ? A.in[I_CTX] : XC; e.xout_l = A.out; e.xout_c = XC;
                g = pg8::Gemm{(const bf16_t*)(F.ws + O_H), (const bf16_t*)(F.ws + W_OUT), Mrows, 2048, 2048}; break;
            case S_UP: e.mode = EM_BF16; e.O = (bf16_t*)(F.ws + A_U); e.ldc = FF2;
                g = pg8::Gemm{(const bf16_t*)(F.ws + O_H), (const bf16_t*)(F.ws + W_UP), Mrows, FF2, 2048}; break;
            default: e.mode = EM_RESID; e.aux = 5 * 2048; e.gmod = mod; e.xin_l = A.out; e.xin_c = XC; e.xout_l = A.out; e.xout_c = XC;
                g = pg8::Gemm{(const bf16_t*)(F.ws + A_ACT), (const bf16_t*)(F.ws + W_DOWN), Mrows, 2048, FF}; break;
            }
            pg8::StaticOrder S; S.init(g.M, g.N, (int)gridDim.x, (int)blockIdx.x);
            pg8::gemm_phase<Epi, pg8::StaticOrder, true, true>((LAS unsigned char*)lds_raw, g, S, e);
            __syncthreads();
        }
        if (p + 1 < args.ph_hi) { if (args.ph_hi > 1000) { __threadfence(); cg::this_grid().sync(); }
            xcd_barrier(bar); }
    }
}

extern "C" void kernel_launch(void* const* d_in, const int* in_sizes, int n_in, void* d_out, int out_size, void* d_ws, size_t ws_size, hipStream_t stream) {
    static int grid = 0;
    if (grid == 0) {
        if (n_in != N_IN || out_size != TL * DM || ws_size < WS_NEED) { fprintf(stderr, "kernel_launch: unexpected shapes n_in %d out %d ws %zu (need %zu)\n", n_in, out_size, ws_size, (size_t)WS_NEED); grid = -1; return; }
        int dev = 0, cus = 0, per_cu = 0;
        hipGetDevice(&dev); hipDeviceGetAttribute(&cus, hipDeviceAttributeMultiprocessorCount, dev);
        if (hipFuncSetAttribute((const void*)mega_fwd, hipFuncAttributeMaxDynamicSharedMemorySize, LDS_BYTES) != hipSuccess) { fprintf(stderr, "kernel_launch: hipFuncSetAttribute failed\n"); grid = -1; return; }
        hipOccupancyMaxActiveBlocksPerMultiprocessor(&per_cu, (const void*)mega_fwd, NTHREADS, LDS_BYTES);
        (void)hipGetLastError();
        if (per_cu < 1) { fprintf(stderr, "kernel_launch: occupancy query says %d blocks/CU\n", per_cu); per_cu = 1; }
        grid = cus;
        if (grid > 256) grid = 256;
    }
    if (grid < 0) return;
    hipMemsetAsync((char*)d_ws + O_CTL, 0, CTL_BYTES, stream);
    Args a{};
    for (int i = 0; i < N_IN; ++i) a.in[i] = (const float*)d_in[i];
    a.out = (float*)d_out; a.ws = (unsigned char*)d_ws;
#if MK_ONE_LAUNCH
    { int nph = 0; for (int b = 0; b < NPH; ++b) nph += ((PROBE_MASK >> stage_of_phase(b)) & 1) ? 2 : 1; a.ph_lo = 0; a.ph_hi = nph; }
    void* kargs[] = {&a};
    hipError_t e = hipLaunchCooperativeKernel((const void*)mega_fwd, dim3(grid), dim3(NTHREADS), kargs, LDS_BYTES, stream);
    if (e != hipSuccess) fprintf(stderr, "kernel_launch: cooperative launch failed: %s\n", hipGetErrorString(e));
#else
    for (int p = 0; p < NPH; ++p) { a.ph_lo = p; a.ph_hi = p + 1; hipLaunchKernelGGL(mega_fwd, dim3(grid), dim3(NTHREADS), LDS_BYTES, stream, a); }
#endif
}
```

```cpp
#include <hip/hip_runtime.h>
#include <hip/hip_cooperative_groups.h>
#include <cstdio>
#include <cstdint>
namespace cg = cooperative_groups;
#ifndef MK_ONE_LAUNCH
#define MK_ONE_LAUNCH 1
#endif
__device__ __forceinline__ int lthread() { int t = threadIdx.x; asm volatile("" : "+v"(t)); return t; }
namespace pg8 {
#define PG8_LAS __attribute__((address_space(3)))
typedef unsigned short bf16_t;
typedef short bf16x8 __attribute__((ext_vector_type(8)));
typedef float f32x4 __attribute__((ext_vector_type(4)));
typedef unsigned u32x4 __attribute__((ext_vector_type(4)));
constexpr int BM = 256, BK = 64, HALF = 128, HTB = HALF * BK * 2  , STAGE_BYTES = 8 * HTB, NXCD = 8, WGM = 8;

__host__ __device__ __forceinline__ int lds_byte(int r, int c) { const int st = (r >> 4) * 2 + (c >> 5), rr = r & 15, cc = c & 31, ob = rr * 64 + cc * 2; return st * 1024 + (ob ^ (((ob >> 9) & 1) << 5)); }
__host__ __device__ __forceinline__ void stage_rc(int b, int& R, int& C) { const int st = b / 1024, sb = b % 1024, swz = sb ^ (((sb >> 9) & 1) << 5); R = (st >> 1) * 16 + swz / 64; C = (st & 1) * 32 + (swz % 64) / 2; }
__host__ __device__ __forceinline__ int perm32(int rho) { const int n = rho >> 4, i = rho & 15; return 8 * (i >> 2) + 4 * n + (i & 3); }

struct Unit { int pm, pn; };
struct Gemm { const bf16_t* A; const bf16_t* Bt; int M, N, K; };

struct StaticOrder {
    int nM, nN, nwg, G, c;
    __host__ __device__ void init(int M, int N, int G_, int c_) { nM = M / BM; nN = N / BM; nwg = nM * nN; G = G_; c = c_; }
    __host__ __device__ bool next(int i, Unit& u) const {
        const long L = (long)i * G + c; if (L >= nwg) return false;
        int wgid = (int)L; { const int q = nwg / NXCD, r = nwg % NXCD, xcd = wgid % NXCD, off = wgid / NXCD; wgid = (xcd < r ? xcd * (q + 1) : r * (q + 1) + (xcd - r) * q) + off; }
        const int nig = WGM * nN, gid = wgid / nig, fm = gid * WGM, gsz = (nM - fm) < WGM ? (nM - fm) : WGM;
        u.pm = fm + ((wgid % nig) % gsz); u.pn = (wgid % nig) / gsz; return true;
    }
    __device__ __forceinline__ void a_ready(const Unit&) const {}
    __device__ __forceinline__ void done(const Unit&) const {}
};

template <class Epi, class Sched, bool ALIGN_EPI = false, bool SP2 = false>
__device__ __forceinline__ void gemm_phase(PG8_LAS unsigned char* lds, const Gemm g, const Sched& S, const Epi& E) {
    const int tid = lthread(), wid = __builtin_amdgcn_readfirstlane(tid >> 6), lane = tid & 63, wr = wid >> 2, wc = wid & 3, fr = lane & 15, fq = lane >> 4;
    const int K = g.K, nt = K / BK;
    unsigned voffA[2], voffB[2];
#pragma unroll
    for (int i = 0; i < 2; ++i) { int R, C; stage_rc(tid * 16 + i * 8192, R, C); const int Rb = Epi::PERM ? ((R & ~31) + perm32(R & 31)) : R;
        voffA[i] = (unsigned)(R * K + C) * 2u; voffB[i] = (unsigned)(Rb * K + C) * 2u; }
    const size_t kstep = (size_t)(BK * 2);
    const size_t hstep = (size_t)HALF * K * 2;
    const size_t tstep = 2 * hstep;
    const unsigned ldsw = (unsigned)wid * 1024u;
    const int aoff = lds_byte(wr * 64 + fr, fq * 8), boff = lds_byte(wc * 32 + fr, fq * 8);
#define PG8_SA(b, h) (((b) * 2 + (h)) * HTB)
#define PG8_SB(b, h) ((4 + (b) * 2 + (h)) * HTB)
#define PG8_STAGE(bufoff, gbase, voff) do { _Pragma("unroll") for (int _i = 0; _i < 2; ++_i) \
        __builtin_amdgcn_global_load_lds((const unsigned*)((const char*)(gbase) + (voff)[_i]), (PG8_LAS unsigned*)(lds + (bufoff) + ldsw + _i * 8192), 16, 0, 0); } while (0)
#define PG8_LDA(dst, b, h) do { _Pragma("unroll") for (int m = 0; m < 4; ++m) _Pragma("unroll") for (int k = 0; k < 2; ++k) dst[m][k] = *(const PG8_LAS bf16x8*)(lds + PG8_SA(b, h) + aoff + m * 2048 + k * 1024); } while (0)
#define PG8_LDB(dst, b, h) do { _Pragma("unroll") for (int n = 0; n < 2; ++n) _Pragma("unroll") for (int k = 0; k < 2; ++k) dst[n][k] = *(const PG8_LAS bf16x8*)(lds + PG8_SB(b, h) + boff + n * 2048 + k * 1024); } while (0)
#define PG8_MMA(ai, bj, At, Bt) do { __builtin_amdgcn_s_setprio(1); _Pragma("unroll") for (int m = 0; m < 4; ++m) _Pragma("unroll") for (int n = 0; n < 2; ++n) _Pragma("unroll") for (int k = 0; k < 2; ++k) \
        acc[ai][bj][m][n] = __builtin_amdgcn_mfma_f32_16x16x32_bf16(Bt[n][k], At[m][k], acc[ai][bj][m][n], 0, 0, 0); __builtin_amdgcn_s_setprio(0); } while (0)
#define PG8_WAIT_V(n) asm volatile("s_waitcnt vmcnt(" #n ")" ::: "memory")
#define PG8_WAIT_L(n) asm volatile("s_waitcnt lgkmcnt(" #n ")" ::: "memory")
#define PG8_BAR __builtin_amdgcn_s_barrier()
#define PG8_SCHED __builtin_amdgcn_sched_barrier(0)
    Unit cur, nxt; int ui = 0;
    if (!S.next(0, cur)) return;
    f32x4 acc[2][2][4][2];
#pragma unroll
    for (int a = 0; a < 2; ++a)
#pragma unroll
        for (int b = 0; b < 2; ++b)
#pragma unroll
            for (int m = 0; m < 4; ++m)
#pragma unroll
                for (int n = 0; n < 2; ++n) acc[a][b][m][n] = (f32x4){0.f, 0.f, 0.f, 0.f};
    bf16x8 At[4][2], B0[2][2], B1[2][2];
    const char* cA = (const char*)g.A + (size_t)cur.pm * tstep; const char* cB = (const char*)g.Bt + (size_t)cur.pn * tstep;
    S.a_ready(cur);
    if constexpr (SP2) {
        PG8_STAGE(PG8_SB(0, 0), cB, voffB); PG8_STAGE(PG8_SB(0, 1), cB + hstep, voffB); PG8_STAGE(PG8_SA(0, 0), cA, voffA); PG8_STAGE(PG8_SA(0, 1), cA + hstep, voffA);
        if (wr == 1) PG8_BAR;
        PG8_WAIT_V(2); PG8_BAR;
        PG8_STAGE(PG8_SB(1, 0), cB + kstep, voffB); PG8_STAGE(PG8_SA(1, 0), cA + kstep, voffA); PG8_STAGE(PG8_SB(1, 1), cB + hstep + kstep, voffB);
        PG8_WAIT_V(6); PG8_BAR;
    } else {
        PG8_STAGE(PG8_SB(0, 0), cB, voffB); PG8_STAGE(PG8_SA(0, 0), cA, voffA); PG8_STAGE(PG8_SB(0, 1), cB + hstep, voffB); PG8_STAGE(PG8_SA(0, 1), cA + hstep, voffA);
        if (wr == 1) PG8_BAR;
        PG8_WAIT_V(4); PG8_BAR;
        PG8_STAGE(PG8_SB(1, 0), cB + kstep, voffB); PG8_STAGE(PG8_SA(1, 0), cA + kstep, voffA); PG8_STAGE(PG8_SB(1, 1), cB + hstep + kstep, voffB);
        PG8_WAIT_V(6); PG8_BAR;
    }
    for (;;) {
        const bool has_next = S.next(ui + 1, nxt);
        const char* nA = has_next ? (const char*)g.A + (size_t)nxt.pm * tstep : cA; const char* nB = has_next ? (const char*)g.Bt + (size_t)nxt.pn * tstep : cB;
        for (int t = 0; t < nt; t += 2) {
            const bool last = (t == nt - 2);
            const char* a1 = cA + (size_t)(t + 1) * kstep;
            const char* a2 = last ? nA : cA + (size_t)(t + 2) * kstep; const char* b2 = last ? nB : cB + (size_t)(t + 2) * kstep;
            const char* a3 = a2 + kstep; const char* b3 = b2 + kstep;
            if (last && has_next) S.a_ready(nxt);
            if constexpr (SP2) {
            PG8_LDB(B0, 0, 0); PG8_LDB(B1, 0, 1); PG8_SCHED; PG8_LDA(At, 0, 0); PG8_STAGE(PG8_SA(1, 1), a1 + hstep, voffA);
            PG8_WAIT_V(8); PG8_WAIT_L(0); PG8_BAR; PG8_MMA(0, 0, At, B0); PG8_MMA(0, 1, At, B1); PG8_BAR; PG8_SCHED;
            PG8_LDA(At, 0, 1); PG8_STAGE(PG8_SB(0, 0), b2, voffB); PG8_STAGE(PG8_SB(0, 1), b2 + hstep, voffB); PG8_STAGE(PG8_SA(0, 0), a2, voffA);
            PG8_WAIT_V(8); PG8_WAIT_L(0); PG8_BAR; PG8_MMA(1, 0, At, B0); PG8_MMA(1, 1, At, B1); PG8_BAR; PG8_SCHED;
            PG8_LDB(B0, 1, 0); PG8_LDB(B1, 1, 1); PG8_SCHED; PG8_LDA(At, 1, 0); PG8_STAGE(PG8_SA(0, 1), a2 + hstep, voffA);
            PG8_WAIT_V(8); PG8_WAIT_L(0); PG8_BAR; PG8_MMA(0, 0, At, B0); PG8_MMA(0, 1, At, B1); PG8_BAR; PG8_SCHED;
            PG8_LDA(At, 1, 1); PG8_STAGE(PG8_SB(1, 0), b3, voffB); PG8_STAGE(PG8_SB(1, 1), b3 + hstep, voffB); PG8_STAGE(PG8_SA(1, 0), a3, voffA);
            PG8_WAIT_V(8); PG8_WAIT_L(0); PG8_BAR; PG8_MMA(1, 0, At, B0); PG8_MMA(1, 1, At, B1); PG8_BAR; PG8_SCHED;
            } else {
            PG8_LDB(B0, 0, 0); PG8_SCHED; PG8_LDA(At, 0, 0); PG8_STAGE(PG8_SA(1, 1), a1 + hstep, voffA);
            PG8_WAIT_L(8); PG8_BAR; PG8_WAIT_L(0); PG8_MMA(0, 0, At, B0); PG8_BAR; PG8_SCHED;
            PG8_LDB(B1, 0, 1); PG8_STAGE(PG8_SB(0, 0), b2, voffB);
            PG8_BAR; PG8_WAIT_L(0); PG8_MMA(0, 1, At, B1); PG8_BAR;
            PG8_LDA(At, 0, 1); PG8_STAGE(PG8_SA(0, 0), a2, voffA);
            PG8_BAR; PG8_WAIT_L(0); PG8_MMA(1, 0, At, B0); PG8_BAR; PG8_SCHED;
            PG8_STAGE(PG8_SB(0, 1), b2 + hstep, voffB);
            PG8_WAIT_V(6); PG8_BAR; PG8_MMA(1, 1, At, B1); PG8_BAR;
            PG8_LDB(B0, 1, 0); PG8_SCHED; PG8_LDA(At, 1, 0); PG8_STAGE(PG8_SA(0, 1), a2 + hstep, voffA);
            PG8_WAIT_L(8); PG8_BAR; PG8_WAIT_L(0); PG8_MMA(0, 0, At, B0); PG8_BAR; PG8_SCHED;
            PG8_LDB(B1, 1, 1); PG8_STAGE(PG8_SB(1, 0), b3, voffB);
            PG8_BAR; PG8_WAIT_L(0); PG8_MMA(0, 1, At, B1); PG8_BAR;
            PG8_LDA(At, 1, 1); PG8_STAGE(PG8_SA(1, 0), a3, voffA);
            PG8_BAR; PG8_WAIT_L(0); PG8_MMA(1, 0, At, B0); PG8_BAR; PG8_SCHED;
            PG8_STAGE(PG8_SB(1, 1), b3 + hstep, voffB);
            PG8_WAIT_V(6); PG8_BAR; PG8_MMA(1, 1, At, B1); PG8_BAR;
            }
        }
        if constexpr (ALIGN_EPI) { if (wr == 0) PG8_BAR; }
        if constexpr (!Epi::AFTER_DRAIN) { E(acc, cur, wr, wc, fr, fq); S.done(cur); }
        if (!has_next) break;
#pragma unroll
        for (int a = 0; a < 2; ++a)
#pragma unroll
            for (int b = 0; b < 2; ++b)
#pragma unroll
                for (int m = 0; m < 4; ++m)
#pragma unroll
                    for (int n = 0; n < 2; ++n) acc[a][b][m][n] = (f32x4){0.f, 0.f, 0.f, 0.f};
        cur = nxt; cA = nA; cB = nB; ++ui;
        if constexpr (ALIGN_EPI) { if (wr == 1) PG8_BAR; }
    }
    PG8_WAIT_V(0);
    if constexpr (!ALIGN_EPI) { if (wr == 0) PG8_BAR; }
    PG8_BAR;
    if constexpr (Epi::AFTER_DRAIN) { E.fused(acc, cur, wr, wc, fr, fq, lds, wid, lane); S.done(cur); }
#undef PG8_SA
#undef PG8_SB
#undef PG8_STAGE
#undef PG8_LDA
#undef PG8_LDB
#undef PG8_MMA
#undef PG8_WAIT_V
#undef PG8_WAIT_L
#undef PG8_BAR
#undef PG8_SCHED
}
}

#define LAS __attribute__((address_space(3)))
typedef unsigned short bf16_t;
typedef float f32x4 __attribute__((ext_vector_type(4)));
typedef float f32x2 __attribute__((ext_vector_type(2)));
typedef unsigned u32x4 __attribute__((ext_vector_type(4)));
typedef unsigned u32x2 __attribute__((ext_vector_type(2)));
typedef short bf16x8 __attribute__((ext_vector_type(8)));

constexpr int DM = 2048, NB = 4, SEQ = 4096, CTX = 256, TL = NB * SEQ, TC = NB * CTX, TT = TL + TC, KVS = CTX + SEQ;
constexpr int RW = 768, RCOLS = 2560, FF = 5504, FF2 = 11008, MODW = 12288;
constexpr int NTHREADS = 512, NWAVES = 8;

enum { I_X = 0, I_C, I_CTX, I_CCTX, I_WMOD, I_BMOD, I_NORM1, I_WIN, I_MU, I_W0, I_W2, I_A0, I_A2, I_KK, I_KA, I_RK, I_G2, I_LNW, I_LNB,
       I_V0, I_V1, I_V2, I_QN, I_KN, I_LQ1, I_LK1, I_LQ2, I_LK2, I_SUBLN, I_WBR, I_WBG, I_WBD, I_WOUT, I_NORM2, I_UP, I_CW, I_CB, I_DOWN, I_FN, N_IN };

#define XB_TMO      128
#define XB_XCNT(j)  (256  + 64 * (j))
#define XB_XSUB(j)  (1280 + 64 * (j))
#define XB_XGEN(j)  (2304 + 64 * (j))
#define XB_TOP      3328
#define XB_TOPGEN   3392
#define XCD_BAR_WORDS 3456
#define XB_SPIN_CAP (1u << 18)

__device__ __forceinline__ unsigned xb_ld(unsigned* p)              { return __hip_atomic_load(p, __ATOMIC_RELAXED, __HIP_MEMORY_SCOPE_AGENT); }
__device__ __forceinline__ unsigned xb_add(unsigned* p, unsigned v) { return __hip_atomic_fetch_add(p, v, __ATOMIC_RELAXED, __HIP_MEMORY_SCOPE_AGENT); }
__device__ __forceinline__ unsigned xb_xcc_id() { return (unsigned)__builtin_amdgcn_s_getreg((3 << 11) | 20) & 0xFu; }
#define XB_SPIN(cond, bar) do { unsigned _sp = 0; while (cond) { __builtin_amdgcn_s_sleep(1); \
    if ((++_sp & 255u) == 0u) { if (xb_ld(&(bar)[XB_TMO])) break; if (_sp > XB_SPIN_CAP) { atomicAdd(&(bar)[XB_TMO], 1u); break; } } } } while (0)

struct XcdBarrier {
    unsigned* bar; unsigned x;
    volatile LAS unsigned* st;
};

__device__ __forceinline__ XcdBarrier xcd_barrier_post(unsigned* bar, volatile LAS unsigned* st) {
    XcdBarrier b; b.bar = bar; b.x = xb_xcc_id(); b.st = st;
    if (threadIdx.x == 0) (void)xb_add(&bar[XB_XCNT(b.x)], 1u);
    return b;
}
__device__ __forceinline__ void xcd_barrier_complete(unsigned* bar, unsigned x, unsigned& nloc, unsigned& nx) {
    const unsigned G = gridDim.x * gridDim.y * gridDim.z;
    unsigned sum, cnt, mine, sp = 0u;
    for (;;) {
        sum = 0u; cnt = 0u; mine = 0u;
#pragma unroll
        for (unsigned j = 0; j < 16; ++j) { const unsigned c = xb_ld(&bar[XB_XCNT(j)]); sum += c; cnt += (c > 0u) ? 1u : 0u; mine = (j == x) ? c : mine; }
        if (sum == G) break;
        __builtin_amdgcn_s_sleep(1);
        if ((++sp & 255u) == 0u) { if (xb_ld(&bar[XB_TMO])) break; if (sp > XB_SPIN_CAP) { atomicAdd(&bar[XB_TMO], 1u); break; } }
    }
    nloc = mine > 0u ? mine : 1u; nx = cnt > 0u ? cnt : 1u;
}

__device__ __forceinline__ void xcd_barrier(const XcdBarrier& b) {
    asm volatile("s_waitcnt vmcnt(0)" ::: "memory");
    __syncthreads();
    if (threadIdx.x == 0) {
        unsigned* bar = b.bar;
        __builtin_amdgcn_s_waitcnt(0);
        unsigned nloc = b.st[0], nx = b.st[1];
        if (nloc == 0u) { xcd_barrier_complete(bar, b.x, nloc, nx); b.st[0] = nloc; b.st[1] = nx; }
        const unsigned old = xb_add(&bar[XB_XSUB(b.x)], 1u);
        const unsigned gen = old / nloc;
        if (old + 1u == (gen + 1u) * nloc) {
            __builtin_amdgcn_fence(__ATOMIC_RELEASE, "agent");
            asm volatile("s_waitcnt vmcnt(0)" ::: "memory");
            const unsigned og = xb_add(&bar[XB_TOP], 1u);
            const unsigned tg = og / nx;
            if (og + 1u == (tg + 1u) * nx) xb_add(&bar[XB_TOPGEN], 1u);
            else XB_SPIN(xb_ld(&bar[XB_TOPGEN]) == tg, bar);
            __builtin_amdgcn_fence(__ATOMIC_ACQUIRE, "agent");
            xb_add(&bar[XB_XGEN(b.x)], 1u);
            asm volatile("s_waitcnt vmcnt(0)" ::: "memory");
        } else {
            XB_SPIN(xb_ld(&bar[XB_XGEN(b.x)]) == gen, bar);
            __builtin_amdgcn_fence(__ATOMIC_ACQUIRE, "agent");
            asm volatile("s_waitcnt vmcnt(0)" ::: "memory");
        }
    }
    __syncthreads();
}

constexpr size_t MiB = 1u << 20, HMiB = 1u << 19;
constexpr size_t O_CTL = 0, CTL_BYTES = 65536, O_MOD = 1 * MiB, O_XC = 2 * MiB;
constexpr size_t W_IN = 10 * MiB, W_BR = W_IN + 48 * MiB, W_OUT = W_BR + 9 * MiB, W_UP = W_OUT + 8 * MiB, W_DOWN = W_UP + 43 * MiB,
                 W_LR = W_DOWN + 22 * MiB, W_V12 = W_LR + (size_t)3840 * 256 * 2;
constexpr size_t O_H = 143 * MiB, O_VF = 211 * MiB, O_AR = 237 * MiB;
static_assert(W_V12 + (size_t)768 * 768 * 2 == O_H, "weight map");
constexpr size_t A_QG = O_AR, A_KG = O_AR + 51 * HMiB, A_VG = O_AR + 68 * HMiB, A_DQ = O_AR + 85 * HMiB, A_DK = O_AR + 136 * HMiB, A_DV = O_AR + 187 * HMiB;
constexpr size_t A_PR = O_AR + 238 * HMiB, A_EW = A_PR, A_AS = O_AR + 340 * HMiB, A_G = O_AR + 442 * HMiB;
constexpr size_t A_R = O_AR + 493 * HMiB, A_K = O_AR + 544 * HMiB, A_V = O_AR + 595 * HMiB, A_KKN = O_AR + 646 * HMiB;
constexpr size_t A_LR = O_AR + 697 * HMiB, A_T1 = O_AR + 714 * HMiB;
constexpr size_t A_YS = O_AR + 731 * HMiB, A_OD = O_AR + 935 * HMiB, A_YG = O_AR + 1139 * HMiB, A_END1 = O_AR + 1190 * HMiB;
constexpr size_t A_YR = O_AR, A_YD = O_AR + 51 * HMiB, A_GATES = A_PR;
constexpr size_t A_U = O_AR, A_ACT = O_AR + 731 * HMiB;
constexpr size_t WS_NEED = A_END1;
static_assert((size_t)TT * 768 * 2 == 51 * HMiB && (size_t)TT * 2048 * 2 == 68 * MiB && (size_t)TT * FF2 * 2 == 731 * HMiB, "sizes");
static_assert(A_ACT + (size_t)TT * FF * 2 <= A_END1 && A_GATES + (size_t)TT * 6144 * 2 <= A_KKN, "overlays");

__device__ __forceinline__ float bf2f(unsigned v) { return __uint_as_float(v << 16); }
__device__ __forceinline__ unsigned cvt_pk_bf16(float lo, float hi) { unsigned r; asm volatile("v_cvt_pk_bf16_f32 %0, %1, %2" : "=v"(r) : "v"(lo), "v"(hi)); return r; }
__device__ __forceinline__ unsigned f2bf(float f) { return cvt_pk_bf16(f, 0.f) & 0xffffu; }
__device__ __forceinline__ float wave_sum(float v) {
    v += __int_as_float(__builtin_amdgcn_update_dpp(0, __float_as_int(v), 0xB1, 0xF, 0xF, true));
    v += __int_as_float(__builtin_amdgcn_update_dpp(0, __float_as_int(v), 0x4E, 0xF, 0xF, true));
    v += __int_as_float(__builtin_amdgcn_update_dpp(0, __float_as_int(v), 0x141, 0xF, 0xF, true));
    v += __int_as_float(__builtin_amdgcn_update_dpp(0, __float_as_int(v), 0x140, 0xF, 0xF, true));
    { auto r16 = __builtin_amdgcn_permlane16_swap(__float_as_uint(v), __float_as_uint(v), false, false); v = __uint_as_float(r16[0]) + __uint_as_float(r16[1]); }
    { auto r32 = __builtin_amdgcn_permlane32_swap(__float_as_uint(v), __float_as_uint(v), false, false); v = __uint_as_float(r32[0]) + __uint_as_float(r32[1]); }
    return v;
}
__device__ __forceinline__ float sigmoidf_(float x) { return 1.f / (1.f + __expf(-x)); }
__device__ __forceinline__ void unpack8(u32x4 w, float* f) {
    f[0] = bf2f(w.x & 0xffffu); f[1] = __uint_as_float(w.x & 0xffff0000u); f[2] = bf2f(w.y & 0xffffu); f[3] = __uint_as_float(w.y & 0xffff0000u);
    f[4] = bf2f(w.z & 0xffffu); f[5] = __uint_as_float(w.z & 0xffff0000u); f[6] = bf2f(w.w & 0xffffu); f[7] = __uint_as_float(w.w & 0xffff0000u);
}
__device__ __forceinline__ u32x4 pack8(const float* f) { u32x4 w; w.x = cvt_pk_bf16(f[0], f[1]); w.y = cvt_pk_bf16(f[2], f[3]); w.z = cvt_pk_bf16(f[4], f[5]); w.w = cvt_pk_bf16(f[6], f[7]); return w; }

enum { EM_ROUTE = 0, EM_BF16, EM_SIGMOID, EM_LR, EM_VRES, EM_MERGE, EM_RESID };
struct Epi {
    static constexpr bool PERM = true, AFTER_DRAIN = false;
    int mode, ldc, aux, layer;
    unsigned char* ws; bf16_t* O; const float* p0; const float* p1;
    const float* xin_l; const float* xin_c; float* xout_l; float* xout_c; const float* gmod;
    __device__ __forceinline__ void operator()(const f32x4 (&acc)[2][2][4][2], const pg8::Unit& u, int wr, int wc, int fr, int fq) const {
        int fr_ = fr, fq_ = fq; asm volatile("" : "+v"(fr_), "+v"(fq_));
        size_t zoff_ = 0; asm volatile("" : "+s"(zoff_)); unsigned char* ws = this->ws + zoff_;
        const int rt = wr * 64 + fr_, ct = wc * 32 + 8 * fq_;
        if (mode == EM_ROUTE) {
            const int pn = u.pn, pm = u.pm;
            const int kvrow = pm < 64 ? ((pm >> 4) * KVS + CTX + (pm & 15) * 256) : ((pm - 64) * KVS);
            const int nat = pm * 256;
            size_t off; int ld, rowbase, colb;
            if (pn < 10) { off = A_PR; ld = 2560; rowbase = nat; colb = pn * 256; }
            else if (pn < 13) { off = A_QG; ld = 768; rowbase = nat; colb = (pn - 10) * 256; }
            else if (pn == 13) { off = A_KG; ld = 256; rowbase = kvrow; colb = 0; }
            else if (pn == 14) { off = A_VG; ld = 256; rowbase = kvrow; colb = 0; }
            else if (pn < 18) { off = A_DQ; ld = 768; rowbase = nat; colb = (pn - 15) * 256; }
            else if (pn < 21) { off = A_DK; ld = 768; rowbase = kvrow; colb = (pn - 18) * 256; }
            else { off = A_DV; ld = 768; rowbase = kvrow; colb = (pn - 21) * 256; }
            bf16_t* base = (bf16_t*)(ws + off) + (size_t)(rowbase + rt) * ld + colb + ct;
#pragma unroll
            for (int ai = 0; ai < 2; ++ai)
#pragma unroll
                for (int m = 0; m < 4; ++m) { bf16_t* rp = base + (size_t)(ai * 128 + m * 16) * ld;
#pragma unroll
                    for (int bj = 0; bj < 2; ++bj) { const f32x4 v0 = acc[ai][bj][m][0], v1 = acc[ai][bj][m][1]; u32x4 w;
                        w.x = cvt_pk_bf16(v0[0], v0[1]); w.y = cvt_pk_bf16(v0[2], v0[3]); w.z = cvt_pk_bf16(v1[0], v1[1]); w.w = cvt_pk_bf16(v1[2], v1[3]);
                        *(u32x4*)(rp + bj * 128) = w; } }
        } else if (mode == EM_BF16 || mode == EM_SIGMOID) {
            bf16_t* base = O + (size_t)(u.pm * 256 + rt) * ldc + u.pn * 256 + ct;
            const bool sg = mode == EM_SIGMOID;
#pragma unroll
            for (int ai = 0; ai < 2; ++ai)
#pragma unroll
                for (int m = 0; m < 4; ++m) { bf16_t* rp = base + (size_t)(ai * 128 + m * 16) * ldc;
#pragma unroll
                    for (int bj = 0; bj < 2; ++bj) { f32x4 v0 = acc[ai][bj][m][0], v1 = acc[ai][bj][m][1];
                        if (sg) {
#pragma unroll
                            for (int e = 0; e < 4; ++e) { v0[e] = sigmoidf_(v0[e]); v1[e] = sigmoidf_(v1[e]); } }
                        u32x4 w; w.x = cvt_pk_bf16(v0[0], v0[1]); w.y = cvt_pk_bf16(v0[2], v0[3]); w.z = cvt_pk_bf16(v1[0], v1[1]); w.w = cvt_pk_bf16(v1[2], v1[3]);
                        *(u32x4*)(rp + bj * 128) = w; } }
        } else if (mode == EM_LR) {
            const int seg = u.pn / 3, c768 = (u.pn % 3) * 256 + ct;
            const float* par = seg < 2 ? (p0 + seg * 768) : (seg < 4 ? (p1 + (seg - 2) * 768) : nullptr);
            bf16_t* base = (bf16_t*)(ws + (seg < 2 ? A_EW + (size_t)seg * TT * 768 * 2 : (seg < 4 ? A_AS + (size_t)(seg - 2) * TT * 768 * 2 : A_G))) + (size_t)(u.pm * 256 + rt) * 768 + c768;
            const float mul = seg < 2 ? 0.60653065971263342f : 1.f;
#pragma unroll
            for (int bj = 0; bj < 2; ++bj) {
                f32x4 pa = {0.f, 0.f, 0.f, 0.f}, pb = pa;
                if (par) { pa = *(const f32x4*)(par + c768 + bj * 128); pb = *(const f32x4*)(par + c768 + bj * 128 + 4); }
#pragma unroll
                for (int ai = 0; ai < 2; ++ai)
#pragma unroll
                    for (int m = 0; m < 4; ++m) { f32x4 v0 = acc[ai][bj][m][0] + pa, v1 = acc[ai][bj][m][1] + pb;
                        if (par) {
#pragma unroll
                            for (int e = 0; e < 4; ++e) { v0[e] = mul * sigmoidf_(v0[e]); v1[e] = mul * sigmoidf_(v1[e]); } }
                        u32x4 w; w.x = cvt_pk_bf16(v0[0], v0[1]); w.y = cvt_pk_bf16(v0[2], v0[3]); w.z = cvt_pk_bf16(v1[0], v1[1]); w.w = cvt_pk_bf16(v1[2], v1[3]);
                        *(u32x4*)(base + (size_t)(ai * 128 + m * 16) * 768 + bj * 128) = w; } }
        } else if (mode == EM_VRES) {
            const int c0 = u.pn * 256 + ct;
            bf16_t* V = (bf16_t*)(ws + A_V); const bf16_t* VS = (const bf16_t*)(ws + A_YS); const bf16_t* VF = (const bf16_t*)(ws + O_VF);
#pragma unroll
            for (int bj = 0; bj < 2; ++bj) {
                const f32x4 pa = *(const f32x4*)(p0 + c0 + bj * 128), pb = *(const f32x4*)(p0 + c0 + bj * 128 + 4);
#pragma unroll
                for (int ai = 0; ai < 2; ++ai)
#pragma unroll
                    for (int m = 0; m < 4; ++m) { const size_t o = (size_t)(u.pm * 256 + rt + ai * 128 + m * 16) * 768 + c0 + bj * 128;
                        float vs[8], vf[8], r[8]; unpack8(*(const u32x4*)(VS + o), vs); unpack8(*(const u32x4*)(VF + o), vf);
                        const f32x4 v0 = acc[ai][bj][m][0] + pa, v1 = acc[ai][bj][m][1] + pb;
#pragma unroll
                        for (int e = 0; e < 4; ++e) { r[e] = vs[e] + (vf[e] - vs[e]) * sigmoidf_(v0[e]); r[4 + e] = vs[4 + e] + (vf[4 + e] - vs[4 + e]) * sigmoidf_(v1[e]); }
                        *(u32x4*)(V + o) = pack8(r); } }
        } else if (mode == EM_MERGE) {
            const bf16_t* GT = (const bf16_t*)(ws + A_GATES); bf16_t* Mb = (bf16_t*)(ws + O_H);
            const int c0 = u.pn * 256 + ct;
#pragma unroll
            for (int ai = 0; ai < 2; ++ai) {
                u32x4 gv[4][2], mv[4][2];
#pragma unroll
                for (int m = 0; m < 4; ++m)
#pragma unroll
                    for (int bj = 0; bj < 2; ++bj) { const size_t row = (size_t)(u.pm * 256 + rt + ai * 128 + m * 16); const int c = c0 + bj * 128;
                        gv[m][bj] = *(const u32x4*)(GT + row * 6144 + aux * 2048 + c);
                        if (aux > 0) mv[m][bj] = *(const u32x4*)(Mb + row * 2048 + c); else mv[m][bj] = (u32x4){0u, 0u, 0u, 0u}; }
                asm volatile("" ::: "memory");
#pragma unroll
                for (int m = 0; m < 4; ++m)
#pragma unroll
                    for (int bj = 0; bj < 2; ++bj) { const size_t row = (size_t)(u.pm * 256 + rt + ai * 128 + m * 16); const int c = c0 + bj * 128;
                        float g[8], o[8], r[8]; unpack8(gv[m][bj], g); unpack8(mv[m][bj], o);
                        const f32x4 v0 = acc[ai][bj][m][0], v1 = acc[ai][bj][m][1];
#pragma unroll
                        for (int e2 = 0; e2 < 4; ++e2) { r[e2] = g[e2] * v0[e2] + o[e2]; r[4 + e2] = g[4 + e2] * v1[e2] + o[4 + e2]; }
                        *(u32x4*)(Mb + row * 2048 + c) = pack8(r); }
                asm volatile("" ::: "memory");
            }
        } else {
            const int c0 = u.pn * 256 + ct;
            const bool lat = u.pm < 64;
            const int cond = lat ? (u.pm >> 4) : 4;
            const float* gp = gmod + (size_t)cond * MODW + aux + c0;
            const float* xi = lat ? xin_l + (size_t)(u.pm * 256) * DM : xin_c + (size_t)((u.pm - 64) * 256) * DM;
            float* xo = lat ? xout_l + (size_t)(u.pm * 256) * DM : xout_c + (size_t)((u.pm - 64) * 256) * DM;
            f32x4 ga[2], gb[2];
#pragma unroll
            for (int bj = 0; bj < 2; ++bj) { ga[bj] = *(const f32x4*)(gp + bj * 128); gb[bj] = *(const f32x4*)(gp + bj * 128 + 4); }
#pragma unroll
            for (int ai = 0; ai < 2; ++ai) {
                f32x4 xa[4][2], xb[4][2];
#pragma unroll
                for (int m = 0; m < 4; ++m)
#pragma unroll
                    for (int bj = 0; bj < 2; ++bj) { const size_t o = (size_t)(rt + ai * 128 + m * 16) * DM + c0 + bj * 128; xa[m][bj] = *(const f32x4*)(xi + o); xb[m][bj] = *(const f32x4*)(xi + o + 4); }
                asm volatile("" ::: "memory");
#pragma unroll
                for (int m = 0; m < 4; ++m)
#pragma unroll
                    for (int bj = 0; bj < 2; ++bj) { const size_t o = (size_t)(rt + ai * 128 + m * 16) * DM + c0 + bj * 128;
                        *(f32x4*)(xo + o) = xa[m][bj] + ga[bj] * acc[ai][bj][m][0]; *(f32x4*)(xo + o + 4) = xb[m][bj] + gb[bj] * acc[ai][bj][m][1]; }
                asm volatile("" ::: "memory");
            }
        }
    }
};

namespace att {
using s16x4 = __attribute__((ext_vector_type(4))) short;
using f32x16 = __attribute__((ext_vector_type(16))) float;
constexpr int NW = 8, QBLK = 32, KVBLK = 64;
constexpr float THR = 8.f;
#ifndef ATT_SDEPTH
#define ATT_SDEPTH 1
#endif
constexpr int SDEPTH = ATT_SDEPTH;
constexpr size_t SHM_V = KVBLK * 128 * 2, SHM_KMAX = KVBLK * 128 * 2, SHM_ATTN = 2 * SHM_V + 2 * SHM_KMAX + NW * 64 * 4;
#define SBAR() __builtin_amdgcn_sched_barrier(0)
template <int DQK> __device__ __forceinline__ int kswz(int row, int colB) { return row * (DQK * 2) + (colB ^ ((DQK == 128 ? (row & 15) : ((row >> 1) & 7)) << 4)); }
__device__ __forceinline__ int crow(int r, int hi) { return (r & 3) + 8 * (r >> 2) + 4 * hi; }
__device__ __forceinline__ void partialSM(f32x16& p0, f32x16& p1, float& m_reg, float& mn, float& alpha, const float C, const float thr_raw) {
    float pmax = p0[0];
#pragma unroll
    for (int r = 1; r < 16; ++r) pmax = fmaxf(pmax, p0[r]);
#pragma unroll
    for (int r = 0; r < 16; ++r) pmax = fmaxf(pmax, p1[r]);
    { auto rr = __builtin_amdgcn_permlane32_swap(__float_as_uint(pmax), __float_as_uint(pmax), false, false);
      pmax = fmaxf(__uint_as_float(rr[0]), __uint_as_float(rr[1])); }
    if (__builtin_expect(__all(pmax - m_reg <= thr_raw), 1)) { mn = m_reg; alpha = 1.f; }
    else { mn = fmaxf(m_reg, pmax); alpha = __builtin_amdgcn_exp2f((m_reg - mn) * C); m_reg = mn; }
    const float mnC = -mn * C;
#pragma unroll
    for (int r = 0; r < 16; ++r) p0[r] = fmaf(p0[r], C, mnC);
#pragma unroll
    for (int r = 0; r < 16; ++r) p1[r] = fmaf(p1[r], C, mnC);
#pragma unroll
    for (int r = 0; r < 16; ++r) p0[r] = __builtin_amdgcn_exp2f(p0[r]);
}
__device__ __forceinline__ void finishSM(f32x16& p0, f32x16& p1, float alpha, float& l_reg, bf16x8& pa0, bf16x8& pa1, bf16x8& pa2, bf16x8& pa3) {
#pragma unroll
    for (int r = 0; r < 16; ++r) p1[r] = __builtin_amdgcn_exp2f(p1[r]);
    float ps = 0;
#pragma unroll
    for (int r = 0; r < 16; ++r) ps += p0[r];
#pragma unroll
    for (int r = 0; r < 16; ++r) ps += p1[r];
    { auto rr = __builtin_amdgcn_permlane32_swap(__float_as_uint(ps), __float_as_uint(ps), false, false);
      ps = __uint_as_float(rr[0]) + __uint_as_float(rr[1]); }
    l_reg = l_reg * alpha + ps;
#define PK4(P, BASE, OUT) do { unsigned a0 = cvt_pk_bf16(P[BASE + 0], P[BASE + 1]), a1 = cvt_pk_bf16(P[BASE + 2], P[BASE + 3]);   \
    unsigned b0 = cvt_pk_bf16(P[BASE + 4], P[BASE + 5]), b1 = cvt_pk_bf16(P[BASE + 6], P[BASE + 7]);                              \
    auto r0 = __builtin_amdgcn_permlane32_swap(a0, b0, false, false); auto r1 = __builtin_amdgcn_permlane32_swap(a1, b1, false, false); \
    u32x4 w = {r0[0], r1[0], r0[1], r1[1]}; OUT = *reinterpret_cast<bf16x8*>(&w); } while (0)
    PK4(p0, 0, pa0); PK4(p0, 8, pa1); PK4(p1, 0, pa2); PK4(p1, 8, pa3);
#undef PK4
}
template <int DQK> __device__ __forceinline__ void qkt(f32x16& p0, f32x16& p1, const char* Ks, const bf16x8* qr, int r32, int hi) {
    p0 = f32x16{}; p1 = f32x16{};
#pragma unroll
    for (int d0 = 0; d0 < DQK / 16; ++d0) { const int cb = (d0 * 16 + hi * 8) * 2;
        const bf16x8 b0 = *reinterpret_cast<const bf16x8*>(Ks + kswz<DQK>(r32, cb));
        const bf16x8 b1 = *reinterpret_cast<const bf16x8*>(Ks + kswz<DQK>(32 + r32, cb));
        p0 = __builtin_amdgcn_mfma_f32_32x32x16_bf16(b0, qr[d0], p0, 0, 0, 0);
        p1 = __builtin_amdgcn_mfma_f32_32x32x16_bf16(b1, qr[d0], p1, 0, 0, 0); }
}
__device__ __forceinline__ int v_st(int k, int c) { const int kk = (k & ~0xC) | ((k & 4) << 1) | ((k & 8) >> 1); return ((kk >> 3) * 4 + (c >> 5)) * 512 + ((kk & 7) * 32 + (c & 31)) * 2; }
__device__ __forceinline__ int v_rd_base(int lane) { return ((lane & 3) << 3) | (((lane >> 2) & 3) << 6) | (((lane >> 4) & 1) << 5) | (((lane >> 5) & 1) << 8); }
constexpr int v_rd_off(int d0, int ks, int half) { return d0 * 512 + ks * 4096 + half * 2048; }
template <int OFF> __device__ __forceinline__ s16x4 tr_read(int vb) {
    s16x4 r; asm volatile("ds_read_b64_tr_b16 %0, %1 offset:%2" : "=&v"(r) : "v"(vb), "i"(OFF) : "memory"); return r;
}
template <int D0> __device__ __forceinline__ void pv_one(f32x16& od, int vb, bf16x8 pa0, bf16x8 pa1, bf16x8 pa2, bf16x8 pa3) {
    const s16x4 l0 = tr_read<v_rd_off(D0, 0, 0)>(vb), h0 = tr_read<v_rd_off(D0, 0, 1)>(vb), l1 = tr_read<v_rd_off(D0, 1, 0)>(vb), h1 = tr_read<v_rd_off(D0, 1, 1)>(vb);
    const s16x4 l2 = tr_read<v_rd_off(D0, 2, 0)>(vb), h2 = tr_read<v_rd_off(D0, 2, 1)>(vb), l3 = tr_read<v_rd_off(D0, 3, 0)>(vb), h3 = tr_read<v_rd_off(D0, 3, 1)>(vb);
    asm volatile("s_waitcnt lgkmcnt(0)" ::: "memory"); SBAR();
#define PK(L, H) (bf16x8){L[0], L[1], L[2], L[3], H[0], H[1], H[2], H[3]}
    od = __builtin_amdgcn_mfma_f32_32x32x16_bf16(pa0, PK(l0, h0), od, 0, 0, 0);
    od = __builtin_amdgcn_mfma_f32_32x32x16_bf16(pa1, PK(l1, h1), od, 0, 0, 0);
    od = __builtin_amdgcn_mfma_f32_32x32x16_bf16(pa2, PK(l2, h2), od, 0, 0, 0);
    od = __builtin_amdgcn_mfma_f32_32x32x16_bf16(pa3, PK(l3, h3), od, 0, 0, 0);
#undef PK
}
__device__ __forceinline__ void pv_d0(f32x16* o, int vb, bf16x8 pa0, bf16x8 pa1, bf16x8 pa2, bf16x8 pa3) {
    pv_one<0>(o[0], vb, pa0, pa1, pa2, pa3); pv_one<1>(o[1], vb, pa0, pa1, pa2, pa3); pv_one<2>(o[2], vb, pa0, pa1, pa2, pa3); pv_one<3>(o[3], vb, pa0, pa1, pa2, pa3);
}
__device__ __forceinline__ void store_o(float* p, float v) { *p = v; }
__device__ __forceinline__ void store_o(bf16_t* p, float v) { *p = (bf16_t)f2bf(v); }

template <int DQK, int LDKV, typename TO>
__device__ __forceinline__ void attn_body(const bf16_t* __restrict__ Qb, const bf16_t* __restrict__ Kh, const bf16_t* __restrict__ Vh,
                                          TO* __restrict__ Ob, int seq, float scale, char* lds) {
    constexpr int ldq = 768, ldo = 768, ldk = LDKV, ldv = LDKV;
    constexpr size_t SHM_K = KVBLK * DQK * 2;
    const int tid = lthread(), wid = tid >> 6, lane = tid & 63, r32 = lane & 31, hi = lane >> 5;
    char* V_lds = lds; char* K_lds = lds + 2 * SHM_V;
    float* ws = (float*)(lds + 2 * SHM_V + 2 * SHM_KMAX) + wid * 64; float* li_l = ws; float* al_l = ws + 32;
    const float C = scale * 1.4426950408889634f, thr_raw = THR / scale;
    float m_reg = -1e30f, l_reg = 0; f32x16 o[4] = {}; bf16x8 qr[DQK / 16];
    const bf16_t* Qw = Qb + (long)(wid * QBLK + r32) * ldq + hi * 8;
#pragma unroll
    for (int d0 = 0; d0 < DQK / 16; ++d0) qr[d0] = *reinterpret_cast<const bf16x8*>(Qw + d0 * 16);
    const int sr = tid >> 4, sc = (tid & 15) * 8, vst0 = v_st(sr, sc), vst1 = v_st(32 + sr, sc);
    const int ksr = DQK == 128 ? sr : (tid >> 3), ksc = DQK == 128 ? sc : (tid & 7) * 8;
    const int vb0 = (int)(uintptr_t)V_lds + v_rd_base(lane);
    struct { bf16x8 vs0, vs1, ks0, ks1; } sr_[SDEPTH];
#define SLOAD(i, k0) do { sr_[i].vs0 = *reinterpret_cast<const bf16x8*>(&Vh[(long)((k0) + sr) * ldv + sc]); sr_[i].vs1 = *reinterpret_cast<const bf16x8*>(&Vh[(long)((k0) + 32 + sr) * ldv + sc]); \
    sr_[i].ks0 = *reinterpret_cast<const bf16x8*>(&Kh[(long)((k0) + ksr) * ldk + ksc]); \
    if (DQK == 128) sr_[i].ks1 = *reinterpret_cast<const bf16x8*>(&Kh[(long)((k0) + 32 + ksr) * ldk + ksc]); } while (0)
#define SWRITE(b, i) do { *(bf16x8*)(V_lds + (b) * SHM_V + vst0) = sr_[i].vs0;          \
    *(bf16x8*)(V_lds + (b) * SHM_V + vst1) = sr_[i].vs1; const int kc = ksc * 2;               \
    *(bf16x8*)(K_lds + (b) * SHM_K + kswz<DQK>(ksr, kc)) = sr_[i].ks0;                       \
    if (DQK == 128) *(bf16x8*)(K_lds + (b) * SHM_K + kswz<DQK>(32 + ksr, kc)) = sr_[i].ks1; } while (0)
#define SWAIT() do { if (SDEPTH == 1) asm volatile("s_waitcnt vmcnt(0)" ::: "memory"); else if (DQK == 128) asm volatile("s_waitcnt vmcnt(4)" ::: "memory"); else asm volatile("s_waitcnt vmcnt(3)" ::: "memory"); } while (0)
#define RESC(a) do { if (__any((a) < 1.f)) { if (hi == 0) al_l[r32] = (a); asm volatile("s_waitcnt lgkmcnt(0)" ::: "memory"); \
    _Pragma("unroll") for (int d = 0; d < 4; ++d) _Pragma("unroll") for (int r = 0; r < 16; ++r) o[d][r] *= al_l[crow(r, hi)]; } } while (0)
    f32x16 pA0, pA1, pB0, pB1; float mnA, mnB, alA, alB; bf16x8 pa0, pa1, pa2, pa3; const int NT = seq / KVBLK;
    constexpr int SE = 0, SO = SDEPTH - 1;
    SLOAD(SE, 0); asm volatile("s_waitcnt vmcnt(0)" ::: "memory"); SWRITE(0, SE); __syncthreads();
    qkt<DQK>(pA0, pA1, K_lds, qr, r32, hi); partialSM(pA0, pA1, m_reg, mnA, alA, C, thr_raw);
    SLOAD(SO, KVBLK); if (SDEPTH == 2) { if (2 < NT) SLOAD(SE, 2 * KVBLK); }
    SWAIT(); SWRITE(1, SO); __syncthreads();
    for (int j = 1; j + 1 < NT; j += 2) {
        SBAR(); qkt<DQK>(pB0, pB1, K_lds + SHM_K, qr, r32, hi);
        finishSM(pA0, pA1, alA, l_reg, pa0, pa1, pa2, pa3); SBAR();
        SLOAD(SO, (j + SDEPTH) * KVBLK); SBAR();
        pv_d0(o, vb0, pa0, pa1, pa2, pa3); partialSM(pB0, pB1, m_reg, mnB, alB, C, thr_raw);
        __syncthreads(); SWAIT(); SWRITE(0, SE);
        RESC(alB); __syncthreads();
        SBAR(); qkt<DQK>(pA0, pA1, K_lds, qr, r32, hi);
        finishSM(pB0, pB1, alB, l_reg, pa0, pa1, pa2, pa3); SBAR();
        if (SDEPTH == 1 || j + 3 < NT) SLOAD(SE, (j + 1 + SDEPTH) * KVBLK); SBAR();
        pv_d0(o, vb0 + (int)SHM_V, pa0, pa1, pa2, pa3); partialSM(pA0, pA1, m_reg, mnA, alA, C, thr_raw);
        __syncthreads(); SWAIT(); SWRITE(1, SO);
        RESC(alA); __syncthreads();
    }
    SBAR(); qkt<DQK>(pB0, pB1, K_lds + SHM_K, qr, r32, hi);
    finishSM(pA0, pA1, alA, l_reg, pa0, pa1, pa2, pa3); SBAR();
    pv_d0(o, vb0, pa0, pa1, pa2, pa3); partialSM(pB0, pB1, m_reg, mnB, alB, C, thr_raw);
    __syncthreads(); RESC(alB);
    finishSM(pB0, pB1, alB, l_reg, pa0, pa1, pa2, pa3); SBAR();
    pv_d0(o, vb0 + (int)SHM_V, pa0, pa1, pa2, pa3);
    if (hi == 0) li_l[r32] = l_reg; asm volatile("s_waitcnt lgkmcnt(0)" ::: "memory");
    float rli[16];
#pragma unroll
    for (int r = 0; r < 16; ++r) rli[r] = __builtin_amdgcn_rcpf(li_l[crow(r, hi)]);
    __syncthreads();
    bf16_t* stg = (bf16_t*)(lds + wid * 8192);
#pragma unroll
    for (int r = 0; r < 16; ++r) { const int orow = crow(r, hi);
#pragma unroll
        for (int d0 = 0; d0 < 4; ++d0) stg[orow * 128 + d0 * 32 + r32] = (bf16_t)f2bf(o[d0][r] * rli[r]); }
    asm volatile("s_waitcnt lgkmcnt(0)" ::: "memory");
    TO* Ow = Ob + (long)(wid * QBLK) * ldo;
#pragma unroll
    for (int i = 0; i < 8; ++i) { const int row = i * 4 + (lane >> 4), ch = lane & 15;
        const u32x4 v = *(const u32x4*)(stg + row * 128 + ch * 8); *(u32x4*)(Ow + (long)row * ldo + ch * 8) = v; }
#undef SLOAD
#undef SWRITE
#undef SWAIT
#undef RESC
}
#undef SBAR
}

struct Args { const float* in[N_IN]; float* out; unsigned char* ws; int ph_lo, ph_hi; };

constexpr int RING_BYTES = 131072, MISC_OFF = RING_BYTES, LDS_BYTES = 147456;

struct Frame {
    const Args* a; unsigned char* ws; char* lds; int tid, lane, wave, gw, ngw;
};

__device__ __forceinline__ void transpose_item(const float* W, int N, bf16_t* WT, int ldk, float* scr, int item, int lane) {
    const int nblk = N / 32, kb = item / nblk, nb = item % nblk, k0 = 64 * kb, n0 = 32 * nb;
    float tv[32];
#pragma unroll
    for (int i = 0; i < 32; ++i) { const int kk = 2 * i + (lane >> 5); tv[i] = W[(size_t)(k0 + kk) * N + n0 + (lane & 31)]; }
#pragma unroll
    for (int i = 0; i < 32; ++i) { const int kk = 2 * i + (lane >> 5); scr[kk * 33 + (lane & 31)] = tv[i]; }
    asm volatile("s_waitcnt lgkmcnt(0)" ::: "memory");
    const int c = lane & 7;
#pragma unroll
    for (int j = 0; j < 4; ++j) { const int n = (lane >> 3) + 8 * j; const float* s = scr + (8 * c) * 33 + n;
        u32x4 o; o.x = cvt_pk_bf16(s[0 * 33], s[1 * 33]); o.y = cvt_pk_bf16(s[2 * 33], s[3 * 33]); o.z = cvt_pk_bf16(s[4 * 33], s[5 * 33]); o.w = cvt_pk_bf16(s[6 * 33], s[7 * 33]);
        *(u32x4*)(WT + (size_t)(n0 + n) * ldk + k0 + 8 * c) = o; }
    asm volatile("s_waitcnt lgkmcnt(0)" ::: "memory");
}
__device__ __forceinline__ void convert_weights(const Frame& F, int layer) {
    float* scr = (float*)(F.lds + F.wave * 16384);
    const Args& A = *F.a;
    constexpr int I_IN = (2048 / 64) * (12288 / 32), I_BRX = (768 / 64) * (2048 / 32), I_OUT = (2048 / 64) * (2048 / 32), I_UPX = (2048 / 64) * (FF2 / 32), I_DN = (FF / 64) * (2048 / 32);
    constexpr int NITEMS = I_IN + 3 * I_BRX + I_OUT + I_UPX + I_DN;
    for (int it = F.gw; it < NITEMS; it += F.ngw) {
        int r = it;
        if (r < I_IN) { transpose_item(A.in[I_WIN] + (size_t)layer * 2048 * 12288, 12288, (bf16_t*)(F.ws + W_IN), 2048, scr, r, F.lane); continue; } r -= I_IN;
        if (r < I_BRX) { transpose_item(A.in[I_WBR] + (size_t)layer * 768 * 2048, 2048, (bf16_t*)(F.ws + W_BR), 768, scr, r, F.lane); continue; } r -= I_BRX;
        if (r < I_BRX) { transpose_item(A.in[I_WBG] + (size_t)layer * 768 * 2048, 2048, (bf16_t*)(F.ws + W_BR) + 2048 * 768, 768, scr, r, F.lane); continue; } r -= I_BRX;
        if (r < I_BRX) { transpose_item(A.in[I_WBD] + (size_t)layer * 768 * 2048, 2048, (bf16_t*)(F.ws + W_BR) + 2 * 2048 * 768, 768, scr, r, F.lane); continue; } r -= I_BRX;
        if (r < I_OUT) { transpose_item(A.in[I_WOUT] + (size_t)layer * 2048 * 2048, 2048, (bf16_t*)(F.ws + W_OUT), 2048, scr, r, F.lane); continue; } r -= I_OUT;
        if (r < I_UPX) { transpose_item(A.in[I_UP] + (size_t)layer * 2048 * FF2, FF2, (bf16_t*)(F.ws + W_UP), 2048, scr, r, F.lane); continue; } r -= I_UPX;
        transpose_item(A.in[I_DOWN] + (size_t)layer * FF * 2048, 2048, (bf16_t*)(F.ws + W_DOWN), FF, scr, r, F.lane);
    }
    const float* w2 = A.in[I_W2] + (size_t)layer * 2 * 64 * 768; const float* a2 = A.in[I_A2] + (size_t)layer * 2 * 64 * 768; const float* g2 = A.in[I_G2] + (size_t)layer * 128 * 768;
    for (int n = F.gw; n < 3840 + (layer == 1 ? 768 * 12 : 0); n += F.ngw) {
        if (n < 3840) {
            const int seg = n / 768, c = n % 768; bf16_t* dst = (bf16_t*)(F.ws + W_LR) + (size_t)n * 256;
#pragma unroll
            for (int j = 0; j < 4; ++j) { const int k = j * 64 + F.lane; float v = 0.f;
                if (seg < 2) { if (k < 64) v = w2[((size_t)seg * 64 + k) * 768 + c]; }
                else if (seg < 4) { if (k >= 64 && k < 128) v = a2[((size_t)(seg - 2) * 64 + (k - 64)) * 768 + c]; }
                else { if (k >= 128) v = g2[(size_t)(k - 128) * 768 + c]; }
                dst[k] = (bf16_t)f2bf(v); }
        } else {
            const int q_ = n - 3840, nn = q_ / 12, k = (q_ % 12) * 64 + F.lane;
            const float* v1r = A.in[I_V1] + (size_t)k * 32; const float* v2p = A.in[I_V2] + nn;
            f32x4 a[8]; float b[32];
#pragma unroll
            for (int r4 = 0; r4 < 8; ++r4) a[r4] = *(const f32x4*)(v1r + 4 * r4);
#pragma unroll
            for (int r = 0; r < 32; ++r) b[r] = v2p[(size_t)r * 768];
            float s = 0.f;
#pragma unroll
            for (int r4 = 0; r4 < 8; ++r4) s += a[r4].x * b[4 * r4] + a[r4].y * b[4 * r4 + 1] + a[r4].z * b[4 * r4 + 2] + a[r4].w * b[4 * r4 + 3];
            ((bf16_t*)(F.ws + W_V12))[(size_t)nn * 768 + k] = (bf16_t)f2bf(s);
        }
    }
}
__device__ __forceinline__ void adaln(const Frame& F) {
    const Args& A = *F.a;
    float* sc = (float*)F.lds;
    float* red = (float*)(F.lds + 40960);
    for (int i = F.tid; i < 5 * 2048; i += NTHREADS) { const int cnd = i >> 11, k = i & 2047; const float v = cnd < 4 ? A.in[I_C][cnd * 2048 + k] : A.in[I_CCTX][k]; sc[i] = v / (1.f + __expf(-v)); }
    __syncthreads();
    float* MOD = (float*)(F.ws + O_MOD);
    for (int slab = blockIdx.x; slab < 256; slab += gridDim.x) {
        const int col0 = slab * 96, layer = col0 / MODW, cc = col0 % MODW;
        const float* W = A.in[I_WMOD] + (size_t)layer * 2048 * MODW + cc;
        float a0[5] = {0.f, 0.f, 0.f, 0.f, 0.f}, a1[5] = {0.f, 0.f, 0.f, 0.f, 0.f};
        const int kb = F.wave * 256;
#pragma unroll 8
        for (int k = kb; k < kb + 256; ++k) {
            const float w0 = W[(size_t)k * MODW + F.lane]; const float w1 = F.lane < 32 ? W[(size_t)k * MODW + 64 + F.lane] : 0.f;
#pragma unroll
            for (int c = 0; c < 5; ++c) { const float s = sc[c * 2048 + k]; a0[c] += s * w0; a1[c] += s * w1; }
        }
#pragma unroll
        for (int c = 0; c < 5; ++c) { red[(F.wave * 10 + c * 2) * 64 + F.lane] = a0[c]; red[(F.wave * 10 + c * 2 + 1) * 64 + F.lane] = a1[c]; }
        __syncthreads();
        if (F.tid < 480) { const int c = F.tid / 96, j = F.tid % 96; float s = A.in[I_BMOD][layer * MODW + cc + j];
#pragma unroll
            for (int w = 0; w < 8; ++w) s += red[(w * 10 + c * 2 + (j >> 6)) * 64 + (j & 63)];
            MOD[((size_t)layer * 5 + c) * MODW + cc + j] = s; }
        __syncthreads();
    }
}
__device__ __forceinline__ void norm_rows(const Frame& F, const float* xl, const float* xc, const float* gain, const float* mod  , int sh_off, int sc_off, int nrows) {
    bf16_t* H = (bf16_t*)(F.ws + O_H);
    for (int m = F.gw; m < nrows; m += F.ngw) {
        const bool lat = m < TL; const int cond = lat ? (m >> 12) : 4;
        const float* xr = lat ? xl + (size_t)m * DM : xc + (size_t)(m - TL) * DM;
        f32x4 v[8]; float s = 0.f;
#pragma unroll
        for (int j = 0; j < 8; ++j) { v[j] = *(const f32x4*)(xr + j * 256 + F.lane * 4); s += v[j].x * v[j].x + v[j].y * v[j].y + v[j].z * v[j].z + v[j].w * v[j].w; }
        const float rs = rsqrtf(wave_sum(s) * (1.f / DM) + 1e-6f);
        const float* mp = mod + (size_t)cond * MODW;
#pragma unroll
        for (int j = 0; j < 8; ++j) { const int c = j * 256 + F.lane * 4;
            const f32x4 g = *(const f32x4*)(gain + c), sh = *(const f32x4*)(mp + sh_off + c), sc = *(const f32x4*)(mp + sc_off + c);
            const f32x4 y = v[j] * rs * g * (sc + 1.f) + sh;
            u32x2 w; w.x = cvt_pk_bf16(y.x, y.y); w.y = cvt_pk_bf16(y.z, y.w); *(u32x2*)(H + (size_t)m * DM + c) = w; }
    }
}
__device__ __forceinline__ void final_norm(const Frame& F) {
    float* X = F.a->out; const float* gain = F.a->in[I_FN];
    for (int m = F.gw; m < TL; m += F.ngw) {
        float* xr = X + (size_t)m * DM; f32x4 v[8]; float s = 0.f;
#pragma unroll
        for (int j = 0; j < 8; ++j) { v[j] = *(const f32x4*)(xr + j * 256 + F.lane * 4); s += v[j].x * v[j].x + v[j].y * v[j].y + v[j].z * v[j].z + v[j].w * v[j].w; }
        const float rs = rsqrtf(wave_sum(s) * (1.f / DM) + 1e-6f);
#pragma unroll
        for (int j = 0; j < 8; ++j) { const int c = j * 256 + F.lane * 4; *(f32x4*)(xr + c) = v[j] * rs * *(const f32x4*)(gain + c); }
    }
}
__device__ __forceinline__ float row16_sum_p(float v) {
    v += __int_as_float(__builtin_amdgcn_update_dpp(0, __float_as_int(v), 0xB1, 0xF, 0xF, true));
    v += __int_as_float(__builtin_amdgcn_update_dpp(0, __float_as_int(v), 0x4E, 0xF, 0xF, true));
    v += __int_as_float(__builtin_amdgcn_update_dpp(0, __float_as_int(v), 0x141, 0xF, 0xF, true));
    v += __int_as_float(__builtin_amdgcn_update_dpp(0, __float_as_int(v), 0x140, 0xF, 0xF, true));
    return v;
}
__device__ __forceinline__ f32x4 unpack4p(u32x2 w) { return (f32x4){bf2f(w.x & 0xffffu), __uint_as_float(w.x & 0xffff0000u), bf2f(w.y & 0xffffu), __uint_as_float(w.y & 0xffff0000u)}; }
__device__ __forceinline__ u32x2 pack4p(f32x4 v) { u32x2 w; w.x = cvt_pk_bf16(v.x, v.y); w.y = cvt_pk_bf16(v.z, v.w); return w; }
__device__ __forceinline__ void rwkv_prep(const Frame& F, int layer) {
    const Args& A = *F.a;
    const bf16_t* PR = (const bf16_t*)(F.ws + A_PR);
    bf16_t* R = (bf16_t*)(F.ws + A_R); bf16_t* K = (bf16_t*)(F.ws + A_K); bf16_t* V = (bf16_t*)(F.ws + (layer == 0 ? O_VF : A_YS));
    bf16_t* KKo = (bf16_t*)(F.ws + A_KKN); bf16_t* LR = (bf16_t*)(F.ws + A_LR);
    const float* mu = A.in[I_MU] + layer * RCOLS; const float* kkw = A.in[I_KK] + layer * RW;
    const int l4 = F.lane * 4;
    for (int m = F.gw; m < TT; m += F.ngw) {
        const bool lat = m < TL; const int t = lat ? (m & 4095) : ((m - TL) & 255), len = lat ? SEQ : CTX;
        const bool hp = t > 0, hn = t < len - 1;
        const bf16_t* p = PR + (size_t)m * RCOLS;
        const u32x2 z2 = {0u, 0u};
        u32x2 rc[10], rp[10], rn[10]; f32x4 rm[10], rk3[3];
#pragma unroll
        for (int it = 0; it < 10; ++it) { const int c = it * 256 + l4;
            rc[it] = *(const u32x2*)(p + c); rp[it] = hp ? *(const u32x2*)(p + c - RCOLS) : z2; rn[it] = hn ? *(const u32x2*)(p + c + RCOLS) : z2; rm[it] = *(const f32x4*)(mu + c); }
#pragma unroll
        for (int j = 0; j < 3; ++j) rk3[j] = *(const f32x4*)(kkw + j * 256 + l4);
        asm volatile("" ::: "memory");
#pragma unroll
        for (int it = 0; it < 10; ++it) { const int c = it * 256 + l4;
            const f32x4 cur = unpack4p(rc[it]), pv = unpack4p(rp[it]), nx = unpack4p(rn[it]);
            const f32x4 xs = cur + rm[it] * ((pv + nx) * 0.5f - cur);
            if (it < 3) { *(u32x2*)(R + (size_t)m * RW + c) = pack4p(xs); }
            else if (it < 6) { const int ck = c - 768; *(u32x2*)(K + (size_t)m * RW + ck) = pack4p(xs);
                const f32x4 kk = xs * rk3[it - 3 < 0 ? 0 : (it - 3 > 2 ? 2 : it - 3)];
                const float ss = row16_sum_p((kk.x * kk.x + kk.y * kk.y) + (kk.z * kk.z + kk.w * kk.w));
                *(u32x2*)(KKo + (size_t)m * RW + ck) = pack4p(kk * (1.f / fmaxf(sqrtf(ss), 1e-12f))); }
            else if (it < 9) { *(u32x2*)(V + (size_t)m * RW + c - 1536) = pack4p(xs); }
            else { f32x4 o;
                if (F.lane < 16) o = (f32x4){tanhf(xs.x), tanhf(xs.y), tanhf(xs.z), tanhf(xs.w)};
                else if (F.lane < 32) o = xs;
                else o = (f32x4){sigmoidf_(xs.x), sigmoidf_(xs.y), sigmoidf_(xs.z), sigmoidf_(xs.w)};
                *(u32x2*)(LR + (size_t)m * 256 + l4) = pack4p(o); }
        }
        asm volatile("" ::: "memory");
    }
}
__device__ __forceinline__ void qk_prep(const Frame& F, int layer) {
    const Args& A = *F.a;
    bf16_t* QG = (bf16_t*)(F.ws + A_QG); bf16_t* KG = (bf16_t*)(F.ws + A_KG); bf16_t* DQ = (bf16_t*)(F.ws + A_DQ); bf16_t* DK = (bf16_t*)(F.ws + A_DK);
    float* TGc = (float*)F.lds; float* TGs = TGc + 2048; float* TDc = TGs + 2048; float* TDs = TDc + 1024;
    __syncthreads();
    for (int i = F.tid; i < 2048; i += NTHREADS) { float s_, c_; sincosf((float)(i >> 5) * powf(10000.f, -(float)(i & 31) / 32.f), &s_, &c_); TGc[i] = c_; TGs[i] = s_; }
    for (int i = F.tid; i < 1024; i += NTHREADS) { float s_, c_; sincosf((float)(i >> 4) * powf(10000.f, -(float)(i & 15) / 16.f), &s_, &c_); TDc[i] = c_; TDs[i] = s_; }
    __syncthreads();
    const int l = F.lane, sub = l & 15, hg = l >> 4, sub8 = l & 7;
    float gq[8], gk[8];
#pragma unroll
    for (int e = 0; e < 8; ++e) { gq[e] = A.in[I_QN][layer * 128 + sub * 8 + e]; gk[e] = A.in[I_KN][layer * 128 + sub * 8 + e]; }
    for (int m = F.gw; m < TT; m += F.ngw) {
        const bool lat = m < TL; const int b = lat ? (m >> 12) : ((m - TL) >> 8), t = lat ? (m & 4095) : ((m - TL) & 255);
        const size_t kvrow = (size_t)b * KVS + (lat ? CTX + t : t);
        const int ridx = t >> 6, cidx = t & 63;
        u32x4 qraw[2], draw[3];
#pragma unroll
        for (int ps = 0; ps < 2; ++ps) { const bool isk = ps == 1 && hg >= 2;
            qraw[ps] = *(const u32x4*)(isk ? KG + kvrow * 256 + (hg - 2) * 128 + sub * 8 : QG + (size_t)m * 768 + (ps * 4 + hg) * 128 + sub * 8); }
#pragma unroll
        for (int ps = 0; ps < 3; ++ps) { const int v = ps * 8 + (l >> 3);
            draw[ps] = lat ? *(const u32x4*)(v < 12 ? DQ + (size_t)m * 768 + v * 64 + sub8 * 8 : DK + kvrow * 768 + (v - 12) * 64 + sub8 * 8) : (u32x4){0u, 0u, 0u, 0u}; }
        asm volatile("" ::: "memory");
#pragma unroll
        for (int ps = 0; ps < 2; ++ps) {
            const bool isk = ps == 1 && hg >= 2;
            bf16_t* ptr = isk ? KG + kvrow * 256 + (hg - 2) * 128 + sub * 8 : QG + (size_t)m * 768 + (ps * 4 + hg) * 128 + sub * 8;
            float x[8]; unpack8(qraw[ps], x);
            float ss = 0.f;
#pragma unroll
            for (int e = 0; e < 8; ++e) ss += x[e] * x[e];
            const float rs = rsqrtf(row16_sum_p(ss) * (1.f / 128.f) + 1e-6f);
#pragma unroll
            for (int e = 0; e < 8; ++e) x[e] *= rs * (isk ? gk[e] : gq[e]);
            if (lat) {
                const int ti = (sub < 8 ? ridx : cidx) * 32 + (sub & 3) * 8; const bool up = (sub & 4) != 0;
                const f32x4 c0 = *(const f32x4*)(TGc + ti), c1 = *(const f32x4*)(TGc + ti + 4), s0 = *(const f32x4*)(TGs + ti), s1 = *(const f32x4*)(TGs + ti + 4);
#pragma unroll
                for (int e = 0; e < 8; ++e) { const float pl_ = __int_as_float(__builtin_amdgcn_update_dpp(0, __float_as_int(x[e]), 0x104, 0xF, 0xF, true)), pr_ = __int_as_float(__builtin_amdgcn_update_dpp(0, __float_as_int(x[e]), 0x114, 0xF, 0xF, true)); const float pz = up ? pr_ : pl_; const float cc = e < 4 ? c0[e & 3] : c1[e & 3], sn = e < 4 ? s0[e & 3] : s1[e & 3];
                    x[e] = up ? pz * sn + x[e] * cc : x[e] * cc - pz * sn; }
            }
            *(u32x4*)ptr = pack8(x);
        }
        if (lat) {
#pragma unroll
            for (int ps = 0; ps < 3; ++ps) { const int v = ps * 8 + (l >> 3);
                bf16_t* ptr = v < 12 ? DQ + (size_t)m * 768 + v * 64 + sub8 * 8 : DK + kvrow * 768 + (v - 12) * 64 + sub8 * 8;
                float x[8]; unpack8(draw[ps], x);
                const int ti = (sub8 < 4 ? ridx : cidx) * 16 + (sub8 & 1) * 8; const bool up = (sub8 & 2) != 0;
                const f32x4 c0 = *(const f32x4*)(TDc + ti), c1 = *(const f32x4*)(TDc + ti + 4), s0 = *(const f32x4*)(TDs + ti), s1 = *(const f32x4*)(TDs + ti + 4);
#pragma unroll
                for (int e = 0; e < 8; ++e) { const float pz = __int_as_float(__builtin_amdgcn_update_dpp(0, __float_as_int(x[e]), 0x4E, 0xF, 0xF, true));
                    const float cc = e < 4 ? c0[e & 3] : c1[e & 3], sn = e < 4 ? s0[e & 3] : s1[e & 3];
                    x[e] = up ? pz * sn + x[e] * cc : x[e] * cc - pz * sn; }
                *(u32x4*)ptr = pack8(x);
            }
        }
    }
}
__device__ __forceinline__ float quad_sum(float v) {
    v += __int_as_float(__builtin_amdgcn_update_dpp(0, __float_as_int(v), 0xB1, 0xF, 0xF, true));
    v += __int_as_float(__builtin_amdgcn_update_dpp(0, __float_as_int(v), 0x4E, 0xF, 0xF, true));
    return v;
}
struct ScanStep { f32x4 w[2], kd[2], kk[2], b[2], r[2]; f32x2 v; };
__device__ __forceinline__ ScanStep scan_ld(const float* cb, const float* vbp, int s) {
    ScanStep d; const float* rec = cb + s * 384;
#pragma unroll
    for (int jj = 0; jj < 2; ++jj) { d.w[jj] = *(const f32x4*)(rec + jj * 4); d.kd[jj] = *(const f32x4*)(rec + 64 + jj * 4); d.kk[jj] = *(const f32x4*)(rec + 128 + jj * 4);
        d.b[jj] = *(const f32x4*)(rec + 192 + jj * 4); d.r[jj] = *(const f32x4*)(rec + 256 + jj * 4); }
    d.v = *(const f32x2*)(vbp + s * 384);
    return d;
}
__device__ __forceinline__ float oct_sum(float v) {
    v += __int_as_float(__builtin_amdgcn_update_dpp(0, __float_as_int(v), 0xB1, 0xF, 0xF, true));
    v += __int_as_float(__builtin_amdgcn_update_dpp(0, __float_as_int(v), 0x4E, 0xF, 0xF, true));
    v += __int_as_float(__builtin_amdgcn_update_dpp(0, __float_as_int(v), 0x141, 0xF, 0xF, true));
    return v;
}
__device__ __forceinline__ int scan_rowof(int g, int b, int dir) { if (g < CTX) { const int tt = dir ? (CTX - 1 - g) : g; return TL + b * CTX + tt; } const int g2 = g - CTX; const int tt = dir ? (SEQ - 1 - g2) : g2; return b * SEQ + tt; }
__device__ __forceinline__ void scan_chain(const Frame& F, int layer, int chain) {
    const Args& A = *F.a;
    const int b = chain / 24, h = (chain >> 1) % 12, dir = chain & 1;
    float* buf = (float*)F.lds;
    float* ybuf = (float*)(F.lds + 49152);
    const bf16_t* R = (const bf16_t*)(F.ws + A_R); const bf16_t* K = (const bf16_t*)(F.ws + A_K); const bf16_t* V = (const bf16_t*)(F.ws + (layer == 0 ? O_VF : A_V));
    const bf16_t* KKp = (const bf16_t*)(F.ws + A_KKN); const bf16_t* EW = (const bf16_t*)(F.ws + A_EW) + (size_t)dir * TT * RW; const bf16_t* AS = (const bf16_t*)(F.ws + A_AS) + (size_t)dir * TT * RW;
    float* YS = (float*)(F.ws + A_YS) + (size_t)dir * TT * RW;
    const bool stager = F.wave >= 4;
    const int t8 = F.tid & 255, s_st = t8 >> 4, part = t8 & 15, seg = part & 7, hrole = part >> 3;
    const int colo = h * 64 + seg * 8;
    float ka[8];
#pragma unroll
    for (int e = 0; e < 8; ++e) ka[e] = A.in[I_KA][layer * RW + colo + e];
    constexpr int NCH = (CTX + SEQ) / 16;
#define rowof(g) scan_rowof((g), b, dir)
    u32x4 z4 = {0u, 0u, 0u, 0u};
    u32x4 a0A = z4, a1A = z4, a2A = z4, a3A = z4, a0B = z4, a1B = z4, a2B = z4, a3B = z4;
#define SC_LOAD(r0, r1, r2, r3, n) do { const size_t ro_ = (size_t)rowof((n) * 16 + s_st) * RW + colo; \
        if (hrole == 0) { r0 = *(const u32x4*)(EW + ro_); r1 = *(const u32x4*)(R + ro_); r2 = *(const u32x4*)(K + ro_); r3 = *(const u32x4*)(AS + ro_); } \
        else { r0 = *(const u32x4*)(KKp + ro_); r1 = *(const u32x4*)(AS + ro_); r2 = *(const u32x4*)(V + ro_); } } while (0)
#define SC_WRITE(r0, r1, r2, r3, bi) do { float* d_ = buf + (bi) * 6144 + s_st * 384 + seg * 8; float x_[8], y_[8]; \
        if (hrole == 0) { unpack8(r0, x_); unpack8(r1, y_); float o_[8]; \
            _Pragma("unroll") for (int e = 0; e < 8; ++e) o_[e] = __expf(-x_[e]); \
            *(f32x4*)(d_) = (f32x4){o_[0], o_[1], o_[2], o_[3]}; *(f32x4*)(d_ + 4) = (f32x4){o_[4], o_[5], o_[6], o_[7]}; \
            *(f32x4*)(d_ + 256) = (f32x4){y_[0], y_[1], y_[2], y_[3]}; *(f32x4*)(d_ + 260) = (f32x4){y_[4], y_[5], y_[6], y_[7]}; \
            unpack8(r2, x_); unpack8(r3, y_); \
            _Pragma("unroll") for (int e = 0; e < 8; ++e) o_[e] = x_[e] * (1.f + (y_[e] - 1.f) * ka[e]); \
            *(f32x4*)(d_ + 64) = (f32x4){o_[0], o_[1], o_[2], o_[3]}; *(f32x4*)(d_ + 68) = (f32x4){o_[4], o_[5], o_[6], o_[7]}; } \
        else { unpack8(r0, x_); unpack8(r1, y_); \
            *(f32x4*)(d_ + 128) = (f32x4){x_[0], x_[1], x_[2], x_[3]}; *(f32x4*)(d_ + 132) = (f32x4){x_[4], x_[5], x_[6], x_[7]}; \
            *(f32x4*)(d_ + 192) = (f32x4){x_[0] * y_[0], x_[1] * y_[1], x_[2] * y_[2], x_[3] * y_[3]}; *(f32x4*)(d_ + 196) = (f32x4){x_[4] * y_[4], x_[5] * y_[5], x_[6] * y_[6], x_[7] * y_[7]}; \
            unpack8(r2, x_); \
            *(f32x4*)(d_ + 320) = (f32x4){x_[0], x_[1], x_[2], x_[3]}; *(f32x4*)(d_ + 324) = (f32x4){x_[4], x_[5], x_[6], x_[7]}; } } while (0)
    const int row_i = (F.wave & 3) * 16 + (F.lane >> 3) * 2, q = F.lane & 7;
    f32x2 S0[4], S1[4];
#pragma unroll
    for (int j = 0; j < 4; ++j) { S0[j] = (f32x2){0.f, 0.f}; S1[j] = (f32x2){0.f, 0.f}; }
    if (stager) { SC_LOAD(a0A, a1A, a2A, a3A, 0); SC_WRITE(a0A, a1A, a2A, a3A, 0); SC_LOAD(a0B, a1B, a2B, a3B, 1); SC_LOAD(a0A, a1A, a2A, a3A, 2); }
    __syncthreads();
#define SC_ITER(n, r0, r1, r2, r3) do { \
        if (!stager) { const float* cb = buf + ((n) & 1) * 6144 + q * 8; const float* vbp = buf + ((n) & 1) * 6144 + 320 + row_i; float* yb = ybuf + ((n) & 1) * 8192 + ((F.wave & 3) * 64 + F.lane) * 2; \
          ScanStep cur = scan_ld(cb, vbp, 0); \
          _Pragma("unroll") for (int hs = 0; hs < 2; ++hs) { f32x2 yreg[8]; \
          _Pragma("unroll") for (int s8 = 0; s8 < 8; ++s8) { const int s = hs * 8 + s8; \
            const ScanStep nx = scan_ld(cb, vbp, s < 15 ? s + 1 : 15); \
            f32x2 a0 = S0[0] * cur.kk[0].xy, a1 = S0[1] * cur.kk[0].zw, c0 = S1[0] * cur.kk[0].xy, c1 = S1[1] * cur.kk[0].zw; \
            a0 += S0[2] * cur.kk[1].xy; a1 += S0[3] * cur.kk[1].zw; c0 += S1[2] * cur.kk[1].xy; c1 += S1[3] * cur.kk[1].zw; \
            a0 += a1; c0 += c1; \
            const float nsa0 = -oct_sum(a0.x + a0.y), nsa1 = -oct_sum(c0.x + c0.y); \
            const float v0 = cur.v.x, v1 = cur.v.y; \
            f32x2 y0 = {0.f, 0.f}, y1 = {0.f, 0.f}, z0 = {0.f, 0.f}, z1 = {0.f, 0.f}; \
            _Pragma("unroll") for (int jj = 0; jj < 2; ++jj) { \
                S0[2 * jj] = S0[2 * jj] * cur.w[jj].xy + (cur.kd[jj].xy * v0 + cur.b[jj].xy * nsa0); \
                S0[2 * jj + 1] = S0[2 * jj + 1] * cur.w[jj].zw + (cur.kd[jj].zw * v0 + cur.b[jj].zw * nsa0); \
                S1[2 * jj] = S1[2 * jj] * cur.w[jj].xy + (cur.kd[jj].xy * v1 + cur.b[jj].xy * nsa1); \
                S1[2 * jj + 1] = S1[2 * jj + 1] * cur.w[jj].zw + (cur.kd[jj].zw * v1 + cur.b[jj].zw * nsa1); \
                y0 += S0[2 * jj] * cur.r[jj].xy; y1 += S0[2 * jj + 1] * cur.r[jj].zw; \
                z0 += S1[2 * jj] * cur.r[jj].xy; z1 += S1[2 * jj + 1] * cur.r[jj].zw; } \
            y0 += y1; z0 += z1; \
            yreg[s8] = (f32x2){y0.x + y0.y, z0.x + z0.y}; \
            cur = nx; } \
          _Pragma("unroll") for (int s8 = 0; s8 < 8; ++s8) *(f32x2*)(yb + (hs * 8 + s8) * 512) = yreg[s8]; } } \
        else { if ((n) + 1 < NCH) SC_WRITE(r0, r1, r2, r3, ((n) + 1) & 1); \
               if ((n) + 3 < NCH) SC_LOAD(r0, r1, r2, r3, (n) + 3); } \
        __syncthreads(); \
        if (stager) { const int s = t8 >> 4, i4 = (t8 & 15) * 4; const float* yb = ybuf + ((n) & 1) * 8192 + s * 512 + (i4 >> 1) * 16; \
          f32x4 o_ = {0.f, 0.f, 0.f, 0.f}; \
          _Pragma("unroll") for (int qq = 0; qq < 4; ++qq) { const f32x4 pa_ = *(const f32x4*)(yb + qq * 4), pb_ = *(const f32x4*)(yb + 16 + qq * 4); \
            o_.x += pa_.x + pa_.z; o_.y += pa_.y + pa_.w; o_.z += pb_.x + pb_.z; o_.w += pb_.y + pb_.w; } \
          *(f32x4*)(YS + (size_t)rowof((n) * 16 + s) * RW + h * 64 + i4) = o_; } } while (0)
    for (int n = 0; n < NCH; n += 2) { SC_ITER(n, a0B, a1B, a2B, a3B); SC_ITER(n + 1, a0A, a1A, a2A, a3A); }
    __syncthreads();
#undef SC_ITER
#undef SC_LOAD
#undef SC_WRITE
#undef rowof
}
__device__ __forceinline__ void ph_mix(const Frame& F, int layer, int rep) {
#ifndef PROBE_SUB
#define PROBE_SUB 0
#endif
    if (!(rep == 1 && PROBE_SUB == 2))
    for (int ch = blockIdx.x; ch < 96; ch += gridDim.x) scan_chain(F, layer, ch);
    unsigned* qbase = (unsigned*)(F.ws + O_CTL) + 64 * (16 + (layer * 2 + rep) * 8);
    volatile unsigned* misc = (volatile unsigned*)(F.lds + MISC_OFF);
    const int NK = (rep == 1 && PROBE_SUB == 1) ? 0 : (layer == 0 ? 144 + 9 : 144);
    const bf16_t* QG = (const bf16_t*)(F.ws + A_QG); const bf16_t* KG = (const bf16_t*)(F.ws + A_KG); const bf16_t* VG = (const bf16_t*)(F.ws + A_VG);
    const bf16_t* DQ = (const bf16_t*)(F.ws + A_DQ); const bf16_t* DK = (const bf16_t*)(F.ws + A_DK); const bf16_t* DV = (const bf16_t*)(F.ws + A_DV);
    bf16_t* YG = (bf16_t*)(F.ws + A_YG); bf16_t* OD = (bf16_t*)(F.ws + A_OD);
    const int x0 = (int)(xb_xcc_id() & 7u);
    int qi = 0;
    for (;;) {
        __syncthreads();
        if (F.tid == 0) { int qq = qi; unsigned uu = 0xFFFFFFFFu;
            while (qq < 8) { const int x = (x0 + qq) & 7; const unsigned k = atomicAdd(qbase + 64 * x, 1u); if ((int)k < NK) { uu = ((unsigned)x << 16) | k; break; } ++qq; }
            misc[0] = uu; misc[1] = (unsigned)qq; }
        __syncthreads();
        const unsigned uu = misc[0]; qi = (int)misc[1];
        if (uu == 0xFFFFFFFFu) break;
        const int x = (int)(uu >> 16), k = (int)(uu & 0xFFFFu);
        const bool isctx = k >= 144;
        const int g = x + 8 * (isctx ? (k - 144) : (k >> 4)), qb = k & 15;
        const bf16_t *qp, *kp, *vp; size_t orow; int kind, seq, oh;
        if (g < 24) { const int b = g / 6, hq = g % 6; orow = isctx ? (size_t)TL + b * CTX : (size_t)b * SEQ + qb * 256; kind = 0; oh = hq;
            qp = QG + orow * 768 + hq * 128; kp = KG + (size_t)b * KVS * 256 + (hq / 3) * 128; vp = VG + (size_t)b * KVS * 256 + (hq / 3) * 128; }
        else { const int d = g - 24, b = d / 12, h = (d >> 1) % 6, mp = d & 1; orow = isctx ? (size_t)TL + b * CTX : (size_t)b * SEQ + qb * 256; kind = 1 + mp; oh = h;
            qp = DQ + orow * 768 + (h * 2 + mp) * 64; kp = DK + (size_t)b * KVS * 768 + (h * 2 + mp) * 64; vp = DV + (size_t)b * KVS * 768 + h * 128; }
        seq = isctx ? CTX : KVS;
        if (kind == 0) att::attn_body<128, 256, bf16_t>(qp, kp, vp, YG + orow * 768 + oh * 128, seq, 0.088388347648318440f, F.lds);
        if (kind != 0) att::attn_body<64, 768, bf16_t>(qp, kp, vp, OD + (size_t)(kind - 1) * TT * 768 + orow * 768 + oh * 128, seq, 0.125f, F.lds);
    }
}
__device__ __forceinline__ float row16_sum(float v) {
    v += __int_as_float(__builtin_amdgcn_update_dpp(0, __float_as_int(v), 0xB1, 0xF, 0xF, true));
    v += __int_as_float(__builtin_amdgcn_update_dpp(0, __float_as_int(v), 0x4E, 0xF, 0xF, true));
    v += __int_as_float(__builtin_amdgcn_update_dpp(0, __float_as_int(v), 0x141, 0xF, 0xF, true));
    v += __int_as_float(__builtin_amdgcn_update_dpp(0, __float_as_int(v), 0x140, 0xF, 0xF, true));
    return v;
}
__device__ __forceinline__ f32x4 unpack4(u32x2 w) { return (f32x4){bf2f(w.x & 0xffffu), __uint_as_float(w.x & 0xffff0000u), bf2f(w.y & 0xffffu), __uint_as_float(w.y & 0xffff0000u)}; }
__device__ __forceinline__ u32x2 pack4(f32x4 v) { u32x2 w; w.x = cvt_pk_bf16(v.x, v.y); w.y = cvt_pk_bf16(v.z, v.w); return w; }
__device__ __forceinline__ void ph_post(const Frame& F, int layer) {
    const Args& A = *F.a; const int l = F.lane;
    const int nrows = layer == 0 ? TT : TL;
    const bf16_t* R = (const bf16_t*)(F.ws + A_R); const bf16_t* K = (const bf16_t*)(F.ws + A_K); const bf16_t* V = (const bf16_t*)(F.ws + (layer == 0 ? O_VF : A_V));
    const bf16_t* AS0 = (const bf16_t*)(F.ws + A_AS); const bf16_t* AS1 = AS0 + (size_t)TT * RW; const bf16_t* G = (const bf16_t*)(F.ws + A_G);
    const float* YS0 = (const float*)(F.ws + A_YS); const float* YS1 = YS0 + (size_t)TT * RW;
    const bf16_t* OD0 = (const bf16_t*)(F.ws + A_OD); const bf16_t* OD1 = OD0 + (size_t)TT * 768;
    bf16_t* YR = (bf16_t*)(F.ws + A_YR); bf16_t* YD = (bf16_t*)(F.ws + A_YD);
    const float* lnw = A.in[I_LNW] + layer * RW; const float* lnb = A.in[I_LNB] + layer * RW; const float* kaw = A.in[I_KA] + layer * RW; const float* rk = A.in[I_RK] + layer * RW;
    const float lam_init = 0.8f - 0.6f * expf(-0.3f * (float)layer);
    const float s1 = wave_sum(A.in[I_LQ1][layer * 64 + l] * A.in[I_LK1][layer * 64 + l]), s2 = wave_sum(A.in[I_LQ2][layer * 64 + l] * A.in[I_LK2][layer * 64 + l]);
    const float lam = expf(s1) - expf(s2) + lam_init;
    const int sub = l & 15, hg = l >> 4;
    const f32x4 sg0 = *(const f32x4*)(A.in[I_SUBLN] + layer * 128 + sub * 8) * (1.f - lam_init), sg1 = *(const f32x4*)(A.in[I_SUBLN] + layer * 128 + sub * 8 + 4) * (1.f - lam_init);
    for (int m = F.gw; m < nrows; m += F.ngw) {
        const size_t ro = (size_t)m * RW;
        f32x4 ly0[3], ly1[3], lw[3], lb[3], lka[3], lrk[3]; u32x2 la0[3], la1[3], lk[3], lr[3], lv[3], lg[3]; u32x4 ld0[2], ld1[2];
#pragma unroll
        for (int it = 0; it < 3; ++it) { const int c = (it * 4 + hg) * 64 + sub * 4;
            ly0[it] = *(const f32x4*)(YS0 + ro + c); ly1[it] = *(const f32x4*)(YS1 + ro + c);
            la0[it] = *(const u32x2*)(AS0 + ro + c); la1[it] = *(const u32x2*)(AS1 + ro + c); lk[it] = *(const u32x2*)(K + ro + c);
            lr[it] = *(const u32x2*)(R + ro + c); lv[it] = *(const u32x2*)(V + ro + c); lg[it] = *(const u32x2*)(G + ro + c);
            lw[it] = *(const f32x4*)(lnw + c); lb[it] = *(const f32x4*)(lnb + c); lka[it] = *(const f32x4*)(kaw + c); lrk[it] = *(const f32x4*)(rk + c); }
#pragma unroll
        for (int ps = 0; ps < 2; ++ps) { const int head = ps * 4 + hg; const int c = (head < 6 ? head : 0) * 128 + sub * 8;
            ld0[ps] = *(const u32x4*)(OD0 + ro + c); ld1[ps] = *(const u32x4*)(OD1 + ro + c); }
        asm volatile("" ::: "memory");
#pragma unroll
        for (int it = 0; it < 3; ++it) { const int c = (it * 4 + hg) * 64 + sub * 4;
            const f32x4 y = ly0[it] + ly1[it];
            const f32x4 a0 = unpack4(la0[it]), a1 = unpack4(la1[it]), k = unpack4(lk[it]), r = unpack4(lr[it]), v = unpack4(lv[it]), g = unpack4(lg[it]);
            const f32x4 w4 = lw[it], b4 = lb[it], ka4 = lka[it], rk4 = lrk[it];
            const float mean = row16_sum((y.x + y.y) + (y.z + y.w)) * (1.f / 64.f);
            const f32x4 d = y - mean;
            const float var = row16_sum((d.x * d.x + d.y * d.y) + (d.z * d.z + d.w * d.w)) * (1.f / 64.f);
            const f32x4 yn = d * rsqrtf(var + 64e-5f) * w4 + b4;
            const f32x4 kd = k * ((a0 + a1 - 2.f) * ka4 + 2.f);
            const f32x4 pr = r * kd * rk4;
            const float bs = row16_sum((pr.x + pr.y) + (pr.z + pr.w));
            *(u32x2*)(YR + ro + c) = pack4((yn + v * bs) * g); }
#pragma unroll
        for (int ps = 0; ps < 2; ++ps) { const int head = ps * 4 + hg;
            if (head < 6) { const int c = head * 128 + sub * 8;
                float pa_[8], pb_[8]; unpack8(ld0[ps], pa_); unpack8(ld1[ps], pb_);
                const f32x4 o0 = (f32x4){pa_[0], pa_[1], pa_[2], pa_[3]} - (f32x4){pb_[0], pb_[1], pb_[2], pb_[3]} * lam, o1 = (f32x4){pa_[4], pa_[5], pa_[6], pa_[7]} - (f32x4){pb_[4], pb_[5], pb_[6], pb_[7]} * lam;
                const float ss = row16_sum(((o0.x * o0.x + o0.y * o0.y) + (o0.z * o0.z + o0.w * o0.w)) + ((o1.x * o1.x + o1.y * o1.y) + (o1.z * o1.z + o1.w * o1.w)));
                const float rs = rsqrtf(ss * (1.f / 128.f) + 1e-5f);
                const f32x4 r0 = o0 * rs * sg0, r1 = o1 * rs * sg1;
                u32x4 w; w.x = cvt_pk_bf16(r0.x, r0.y); w.y = cvt_pk_bf16(r0.z, r0.w); w.z = cvt_pk_bf16(r1.x, r1.y); w.w = cvt_pk_bf16(r1.z, r1.w);
                *(u32x4*)(YD + ro + c) = w; } }
        asm volatile("" ::: "memory");
    }
}
__device__ __forceinline__ void conv_act(const Frame& F, int layer, int nrows) {
    const Args& A = *F.a;
    const bf16_t* U = (const bf16_t*)(F.ws + A_U); bf16_t* ACT = (bf16_t*)(F.ws + A_ACT);
    const float* cw = A.in[I_CW] + (size_t)layer * 3 * FF2; const float* cbias = A.in[I_CB] + (size_t)layer * FF2;
    constexpr int NCK = FF / 8;
    const int nitems = (nrows / 16) * NCK;
    for (int it = blockIdx.x * NTHREADS + F.tid; it < nitems; it += gridDim.x * NTHREADS) {
        const int rg = it / NCK, ck = it % NCK, r0 = rg * 16, c = ck * 8;
        const bool lat = r0 < TL; const int t0 = lat ? (r0 & 4095) : ((r0 - TL) & 255), len = lat ? SEQ : CTX;
        float wv[3][8], wg[3][8], bv[8], bg[8];
#pragma unroll
        for (int e = 0; e < 8; ++e) { bv[e] = cbias[c + e]; bg[e] = cbias[FF + c + e];
#pragma unroll
            for (int k = 0; k < 3; ++k) { wv[k][e] = cw[(size_t)k * FF2 + c + e]; wg[k][e] = cw[(size_t)k * FF2 + FF + c + e]; } }
        float pv[8], pg[8], cv[8], cg[8], nv[8], ng[8];
        const bf16_t* up = U + (size_t)r0 * FF2 + c;
        if (t0 > 0) { unpack8(*(const u32x4*)(up - FF2), pv); unpack8(*(const u32x4*)(up - FF2 + FF), pg); }
        else {
#pragma unroll
            for (int e = 0; e < 8; ++e) { pv[e] = 0.f; pg[e] = 0.f; } }
        unpack8(*(const u32x4*)(up), cv); unpack8(*(const u32x4*)(up + FF), cg);
#pragma unroll 1
        for (int i = 0; i < 16; ++i) {
            if (t0 + i + 1 < len) { unpack8(*(const u32x4*)(up + (size_t)(i + 1) * FF2), nv); unpack8(*(const u32x4*)(up + (size_t)(i + 1) * FF2 + FF), ng); }
            else {
#pragma unroll
                for (int e = 0; e < 8; ++e) { nv[e] = 0.f; ng[e] = 0.f; } }
            float o[8];
#pragma unroll
            for (int e = 0; e < 8; ++e) { const float a = pv[e] * wv[0][e] + cv[e] * wv[1][e] + nv[e] * wv[2][e] + bv[e]; const float g = pg[e] * wg[0][e] + cg[e] * wg[1][e] + ng[e] * wg[2][e] + bg[e];
                o[e] = a * g * sigmoidf_(g); pv[e] = cv[e]; pg[e] = cg[e]; cv[e] = nv[e]; cg[e] = ng[e]; }
            *(u32x4*)(ACT + (size_t)(r0 + i) * FF + c) = pack8(o);
        }
    }
}

enum { S_INIT = 0, S_NORM1, S_IN, S_PREP, S_LR, S_VRES, S_MIX, S_POST, S_GATE, S_MERGE, S_OUT, S_NORM2, S_UP, S_CONV, S_DOWN, S_NEXT, S_FINAL };
constexpr int NPH = 28;
__host__ __device__ inline int phase_code(int p) {
    if (p < 2) return p;
    if (p < 15) { const int s = p - 2; return (s < 3 ? S_IN + s : S_MIX + (s - 3)); }
    { const int s = p - 15; return 256 | (s < 3 ? S_IN + s : S_MIX + (s - 3)); }
}

#ifndef PROBE_MASK
#define PROBE_MASK 0
#endif
__host__ __device__ inline int stage_of_phase(int b) { int code = phase_code(b); int st = code & 255; if ((code >> 8) == 1 && st == S_NEXT) st = S_FINAL; return st; }
__host__ __device__ inline int expand_phase(int p, int& rep) {
    if (PROBE_MASK == 0) { rep = 0; return p; }
    int q = 0;
    for (int b = 0; b < NPH; ++b) { const int n = ((PROBE_MASK >> stage_of_phase(b)) & 1) ? 2 : 1; if (p < q + n) { rep = p - q; return b; } q += n; }
    rep = 0; return NPH - 1;
}
__global__ void __launch_bounds__(NTHREADS, 2) mega_fwd(Args args) {
    extern __shared__ __attribute__((aligned(16))) unsigned char lds_raw[];
    const Args& A = args;
    volatile LAS unsigned* MISC = (volatile LAS unsigned*)((LAS unsigned char*)lds_raw + MISC_OFF);
    if (threadIdx.x < 32) MISC[threadIdx.x] = 0u;
    __syncthreads();
    if ((threadIdx.x & 63) == 0) MISC[16 + (threadIdx.x >> 6)] = (unsigned)__builtin_amdgcn_s_getreg((1 << 11) | (4 << 6) | 4) & 3u;
    __syncthreads();
    if (threadIdx.x == 0) {
        unsigned seen = 0u, nr = 0u;
        for (int w = 0; w < 8; ++w) { const unsigned sd = MISC[16 + w]; if (!((seen >> sd) & 1u) && nr < 4u) { seen |= 1u << sd; MISC[24 + w] = nr++; } else MISC[24 + w] = 0xFFFFFFFFu; }
        for (int w = 0; w < 8; ++w) if (MISC[24 + w] == 0xFFFFFFFFu && nr < 4u) MISC[24 + w] = nr++;
    }
    __syncthreads();
    XcdBarrier bar; bar.bar = (unsigned*)(args.ws + O_CTL) + 4096; bar.x = 0; bar.st = nullptr;
    if (args.ph_hi - args.ph_lo > 1) bar = xcd_barrier_post((unsigned*)(args.ws + O_CTL) + 4096, MISC + 8);
    for (int p = args.ph_lo; p < args.ph_hi; ++p) {
        int rep = 0; int code = phase_code(expand_phase(p, rep)); const int layer = code >> 8; int st = code & 255;
        if (layer == 1 && st == S_NEXT) st = S_FINAL;
        const bool last = layer == 1;
        const int Mrows = last ? TL : TT;
        const int tid_ = lthread();
        size_t zoff_ = 0; asm volatile("" : "+s"(zoff_)); unsigned char* ws_ = args.ws + zoff_;
        Frame F; F.a = &args; F.ws = ws_; F.lds = (char*)lds_raw; F.tid = tid_; F.lane = F.tid & 63; F.wave = __builtin_amdgcn_readfirstlane(F.tid >> 6);
        F.gw = blockIdx.x * NWAVES + F.wave; F.ngw = gridDim.x * NWAVES;
        float* XC = (float*)(F.ws + O_XC);
        const float* MODB = (const float*)(F.ws + O_MOD);
        const float* mod = MODB + (size_t)layer * 5 * MODW;
        int njobs = 0;
        switch (st) {
        case S_INIT: adaln(F); convert_weights(F, 0); break;
        case S_NORM1: norm_rows(F, A.in[I_X], A.in[I_CTX], A.in[I_NORM1], mod, 0, 2048, TT); break;
        case S_PREP: rwkv_prep(F, layer); qk_prep(F, layer); break;
        case S_MIX: ph_mix(F, layer, rep); break;
        case S_POST: ph_post(F, layer); break;
        case S_NORM2: norm_rows(F, A.out, XC, A.in[I_NORM2] + layer * DM, mod, 3 * 2048, 4 * 2048, Mrows); break;
        case S_CONV: conv_act(F, layer, Mrows); break;
        case S_NEXT: convert_weights(F, 1); norm_rows(F, A.out, XC, A.in[I_NORM1] + DM, MODB + (size_t)5 * MODW, 0, 2048, TT); break;
        case S_FINAL: final_norm(F); break;
        case S_LR: njobs = layer == 1 ? 2 : 1; break;
        case S_MERGE: njobs = 3; break;
        default: njobs = 1; break;
        }
        for (int j = 0; j < njobs; ++j) {
            pg8::Gemm g; Epi e{}; e.ws = F.ws; e.layer = layer;
            switch (st) {
            case S_IN: e.mode = EM_ROUTE; g = pg8::Gemm{(const bf16_t*)(F.ws + O_H), (const bf16_t*)(F.ws + W_IN), TT, 6144, 2048}; break;
            case S_LR:
                if (j == 0) { e.mode = EM_LR; e.p0 = A.in[I_W0] + layer * 2 * RW; e.p1 = A.in[I_A0] + layer * 2 * RW; g = pg8::Gemm{(const bf16_t*)(F.ws + A_LR), (const bf16_t*)(F.ws + W_LR), TT, 3840, 256}; }
                else { e.mode = EM_VRES; e.p0 = A.in[I_V0]; g = pg8::Gemm{(const bf16_t*)(F.ws + A_YS), (const bf16_t*)(F.ws + W_V12), TT, 768, 768}; }
                break;
            case S_GATE: e.mode = EM_SIGMOID; e.O = (bf16_t*)(F.ws + A_GATES); e.ldc = 6144;
                g = pg8::Gemm{(const bf16_t*)(F.ws + O_H), (const bf16_t*)(F.ws + W_IN) + (size_t)6144 * 2048, Mrows, 6144, 2048}; break;
            case S_MERGE: e.mode = EM_MERGE; e.aux = j;
                g = pg8::Gemm{(const bf16_t*)(F.ws + (j == 0 ? A_YR : (j == 1 ? A_YG : A_YD))), (const bf16_t*)(F.ws + W_BR) + (size_t)j * 2048 * 768, Mrows, 2048, 768}; break;
            case S_OUT: e.mode = EM_RESID; e.aux = 2 * 2048; e.gmod = mod;
                e.xin_l = layer == 0 ? A.in[I_X] : A.out; e.xin_c = layer == 0 ? A.in[I_CTX] : XC; e.xout_l = A.out; e.xout_c = XC;
                g = pg8::Gemm{(const bf16_t*)(F.ws + O_H), (const bf16_t*)(F.ws + W_OUT), Mrows, 2048, 2048}; break;
            case S_UP: e.mode = EM_BF16; e.O = (bf16_t*)(F.ws + A_U); e.ldc = FF2;
                g = pg8::Gemm{(const bf16_t*)(F.ws + O_H), (const bf16_t*)(F.ws + W_UP), Mrows, FF2, 2048}; break;
            default: e.mode = EM_RESID; e.aux = 5 * 2048; e.gmod = mod; e.xin_l = A.out; e.xin_c = XC; e.xout_l = A.out; e.xout_c = XC;
                g = pg8::Gemm{(const bf16_t*)(F.ws + A_ACT), (const bf16_t*)(F.ws + W_DOWN), Mrows, 2048, FF}; break;
            }
            pg8::StaticOrder S; S.init(g.M, g.N, (int)gridDim.x, (int)blockIdx.x);
            pg8::gemm_phase<Epi, pg8::StaticOrder, true, true>((LAS unsigned char*)lds_raw, g, S, e);
            __syncthreads();
        }
        if (p + 1 < args.ph_hi) { if (args.ph_hi > 1000) { __threadfence(); cg::this_grid().sync(); }
            xcd_barrier(bar); }
    }
}

extern "C" void kernel_launch(void* const* d_in, const int* in_sizes, int n_in, void* d_out, int out_size, void* d_ws, size_t ws_size, hipStream_t stream) {
    static int grid = 0;
    if (grid == 0) {
        if (n_in != N_IN || out_size != TL * DM || ws_size < WS_NEED) { fprintf(stderr, "kernel_launch: unexpected shapes n_in %d out %d ws %zu (need %zu)\n", n_in, out_size, ws_size, (size_t)WS_NEED); grid = -1; return; }
        int dev = 0, cus = 0, per_cu = 0;
        hipGetDevice(&dev); hipDeviceGetAttribute(&cus, hipDeviceAttributeMultiprocessorCount, dev);
        if (hipFuncSetAttribute((const void*)mega_fwd, hipFuncAttributeMaxDynamicSharedMemorySize, LDS_BYTES) != hipSuccess) { fprintf(stderr, "kernel_launch: hipFuncSetAttribute failed\n"); grid = -1; return; }
        hipOccupancyMaxActiveBlocksPerMultiprocessor(&per_cu, (const void*)mega_fwd, NTHREADS, LDS_BYTES);
        (void)hipGetLastError();
        if (per_cu < 1) { fprintf(stderr, "kernel_launch: occupancy query says %d blocks/CU\n", per_cu); per_cu = 1; }
        grid = cus;
        if (grid > 256) grid = 256;
    }
    if (grid < 0) return;
    hipMemsetAsync((char*)d_ws + O_CTL, 0, CTL_BYTES, stream);
    Args a{};
    for (int i = 0; i < N_IN; ++i) a.in[i] = (const float*)d_in[i];
    a.out = (float*)d_out; a.ws = (unsigned char*)d_ws;
#if MK_ONE_LAUNCH
    { int nph = 0; for (int b = 0; b < NPH; ++b) nph += ((PROBE_MASK >> stage_of_phase(b)) & 1) ? 2 : 1; a.ph_lo = 0; a.ph_hi = nph; }
    void* kargs[] = {&a};
    hipError_t e = hipLaunchCooperativeKernel((const void*)mega_fwd, dim3(grid), dim3(NTHREADS), kargs, LDS_BYTES, stream);
    if (e != hipSuccess) fprintf(stderr, "kernel_launch: cooperative launch failed: %s\n", hipGetErrorString(e));
#else
    for (int p = 0; p < NPH; ++p) { a.ph_lo = p; a.ph_hi = p + 1; hipLaunchKernelGGL(mega_fwd, dim3(grid), dim3(NTHREADS), LDS_BYTES, stream, a); }
#endif
}
```

```cpp
#include <hip/hip_runtime.h>
#include <hip/hip_cooperative_groups.h>
#include <cstdio>
#include <cstdint>
namespace cg = cooperative_groups;
#ifndef MK_ONE_LAUNCH
#define MK_ONE_LAUNCH 1
#endif
__device__ __forceinline__ int lthread() { int t = threadIdx.x; asm volatile("" : "+v"(t)); return t; }
namespace pg8 {
#define PG8_LAS __attribute__((address_space(3)))
typedef unsigned short bf16_t;
typedef short bf16x8 __attribute__((ext_vector_type(8)));
typedef float f32x4 __attribute__((ext_vector_type(4)));
typedef unsigned u32x4 __attribute__((ext_vector_type(4)));
constexpr int BM = 256, BK = 64, HALF = 128, HTB = HALF * BK * 2  , STAGE_BYTES = 8 * HTB, NXCD = 8, WGM = 8;

__host__ __device__ __forceinline__ int lds_byte(int r, int c) { const int st = (r >> 4) * 2 + (c >> 5), rr = r & 15, cc = c & 31, ob = rr * 64 + cc * 2; return st * 1024 + (ob ^ (((ob >> 9) & 1) << 5)); }
__host__ __device__ __forceinline__ void stage_rc(int b, int& R, int& C) { const int st = b / 1024, sb = b % 1024, swz = sb ^ (((sb >> 9) & 1) << 5); R = (st >> 1) * 16 + swz / 64; C = (st & 1) * 32 + (swz % 64) / 2; }
__host__ __device__ __forceinline__ int perm32(int rho) { const int n = rho >> 4, i = rho & 15; return 8 * (i >> 2) + 4 * n + (i & 3); }

struct Unit { int pm, pn; };
struct Gemm { const bf16_t* A; const bf16_t* Bt; int M, N, K; };

struct StaticOrder {
    int nM, nN, nwg, G, c;
    __host__ __device__ void init(int M, int N, int G_, int c_) { nM = M / BM; nN = N / BM; nwg = nM * nN; G = G_; c = c_; }
    __host__ __device__ bool next(int i, Unit& u) const {
        const long L = (long)i * G + c; if (L >= nwg) return false;
        int wgid = (int)L; { const int q = nwg / NXCD, r = nwg % NXCD, xcd = wgid % NXCD, off = wgid / NXCD; wgid = (xcd < r ? xcd * (q + 1) : r * (q + 1) + (xcd - r) * q) + off; }
        const int nig = WGM * nN, gid = wgid / nig, fm = gid * WGM, gsz = (nM - fm) < WGM ? (nM - fm) : WGM;
        u.pm = fm + ((wgid % nig) % gsz); u.pn = (wgid % nig) / gsz; return true;
    }
    __device__ __forceinline__ void a_ready(const Unit&) const {}
    __device__ __forceinline__ void done(const Unit&) const {}
};

template <class Epi, class Sched, bool ALIGN_EPI = false, bool SP2 = false>
__device__ __forceinline__ void gemm_phase(PG8_LAS unsigned char* lds, const Gemm g, const Sched& S, const Epi& E) {
    const int tid = lthread(), wid = __builtin_amdgcn_readfirstlane(tid >> 6), lane = tid & 63, wr = wid >> 2, wc = wid & 3, fr = lane & 15, fq = lane >> 4;
    const int K = g.K, nt = K / BK;
    unsigned voffA[2], voffB[2];
#pragma unroll
    for (int i = 0; i < 2; ++i) { int R, C; stage_rc(tid * 16 + i * 8192, R, C); const int Rb = Epi::PERM ? ((R & ~31) + perm32(R & 31)) : R;
        voffA[i] = (unsigned)(R * K + C) * 2u; voffB[i] = (unsigned)(Rb * K + C) * 2u; }
    const size_t kstep = (size_t)(BK * 2);
    const size_t hstep = (size_t)HALF * K * 2;
    const size_t tstep = 2 * hstep;
    const unsigned ldsw = (unsigned)wid * 1024u;
    const int aoff = lds_byte(wr * 64 + fr, fq * 8), boff = lds_byte(wc * 32 + fr, fq * 8);
#define PG8_SA(b, h) (((b) * 2 + (h)) * HTB)
#define PG8_SB(b, h) ((4 + (b) * 2 + (h)) * HTB)
#define PG8_STAGE(bufoff, gbase, voff) do { _Pragma("unroll") for (int _i = 0; _i < 2; ++_i) \
        __builtin_amdgcn_global_load_lds((const unsigned*)((const char*)(gbase) + (voff)[_i]), (PG8_LAS unsigned*)(lds + (bufoff) + ldsw + _i * 8192), 16, 0, 0); } while (0)
#define PG8_LDA(dst, b, h) do { _Pragma("unroll") for (int m = 0; m < 4; ++m) _Pragma("unroll") for (int k = 0; k < 2; ++k) dst[m][k] = *(const PG8_LAS bf16x8*)(lds + PG8_SA(b, h) + aoff + m * 2048 + k * 1024); } while (0)
#define PG8_LDB(dst, b, h) do { _Pragma("unroll") for (int n = 0; n < 2; ++n) _Pragma("unroll") for (int k = 0; k < 2; ++k) dst[n][k] = *(const PG8_LAS bf16x8*)(lds + PG8_SB(b, h) + boff + n * 2048 + k * 1024); } while (0)
#define PG8_MMA(ai, bj, At, Bt) do { __builtin_amdgcn_s_setprio(1); _Pragma("unroll") for (int m = 0; m < 4; ++m) _Pragma("unroll") for (int n = 0; n < 2; ++n) _Pragma("unroll") for (int k = 0; k < 2; ++k) \
        acc[ai][bj][m][n] = __builtin_amdgcn_mfma_f32_16x16x32_bf16(Bt[n][k], At[m][k], acc[ai][bj][m][n], 0, 0, 0); __builtin_amdgcn_s_setprio(0); } while (0)
#define PG8_WAIT_V(n) asm volatile("s_waitcnt vmcnt(" #n ")" ::: "memory")
#define PG8_WAIT_L(n) asm volatile("s_waitcnt lgkmcnt(" #n ")" ::: "memory")
#define PG8_BAR __builtin_amdgcn_s_barrier()
#define PG8_SCHED __builtin_amdgcn_sched_barrier(0)
    Unit cur, nxt; int ui = 0;
    if (!S.next(0, cur)) return;
    f32x4 acc[2][2][4][2];
#pragma unroll
    for (int a = 0; a < 2; ++a)
#pragma unroll
        for (int b = 0; b < 2; ++b)
#pragma unroll
            for (int m = 0; m < 4; ++m)
#pragma unroll
                for (int n = 0; n < 2; ++n) acc[a][b][m][n] = (f32x4){0.f, 0.f, 0.f, 0.f};
    bf16x8 At[4][2], B0[2][2], B1[2][2];
    const char* cA = (const char*)g.A + (size_t)cur.pm * tstep; const char* cB = (const char*)g.Bt + (size_t)cur.pn * tstep;
    S.a_ready(cur);
    if constexpr (SP2) {
        PG8_STAGE(PG8_SB(0, 0), cB, voffB); PG8_STAGE(PG8_SB(0, 1), cB + hstep, voffB); PG8_STAGE(PG8_SA(0, 0), cA, voffA); PG8_STAGE(PG8_SA(0, 1), cA + hstep, voffA);
        if (wr == 1) PG8_BAR;
        PG8_WAIT_V(2); PG8_BAR;
        PG8_STAGE(PG8_SB(1, 0), cB + kstep, voffB); PG8_STAGE(PG8_SA(1, 0), cA + kstep, voffA); PG8_STAGE(PG8_SB(1, 1), cB + hstep + kstep, voffB);
        PG8_WAIT_V(6); PG8_BAR;
    } else {
        PG8_STAGE(PG8_SB(0, 0), cB, voffB); PG8_STAGE(PG8_SA(0, 0), cA, voffA); PG8_STAGE(PG8_SB(0, 1), cB + hstep, voffB); PG8_STAGE(PG8_SA(0, 1), cA + hstep, voffA);
        if (wr == 1) PG8_BAR;
        PG8_WAIT_V(4); PG8_BAR;
        PG8_STAGE(PG8_SB(1, 0), cB + kstep, voffB); PG8_STAGE(PG8_SA(1, 0), cA + kstep, voffA); PG8_STAGE(PG8_SB(1, 1), cB + hstep + kstep, voffB);
        PG8_WAIT_V(6); PG8_BAR;
    }
    for (;;) {
        const bool has_next = S.next(ui + 1, nxt);
        const char* nA = has_next ? (const char*)g.A + (size_t)nxt.pm * tstep : cA; const char* nB = has_next ? (const char*)g.Bt + (size_t)nxt.pn * tstep : cB;
        for (int t = 0; t < nt; t += 2) {
            const bool last = (t == nt - 2);
            const char* a1 = cA + (size_t)(t + 1) * kstep;
            const char* a2 = last ? nA : cA + (size_t)(t + 2) * kstep; const char* b2 = last ? nB : cB + (size_t)(t + 2) * kstep;
            const char* a3 = a2 + kstep; const char* b3 = b2 + kstep;
            if (last && has_next) S.a_ready(nxt);
            if constexpr (SP2) {
            PG8_LDB(B0, 0, 0); PG8_LDB(B1, 0, 1); PG8_SCHED; PG8_LDA(At, 0, 0); PG8_STAGE(PG8_SA(1, 1), a1 + hstep, voffA);
            PG8_WAIT_V(8); PG8_WAIT_L(0); PG8_BAR; PG8_MMA(0, 0, At, B0); PG8_MMA(0, 1, At, B1); PG8_BAR; PG8_SCHED;
            PG8_LDA(At, 0, 1); PG8_STAGE(PG8_SB(0, 0), b2, voffB); PG8_STAGE(PG8_SB(0, 1), b2 + hstep, voffB); PG8_STAGE(PG8_SA(0, 0), a2, voffA);
            PG8_WAIT_V(8); PG8_WAIT_L(0); PG8_BAR; PG8_MMA(1, 0, At, B0); PG8_MMA(1, 1, At, B1); PG8_BAR; PG8_SCHED;
            PG8_LDB(B0, 1, 0); PG8_LDB(B1, 1, 1); PG8_SCHED; PG8_LDA(At, 1, 0); PG8_STAGE(PG8_SA(0, 1), a2 + hstep, voffA);
            PG8_WAIT_V(8); PG8_WAIT_L(0); PG8_BAR; PG8_MMA(0, 0, At, B0); PG8_MMA(0, 1, At, B1); PG8_BAR; PG8_SCHED;
            PG8_LDA(At, 1, 1); PG8_STAGE(PG8_SB(1, 0), b3, voffB); PG8_STAGE(PG8_SB(1, 1), b3 + hstep, voffB); PG8_STAGE(PG8_SA(1, 0), a3, voffA);
            PG8_WAIT_V(8); PG8_WAIT_L(0); PG8_BAR; PG8_MMA(1, 0, At, B0); PG8_MMA(1, 1, At, B1); PG8_BAR; PG8_SCHED;
            } else {
            PG8_LDB(B0, 0, 0); PG8_SCHED; PG8_LDA(At, 0, 0); PG8_STAGE(PG8_SA(1, 1), a1 + hstep, voffA);
            PG8_WAIT_L(8); PG8_BAR; PG8_WAIT_L(0); PG8_MMA(0, 0, At, B0); PG8_BAR; PG8_SCHED;
            PG8_LDB(B1, 0, 1); PG8_STAGE(PG8_SB(0, 0), b2, voffB);
            PG8_BAR; PG8_WAIT_L(0); PG8_MMA(0, 1, At, B1); PG8_BAR;
            PG8_LDA(At, 0, 1); PG8_STAGE(PG8_SA(0, 0), a2, voffA);
            PG8_BAR; PG8_WAIT_L(0); PG8_MMA(1, 0, At, B0); PG8_BAR; PG8_SCHED;
            PG8_STAGE(PG8_SB(0, 1), b2 + hstep, voffB);
            PG8_WAIT_V(6); PG8_BAR; PG8_MMA(1, 1, At, B1); PG8_BAR;
            PG8_LDB(B0, 1, 0); PG8_SCHED; PG8_LDA(At, 1, 0); PG8_STAGE(PG8_SA(0, 1), a2 + hstep, voffA);
            PG8_WAIT_L(8); PG8_BAR; PG8_WAIT_L(0); PG8_MMA(0, 0, At, B0); PG8_BAR; PG8_SCHED;
            PG8_LDB(B1, 1, 1); PG8_STAGE(PG8_SB(1, 0), b3, voffB);
            PG8_BAR; PG8_WAIT_L(0); PG8_MMA(0, 1, At, B1); PG8_BAR;
            PG8_LDA(At, 1, 1); PG8_STAGE(PG8_SA(1, 0), a3, voffA);
            PG8_BAR; PG8_WAIT_L(0); PG8_MMA(1, 0, At, B0); PG8_BAR; PG8_SCHED;
            PG8_STAGE(PG8_SB(1, 1), b3 + hstep, voffB);
            PG8_WAIT_V(6); PG8_BAR; PG8_MMA(1, 1, At, B1); PG8_BAR;
            }
        }
        if constexpr (ALIGN_EPI) { if (wr == 0) PG8_BAR; }
        if constexpr (!Epi::AFTER_DRAIN) { E(acc, cur, wr, wc, fr, fq); S.done(cur); }
        if (!has_next) break;
#pragma unroll
        for (int a = 0; a < 2; ++a)
#pragma unroll
            for (int b = 0; b < 2; ++b)
#pragma unroll
                for (int m = 0; m < 4; ++m)
#pragma unroll
                    for (int n = 0; n < 2; ++n) acc[a][b][m][n] = (f32x4){0.f, 0.f, 0.f, 0.f};
        cur = nxt; cA = nA; cB = nB; ++ui;
        if constexpr (ALIGN_EPI) { if (wr == 1) PG8_BAR; }
    }
    PG8_WAIT_V(0);
    if constexpr (!ALIGN_EPI) { if (wr == 0) PG8_BAR; }
    PG8_BAR;
    if constexpr (Epi::AFTER_DRAIN) { E.fused(acc, cur, wr, wc, fr, fq, lds, wid, lane); S.done(cur); }
#undef PG8_SA
#undef PG8_SB
#undef PG8_STAGE
#undef PG8_LDA
#undef PG8_LDB
#undef PG8_MMA
#undef PG8_WAIT_V
#undef PG8_WAIT_L
#undef PG8_BAR
#undef PG8_SCHED
}
}

#define LAS __attribute__((address_space(3)))
typedef unsigned short bf16_t;
typedef float f32x4 __attribute__((ext_vector_type(4)));
typedef float f32x2 __attribute__((ext_vector_type(2)));
typedef unsigned u32x4 __attribute__((ext_vector_type(4)));
typedef unsigned u32x2 __attribute__((ext_vector_type(2)));
typedef short bf16x8 __attribute__((ext_vector_type(8)));

constexpr int DM = 2048, NB = 4, SEQ = 4096, CTX = 256, TL = NB * SEQ, TC = NB * CTX, TT = TL + TC, KVS = CTX + SEQ;
constexpr int RW = 768, RCOLS = 2560, FF = 5504, FF2 = 11008, MODW = 12288;
constexpr int NTHREADS = 512, NWAVES = 8;

enum { I_X = 0, I_C, I_CTX, I_CCTX, I_WMOD, I_BMOD, I_NORM1, I_WIN, I_MU, I_W0, I_W2, I_A0, I_A2, I_KK, I_KA, I_RK, I_G2, I_LNW, I_LNB,
       I_V0, I_V1, I_V2, I_QN, I_KN, I_LQ1, I_LK1, I_LQ2, I_LK2, I_SUBLN, I_WBR, I_WBG, I_WBD, I_WOUT, I_NORM2, I_UP, I_CW, I_CB, I_DOWN, I_FN, N_IN };

#define XB_TMO      128
#define XB_XCNT(j)  (256  + 64 * (j))
#define XB_XSUB(j)  (1280 + 64 * (j))
#define XB_XGEN(j)  (2304 + 64 * (j))
#define XB_TOP      3328
#define XB_TOPGEN   3392
#define XCD_BAR_WORDS 3456
#define XB_SPIN_CAP (1u << 18)

__device__ __forceinline__ unsigned xb_ld(unsigned* p)              { return __hip_atomic_load(p, __ATOMIC_RELAXED, __HIP_MEMORY_SCOPE_AGENT); }
__device__ __forceinline__ unsigned xb_add(unsigned* p, unsigned v) { return __hip_atomic_fetch_add(p, v, __ATOMIC_RELAXED, __HIP_MEMORY_SCOPE_AGENT); }
__device__ __forceinline__ unsigned xb_xcc_id() { return (unsigned)__builtin_amdgcn_s_getreg((3 << 11) | 20) & 0xFu; }
#define XB_SPIN(cond, bar) do { unsigned _sp = 0; while (cond) { __builtin_amdgcn_s_sleep(1); \
    if ((++_sp & 255u) == 0u) { if (xb_ld(&(bar)[XB_TMO])) break; if (_sp > XB_SPIN_CAP) { atomicAdd(&(bar)[XB_TMO], 1u); break; } } } } while (0)

struct XcdBarrier {
    unsigned* bar; unsigned x;
    volatile LAS unsigned* st;
};

__device__ __forceinline__ XcdBarrier xcd_barrier_post(unsigned* bar, volatile LAS unsigned* st) {
    XcdBarrier b; b.bar = bar; b.x = xb_xcc_id(); b.st = st;
    if (threadIdx.x == 0) (void)xb_add(&bar[XB_XCNT(b.x)], 1u);
    return b;
}
__device__ __forceinline__ void xcd_barrier_complete(unsigned* bar, unsigned x, unsigned& nloc, unsigned& nx) {
    const unsigned G = gridDim.x * gridDim.y * gridDim.z;
    unsigned sum, cnt, mine, sp = 0u;
    for (;;) {
        sum = 0u; cnt = 0u; mine = 0u;
#pragma unroll
        for (unsigned j = 0; j < 16; ++j) { const unsigned c = xb_ld(&bar[XB_XCNT(j)]); sum += c; cnt += (c > 0u) ? 1u : 0u; mine = (j == x) ? c : mine; }
        if (sum == G) break;
        __builtin_amdgcn_s_sleep(1);
        if ((++sp & 255u) == 0u) { if (xb_ld(&bar[XB_TMO])) break; if (sp > XB_SPIN_CAP) { atomicAdd(&bar[XB_TMO], 1u); break; } }
    }
    nloc = mine > 0u ? mine : 1u; nx = cnt > 0u ? cnt : 1u;
}

__device__ __forceinline__ void xcd_barrier(const XcdBarrier& b) {
    asm volatile("s_waitcnt vmcnt(0)" ::: "memory");
    __syncthreads();
    if (threadIdx.x == 0) {
        unsigned* bar = b.bar;
        __builtin_amdgcn_s_waitcnt(0);
        unsigned nloc = b.st[0], nx = b.st[1];
        if (nloc == 0u) { xcd_barrier_complete(bar, b.x, nloc, nx); b.st[0] = nloc; b.st[1] = nx; }
        const unsigned old = xb_add(&bar[XB_XSUB(b.x)], 1u);
        const unsigned gen = old / nloc;
        if (old + 1u == (gen + 1u) * nloc) {
            __builtin_amdgcn_fence(__ATOMIC_RELEASE, "agent");
            asm volatile("s_waitcnt vmcnt(0)" ::: "memory");
            const unsigned og = xb_add(&bar[XB_TOP], 1u);
            const unsigned tg = og / nx;
            if (og + 1u == (tg + 1u) * nx) xb_add(&bar[XB_TOPGEN], 1u);
            else XB_SPIN(xb_ld(&bar[XB_TOPGEN]) == tg, bar);
            __builtin_amdgcn_fence(__ATOMIC_ACQUIRE, "agent");
            xb_add(&bar[XB_XGEN(b.x)], 1u);
            asm volatile("s_waitcnt vmcnt(0)" ::: "memory");
        } else {
            XB_SPIN(xb_ld(&bar[XB_XGEN(b.x)]) == gen, bar);
            __builtin_amdgcn_fence(__ATOMIC_ACQUIRE, "agent");
            asm volatile("s_waitcnt vmcnt(0)" ::: "memory");
        }
    }
    __syncthreads();
}

constexpr size_t MiB = 1u << 20, HMiB = 1u << 19;
constexpr size_t O_CTL = 0, CTL_BYTES = 65536, O_MOD = 1 * MiB, O_XC = 2 * MiB;
constexpr size_t W_IN = 10 * MiB, W_BR = W_IN + 48 * MiB, W_OUT = W_BR + 9 * MiB, W_UP = W_OUT + 8 * MiB, W_DOWN = W_UP + 43 * MiB,
                 W_LR = W_DOWN + 22 * MiB, W_V12 = W_LR + (size_t)3840 * 256 * 2;
constexpr size_t O_H = 143 * MiB, O_VF = 211 * MiB, O_AR = 237 * MiB;
static_assert(W_V12 + (size_t)768 * 768 * 2 == O_H, "weight map");
constexpr size_t A_QG = O_AR, A_KG = O_AR + 51 * HMiB, A_VG = O_AR + 68 * HMiB, A_DQ = O_AR + 85 * HMiB, A_DK = O_AR + 136 * HMiB, A_DV = O_AR + 187 * HMiB;
constexpr size_t A_PR = O_AR + 238 * HMiB, A_EW = A_PR, A_AS = O_AR + 340 * HMiB, A_G = O_AR + 442 * HMiB;
constexpr size_t A_R = O_AR + 493 * HMiB, A_K = O_AR + 544 * HMiB, A_V = O_AR + 595 * HMiB, A_KKN = O_AR + 646 * HMiB;
constexpr size_t A_LR = O_AR + 697 * HMiB, A_T1 = O_AR + 714 * HMiB;
constexpr size_t A_YS = O_AR + 731 * HMiB, A_OD = O_AR + 935 * HMiB, A_YG = O_AR + 1139 * HMiB, A_END1 = O_AR + 1190 * HMiB;
constexpr size_t A_YR = O_AR, A_YD = O_AR + 51 * HMiB, A_GATES = A_PR;
constexpr size_t A_U = O_AR, A_ACT = O_AR + 731 * HMiB;
constexpr size_t WS_NEED = A_END1;
static_assert((size_t)TT * 768 * 2 == 51 * HMiB && (size_t)TT * 2048 * 2 == 68 * MiB && (size_t)TT * FF2 * 2 == 731 * HMiB, "sizes");
static_assert(A_ACT + (size_t)TT * FF * 2 <= A_END1 && A_GATES + (size_t)TT * 6144 * 2 <= A_KKN, "overlays");

__device__ __forceinline__ float bf2f(unsigned v) { return __uint_as_float(v << 16); }
__device__ __forceinline__ unsigned cvt_pk_bf16(float lo, float hi) { unsigned r; asm volatile("v_cvt_pk_bf16_f32 %0, %1, %2" : "=v"(r) : "v"(lo), "v"(hi)); return r; }
__device__ __forceinline__ unsigned f2bf(float f) { return cvt_pk_bf16(f, 0.f) & 0xffffu; }
__device__ __forceinline__ float wave_sum(float v) {
    v += __int_as_float(__builtin_amdgcn_update_dpp(0, __float_as_int(v), 0xB1, 0xF, 0xF, true));
    v += __int_as_float(__builtin_amdgcn_update_dpp(0, __float_as_int(v), 0x4E, 0xF, 0xF, true));
    v += __int_as_float(__builtin_amdgcn_update_dpp(0, __float_as_int(v), 0x141, 0xF, 0xF, true));
    v += __int_as_float(__builtin_amdgcn_update_dpp(0, __float_as_int(v), 0x140, 0xF, 0xF, true));
    { auto r16 = __builtin_amdgcn_permlane16_swap(__float_as_uint(v), __float_as_uint(v), false, false); v = __uint_as_float(r16[0]) + __uint_as_float(r16[1]); }
    { auto r32 = __builtin_amdgcn_permlane32_swap(__float_as_uint(v), __float_as_uint(v), false, false); v = __uint_as_float(r32[0]) + __uint_as_float(r32[1]); }
    return v;
}
__device__ __forceinline__ float sigmoidf_(float x) { return 1.f / (1.f + __expf(-x)); }
__device__ __forceinline__ void unpack8(u32x4 w, float* f) {
    f[0] = bf2f(w.x & 0xffffu); f[1] = __uint_as_float(w.x & 0xffff0000u); f[2] = bf2f(w.y & 0xffffu); f[3] = __uint_as_float(w.y & 0xffff0000u);
    f[4] = bf2f(w.z & 0xffffu); f[5] = __uint_as_float(w.z & 0xffff0000u); f[6] = bf2f(w.w & 0xffffu); f[7] = __uint_as_float(w.w & 0xffff0000u);
}
__device__ __forceinline__ u32x4 pack8(const float* f) { u32x4 w; w.x = cvt_pk_bf16(f[0], f[1]); w.y = cvt_pk_bf16(f[2], f[3]); w.z = cvt_pk_bf16(f[4], f[5]); w.w = cvt_pk_bf16(f[6], f[7]); return w; }

enum { EM_ROUTE = 0, EM_BF16, EM_SIGMOID, EM_LR, EM_VRES, EM_MERGE, EM_RESID };
struct Epi {
    static constexpr bool PERM = true, AFTER_DRAIN = false;
    int mode, ldc, aux, layer;
    unsigned char* ws; bf16_t* O; const float* p0; const float* p1;
    const float* xin_l; const float* xin_c; float* xout_l; float* xout_c; const float* gmod;
    __device__ __forceinline__ void operator()(const f32x4 (&acc)[2][2][4][2], const pg8::Unit& u, int wr, int wc, int fr, int fq) const {
        int fr_ = fr, fq_ = fq; asm volatile("" : "+v"(fr_), "+v"(fq_));
        size_t zoff_ = 0; asm volatile("" : "+s"(zoff_)); unsigned char* ws = this->ws + zoff_;
        const int rt = wr * 64 + fr_, ct = wc * 32 + 8 * fq_;
        if (mode == EM_ROUTE) {
            const int pn = u.pn, pm = u.pm;
            const int kvrow = pm < 64 ? ((pm >> 4) * KVS + CTX + (pm & 15) * 256) : ((pm - 64) * KVS);
            const int nat = pm * 256;
            size_t off; int ld, rowbase, colb;
            if (pn < 10) { off = A_PR; ld = 2560; rowbase = nat; colb = pn * 256; }
            else if (pn < 13) { off = A_QG; ld = 768; rowbase = nat; colb = (pn - 10) * 256; }
            else if (pn == 13) { off = A_KG; ld = 256; rowbase = kvrow; colb = 0; }
            else if (pn == 14) { off = A_VG; ld = 256; rowbase = kvrow; colb = 0; }
            else if (pn < 18) { off = A_DQ; ld = 768; rowbase = nat; colb = (pn - 15) * 256; }
            else if (pn < 21) { off = A_DK; ld = 768; rowbase = kvrow; colb = (pn - 18) * 256; }
            else { off = A_DV; ld = 768; rowbase = kvrow; colb = (pn - 21) * 256; }
            bf16_t* base = (bf16_t*)(ws + off) + (size_t)(rowbase + rt) * ld + colb + ct;
#pragma unroll
            for (int ai = 0; ai < 2; ++ai)
#pragma unroll
                for (int m = 0; m < 4; ++m) { bf16_t* rp = base + (size_t)(ai * 128 + m * 16) * ld;
#pragma unroll
                    for (int bj = 0; bj < 2; ++bj) { const f32x4 v0 = acc[ai][bj][m][0], v1 = acc[ai][bj][m][1]; u32x4 w;
                        w.x = cvt_pk_bf16(v0[0], v0[1]); w.y = cvt_pk_bf16(v0[2], v0[3]); w.z = cvt_pk_bf16(v1[0], v1[1]); w.w = cvt_pk_bf16(v1[2], v1[3]);
                        *(u32x4*)(rp + bj * 128) = w; } }
        } else if (mode == EM_BF16 || mode == EM_SIGMOID) {
            bf16_t* base = O + (size_t)(u.pm * 256 + rt) * ldc + u.pn * 256 + ct;
            const bool sg = mode == EM_SIGMOID;
#pragma unroll
            for (int ai = 0; ai < 2; ++ai)
#pragma unroll
                for (int m = 0; m < 4; ++m) { bf16_t* rp = base + (size_t)(ai * 128 + m * 16) * ldc;
#pragma unroll
                    for (int bj = 0; bj < 2; ++bj) { f32x4 v0 = acc[ai][bj][m][0], v1 = acc[ai][bj][m][1];
                        if (sg) {
#pragma unroll
                            for (int e = 0; e < 4; ++e) { v0[e] = sigmoidf_(v0[e]); v1[e] = sigmoidf_(v1[e]); } }
                        u32x4 w; w.x = cvt_pk_bf16(v0[0], v0[1]); w.y = cvt_pk_bf16(v0[2], v0[3]); w.z = cvt_pk_bf16(v1[0], v1[1]); w.w = cvt_pk_bf16(v1[2], v1[3]);
                        *(u32x4*)(rp + bj * 128) = w; } }
        } else if (mode == EM_LR) {
            const int seg = u.pn / 3, c768 = (u.pn % 3) * 256 + ct;
            const float* par = seg < 2 ? (p0 + seg * 768) : (seg < 4 ? (p1 + (seg - 2) * 768) : nullptr);
            bf16_t* base = (bf16_t*)(ws + (seg < 2 ? A_EW + (size_t)seg * TT * 768 * 2 : (seg < 4 ? A_AS + (size_t)(seg - 2) * TT * 768 * 2 : A_G))) + (size_t)(u.pm * 256 + rt) * 768 + c768;
            const float mul = seg < 2 ? 0.60653065971263342f : 1.f;
#pragma unroll
            for (int bj = 0; bj < 2; ++bj) {
                f32x4 pa = {0.f, 0.f, 0.f, 0.f}, pb = pa;
                if (par) { pa = *(const f32x4*)(par + c768 + bj * 128); pb = *(const f32x4*)(par + c768 + bj * 128 + 4); }
#pragma unroll
                for (int ai = 0; ai < 2; ++ai)
#pragma unroll
                    for (int m = 0; m < 4; ++m) { f32x4 v0 = acc[ai][bj][m][0] + pa, v1 = acc[ai][bj][m][1] + pb;
                        if (par) {
#pragma unroll
                            for (int e = 0; e < 4; ++e) { v0[e] = mul * sigmoidf_(v0[e]); v1[e] = mul * sigmoidf_(v1[e]); } }
                        u32x4 w; w.x = cvt_pk_bf16(v0[0], v0[1]); w.y = cvt_pk_bf16(v0[2], v0[3]); w.z = cvt_pk_bf16(v1[0], v1[1]); w.w = cvt_pk_bf16(v1[2], v1[3]);
                        *(u32x4*)(base + (size_t)(ai * 128 + m * 16) * 768 + bj * 128) = w; } }
        } else if (mode == EM_VRES) {
            const int c0 = u.pn * 256 + ct;
            bf16_t* V = (bf16_t*)(ws + A_V); const bf16_t* VS = (const bf16_t*)(ws + A_YS); const bf16_t* VF = (const bf16_t*)(ws + O_VF);
#pragma unroll
            for (int bj = 0; bj < 2; ++bj) {
                const f32x4 pa = *(const f32x4*)(p0 + c0 + bj * 128), pb = *(const f32x4*)(p0 + c0 + bj * 128 + 4);
#pragma unroll
                for (int ai = 0; ai < 2; ++ai)
#pragma unroll
                    for (int m = 0; m < 4; ++m) { const size_t o = (size_t)(u.pm * 256 + rt + ai * 128 + m * 16) * 768 + c0 + bj * 128;
                        float vs[8], vf[8], r[8]; unpack8(*(const u32x4*)(VS + o), vs); unpack8(*(const u32x4*)(VF + o), vf);
                        const f32x4 v0 = acc[ai][bj][m][0] + pa, v1 = acc[ai][bj][m][1] + pb;
#pragma unroll
                        for (int e = 0; e < 4; ++e) { r[e] = vs[e] + (vf[e] - vs[e]) * sigmoidf_(v0[e]); r[4 + e] = vs[4 + e] + (vf[4 + e] - vs[4 + e]) * sigmoidf_(v1[e]); }
                        *(u32x4*)(V + o) = pack8(r); } }
        } else if (mode == EM_MERGE) {
            const bf16_t* GT = (const bf16_t*)(ws + A_GATES); bf16_t* Mb = (bf16_t*)(ws + O_H);
            const int c0 = u.pn * 256 + ct;
#pragma unroll
            for (int ai = 0; ai < 2; ++ai) {
                u32x4 gv[4][2], mv[4][2];
#pragma unroll
                for (int m = 0; m < 4; ++m)
#pragma unroll
                    for (int bj = 0; bj < 2; ++bj) { const size_t row = (size_t)(u.pm * 256 + rt + ai * 128 + m * 16); const int c = c0 + bj * 128;
                        gv[m][bj] = *(const u32x4*)(GT + row * 6144 + aux * 2048 + c);
                        if (aux > 0) mv[m][bj] = *(const u32x4*)(Mb + row * 2048 + c); else mv[m][bj] = (u32x4){0u, 0u, 0u, 0u}; }
                asm volatile("" ::: "memory");
#pragma unroll
                for (int m = 0; m < 4; ++m)
#pragma unroll
                    for (int bj = 0; bj < 2; ++bj) { const size_t row = (size_t)(u.pm * 256 + rt + ai * 128 + m * 16); const int c = c0 + bj * 128;
                        float g[8], o[8], r[8]; unpack8(gv[m][bj], g); unpack8(mv[m][bj], o);
                        const f32x4 v0 = acc[ai][bj][m][0], v1 = acc[ai][bj][m][1];
#pragma unroll
                        for (int e2 = 0; e2 < 4; ++e2) { r[e2] = g[e2] * v0[e2] + o[e2]; r[4 + e2] = g[4 + e2] * v1[e2] + o[4 + e2]; }
                        *(u32x4*)(Mb + row * 2048 + c) = pack8(r); }
                asm volatile("" ::: "memory");
            }
        } else {
            const int c0 = u.pn * 256 + ct;
            const bool lat = u.pm < 64;
            const int cond = lat ? (u.pm >> 4) : 4;
            const float* gp = gmod + (size_t)cond * MODW + aux + c0;
            const float* xi = lat ? xin_l + (size_t)(u.pm * 256) * DM : xin_c + (size_t)((u.pm - 64) * 256) * DM;
            float* xo = lat ? xout_l + (size_t)(u.pm * 256) * DM : xout_c + (size_t)((u.pm - 64) * 256) * DM;
            f32x4 ga[2], gb[2];
#pragma unroll
            for (int bj = 0; bj < 2; ++bj) { ga[bj] = *(const f32x4*)(gp + bj * 128); gb[bj] = *(const f32x4*)(gp + bj * 128 + 4); }
#pragma unroll
            for (int ai = 0; ai < 2; ++ai) {
                f32x4 xa[4][2], xb[4][2];
#pragma unroll
                for (int m = 0; m < 4; ++m)
#pragma unroll
                    for (int bj = 0; bj < 2; ++bj) { const size_t o = (size_t)(rt + ai * 128 + m * 16) * DM + c0 + bj * 128; xa[m][bj] = *(const f32x4*)(xi + o); xb[m][bj] = *(const f32x4*)(xi + o + 4); }
                asm volatile("" ::: "memory");
#pragma unroll
                for (int m = 0; m < 4; ++m)
#pragma unroll
                    for (int bj = 0; bj < 2; ++bj) { const size_t o = (size_t)(rt + ai * 128 + m * 16) * DM + c0 + bj * 128;
                        *(f32x4*)(xo + o) = xa[m][bj] + ga[bj] * acc[ai][bj][m][0]; *(f32x4*)(xo + o + 4) = xb[m][bj] + gb[bj] * acc[ai][bj][m][1]; }
                asm volatile("" ::: "memory");
            }
        }
    }
};

namespace att {
using s16x4 = __attribute__((ext_vector_type(4))) short;
using f32x16 = __attribute__((ext_vector_type(16))) float;
constexpr int NW = 8, QBLK = 32, KVBLK = 64;
constexpr float THR = 8.f;
#ifndef ATT_SDEPTH
#define ATT_SDEPTH 1
#endif
constexpr int SDEPTH = ATT_SDEPTH;
constexpr size_t SHM_V = KVBLK * 128 * 2, SHM_KMAX = KVBLK * 128 * 2, SHM_ATTN = 2 * SHM_V + 2 * SHM_KMAX + NW * 64 * 4;
#define SBAR() __builtin_amdgcn_sched_barrier(0)
template <int DQK> __device__ __forceinline__ int kswz(int row, int colB) { return row * (DQK * 2) + (colB ^ ((DQK == 128 ? (row & 15) : ((row >> 1) & 7)) << 4)); }
__device__ __forceinline__ int crow(int r, int hi) { return (r & 3) + 8 * (r >> 2) + 4 * hi; }
__device__ __forceinline__ void partialSM(f32x16& p0, f32x16& p1, float& m_reg, float& mn, float& alpha, const float C, const float thr_raw) {
    float pmax = p0[0];
#pragma unroll
    for (int r = 1; r < 16; ++r) pmax = fmaxf(pmax, p0[r]);
#pragma unroll
    for (int r = 0; r < 16; ++r) pmax = fmaxf(pmax, p1[r]);
    { auto rr = __builtin_amdgcn_permlane32_swap(__float_as_uint(pmax), __float_as_uint(pmax), false, false);
      pmax = fmaxf(__uint_as_float(rr[0]), __uint_as_float(rr[1])); }
    if (__builtin_expect(__all(pmax - m_reg <= thr_raw), 1)) { mn = m_reg; alpha = 1.f; }
    else { mn = fmaxf(m_reg, pmax); alpha = __builtin_amdgcn_exp2f((m_reg - mn) * C); m_reg = mn; }
    const float mnC = -mn * C;
#pragma unroll
    for (int r = 0; r < 16; ++r) p0[r] = fmaf(p0[r], C, mnC);
#pragma unroll
    for (int r = 0; r < 16; ++r) p1[r] = fmaf(p1[r], C, mnC);
#pragma unroll
    for (int r = 0; r < 16; ++r) p0[r] = __builtin_amdgcn_exp2f(p0[r]);
}
__device__ __forceinline__ void finishSM(f32x16& p0, f32x16& p1, float alpha, float& l_reg, bf16x8& pa0, bf16x8& pa1, bf16x8& pa2, bf16x8& pa3) {
#pragma unroll
    for (int r = 0; r < 16; ++r) p1[r] = __builtin_amdgcn_exp2f(p1[r]);
    float ps = 0;
#pragma unroll
    for (int r = 0; r < 16; ++r) ps += p0[r];
#pragma unroll
    for (int r = 0; r < 16; ++r) ps += p1[r];
    { auto rr = __builtin_amdgcn_permlane32_swap(__float_as_uint(ps), __float_as_uint(ps), false, false);
      ps = __uint_as_float(rr[0]) + __uint_as_float(rr[1]); }
    l_reg = l_reg * alpha + ps;
#define PK4(P, BASE, OUT) do { unsigned a0 = cvt_pk_bf16(P[BASE + 0], P[BASE + 1]), a1 = cvt_pk_bf16(P[BASE + 2], P[BASE + 3]);   \
    unsigned b0 = cvt_pk_bf16(P[BASE + 4], P[BASE + 5]), b1 = cvt_pk_bf16(P[BASE + 6], P[BASE + 7]);                              \
    auto r0 = __builtin_amdgcn_permlane32_swap(a0, b0, false, false); auto r1 = __builtin_amdgcn_permlane32_swap(a1, b1, false, false); \
    u32x4 w = {r0[0], r1[0], r0[1], r1[1]}; OUT = *reinterpret_cast<bf16x8*>(&w); } while (0)
    PK4(p0, 0, pa0); PK4(p0, 8, pa1); PK4(p1, 0, pa2); PK4(p1, 8, pa3);
#undef PK4
}
template <int DQK> __device__ __forceinline__ void qkt(f32x16& p0, f32x16& p1, const char* Ks, const bf16x8* qr, int r32, int hi) {
    p0 = f32x16{}; p1 = f32x16{};
#pragma unroll
    for (int d0 = 0; d0 < DQK / 16; ++d0) { const int cb = (d0 * 16 + hi * 8) * 2;
        const bf16x8 b0 = *reinterpret_cast<const bf16x8*>(Ks + kswz<DQK>(r32, cb));
        const bf16x8 b1 = *reinterpret_cast<const bf16x8*>(Ks + kswz<DQK>(32 + r32, cb));
        p0 = __builtin_amdgcn_mfma_f32_32x32x16_bf16(b0, qr[d0], p0, 0, 0, 0);
        p1 = __builtin_amdgcn_mfma_f32_32x32x16_bf16(b1, qr[d0], p1, 0, 0, 0); }
}
__device__ __forceinline__ int v_st(int k, int c) { const int kk = (k & ~0xC) | ((k & 4) << 1) | ((k & 8) >> 1); return ((kk >> 3) * 4 + (c >> 5)) * 512 + ((kk & 7) * 32 + (c & 31)) * 2; }
__device__ __forceinline__ int v_rd_base(int lane) { return ((lane & 3) << 3) | (((lane >> 2) & 3) << 6) | (((lane >> 4) & 1) << 5) | (((lane >> 5) & 1) << 8); }
constexpr int v_rd_off(int d0, int ks, int half) { return d0 * 512 + ks * 4096 + half * 2048; }
template <int OFF> __device__ __forceinline__ s16x4 tr_read(int vb) {
    s16x4 r; asm volatile("ds_read_b64_tr_b16 %0, %1 offset:%2" : "=&v"(r) : "v"(vb), "i"(OFF) : "memory"); return r;
}
template <int D0> __device__ __forceinline__ void pv_one(f32x16& od, int vb, bf16x8 pa0, bf16x8 pa1, bf16x8 pa2, bf16x8 pa3) {
    const s16x4 l0 = tr_read<v_rd_off(D0, 0, 0)>(vb), h0 = tr_read<v_rd_off(D0, 0, 1)>(vb), l1 = tr_read<v_rd_off(D0, 1, 0)>(vb), h1 = tr_read<v_rd_off(D0, 1, 1)>(vb);
    const s16x4 l2 = tr_read<v_rd_off(D0, 2, 0)>(vb), h2 = tr_read<v_rd_off(D0, 2, 1)>(vb), l3 = tr_read<v_rd_off(D0, 3, 0)>(vb), h3 = tr_read<v_rd_off(D0, 3, 1)>(vb);
    asm volatile("s_waitcnt lgkmcnt(0)" ::: "memory"); SBAR();
#define PK(L, H) (bf16x8){L[0], L[1], L[2], L[3], H[0], H[1], H[2], H[3]}
    od = __builtin_amdgcn_mfma_f32_32x32x16_bf16(pa0, PK(l0, h0), od, 0, 0, 0);
    od = __builtin_amdgcn_mfma_f32_32x32x16_bf16(pa1, PK(l1, h1), od, 0, 0, 0);
    od = __builtin_amdgcn_mfma_f32_32x32x16_bf16(pa2, PK(l2, h2), od, 0, 0, 0);
    od = __builtin_amdgcn_mfma_f32_32x32x16_bf16(pa3, PK(l3, h3), od, 0, 0, 0);
#undef PK
}
__device__ __forceinline__ void pv_d0(f32x16* o, int vb, bf16x8 pa0, bf16x8 pa1, bf16x8 pa2, bf16x8 pa3) {
    pv_one<0>(o[0], vb, pa0, pa1, pa2, pa3); pv_one<1>(o[1], vb, pa0, pa1, pa2, pa3); pv_one<2>(o[2], vb, pa0, pa1, pa2, pa3); pv_one<3>(o[3], vb, pa0, pa1, pa2, pa3);
}
__device__ __forceinline__ void store_o(float* p, float v) { *p = v; }
__device__ __forceinline__ void store_o(bf16_t* p, float v) { *p = (bf16_t)f2bf(v); }

template <int DQK, int LDKV, typename TO>
__device__ __forceinline__ void attn_body(const bf16_t* __restrict__ Qb, const bf16_t* __restrict__ Kh, const bf16_t* __restrict__ Vh,
                                          TO* __restrict__ Ob, int seq, float scale, char* lds) {
    constexpr int ldq = 768, ldo = 768, ldk = LDKV, ldv = LDKV;
    constexpr size_t SHM_K = KVBLK * DQK * 2;
    const int tid = lthread(), wid = tid >> 6, lane = tid & 63, r32 = lane & 31, hi = lane >> 5;
    char* V_lds = lds; char* K_lds = lds + 2 * SHM_V;
    float* ws = (float*)(lds + 2 * SHM_V + 2 * SHM_KMAX) + wid * 64; float* li_l = ws; float* al_l = ws + 32;
    const float C = scale * 1.4426950408889634f, thr_raw = THR / scale;
    float m_reg = -1e30f, l_reg = 0; f32x16 o[4] = {}; bf16x8 qr[DQK / 16];
    const bf16_t* Qw = Qb + (long)(wid * QBLK + r32) * ldq + hi * 8;
#pragma unroll
    for (int d0 = 0; d0 < DQK / 16; ++d0) qr[d0] = *reinterpret_cast<const bf16x8*>(Qw + d0 * 16);
    const int sr = tid >> 4, sc = (tid & 15) * 8, vst0 = v_st(sr, sc), vst1 = v_st(32 + sr, sc);
    const int ksr = DQK == 128 ? sr : (tid >> 3), ksc = DQK == 128 ? sc : (tid & 7) * 8;
    const int vb0 = (int)(uintptr_t)V_lds + v_rd_base(lane);
    struct { bf16x8 vs0, vs1, ks0, ks1; } sr_[SDEPTH];
#define SLOAD(i, k0) do { sr_[i].vs0 = *reinterpret_cast<const bf16x8*>(&Vh[(long)((k0) + sr) * ldv + sc]); sr_[i].vs1 = *reinterpret_cast<const bf16x8*>(&Vh[(long)((k0) + 32 + sr) * ldv + sc]); \
    sr_[i].ks0 = *reinterpret_cast<const bf16x8*>(&Kh[(long)((k0) + ksr) * ldk + ksc]); \
    if (DQK == 128) sr_[i].ks1 = *reinterpret_cast<const bf16x8*>(&Kh[(long)((k0) + 32 + ksr) * ldk + ksc]); } while (0)
#define SWRITE(b, i) do { *(bf16x8*)(V_lds + (b) * SHM_V + vst0) = sr_[i].vs0;          \
    *(bf16x8*)(V_lds + (b) * SHM_V + vst1) = sr_[i].vs1; const int kc = ksc * 2;               \
    *(bf16x8*)(K_lds + (b) * SHM_K + kswz<DQK>(ksr, kc)) = sr_[i].ks0;                       \
    if (DQK == 128) *(bf16x8*)(K_lds + (b) * SHM_K + kswz<DQK>(32 + ksr, kc)) = sr_[i].ks1; } while (0)
#define SWAIT() do { if (SDEPTH == 1) asm volatile("s_waitcnt vmcnt(0)" ::: "memory"); else if (DQK == 128) asm volatile("s_waitcnt vmcnt(4)" ::: "memory"); else asm volatile("s_waitcnt vmcnt(3)" ::: "memory"); } while (0)
#define RESC(a) do { if (__any((a) < 1.f)) { if (hi == 0) al_l[r32] = (a); asm volatile("s_waitcnt lgkmcnt(0)" ::: "memory"); \
    _Pragma("unroll") for (int d = 0; d < 4; ++d) _Pragma("unroll") for (int r = 0; r < 16; ++r) o[d][r] *= al_l[crow(r, hi)]; } } while (0)
    f32x16 pA0, pA1, pB0, pB1; float mnA, mnB, alA, alB; bf16x8 pa0, pa1, pa2, pa3; const int NT = seq / KVBLK;
    constexpr int SE = 0, SO = SDEPTH - 1;
    SLOAD(SE, 0); asm volatile("s_waitcnt vmcnt(0)" ::: "memory"); SWRITE(0, SE); __syncthreads();
    qkt<DQK>(pA0, pA1, K_lds, qr, r32, hi); partialSM(pA0, pA1, m_reg, mnA, alA, C, thr_raw);
    SLOAD(SO, KVBLK); if (SDEPTH == 2) { if (2 < NT) SLOAD(SE, 2 * KVBLK); }
    SWAIT(); SWRITE(1, SO); __syncthreads();
    for (int j = 1; j + 1 < NT; j += 2) {
        SBAR(); qkt<DQK>(pB0, pB1, K_lds + SHM_K, qr, r32, hi);
        finishSM(pA0, pA1, alA, l_reg, pa0, pa1, pa2, pa3); SBAR();
        SLOAD(SO, (j + SDEPTH) * KVBLK); SBAR();
        pv_d0(o, vb0, pa0, pa1, pa2, pa3); partialSM(pB0, pB1, m_reg, mnB, alB, C, thr_raw);
        __syncthreads(); SWAIT(); SWRITE(0, SE);
        RESC(alB); __syncthreads();
        SBAR(); qkt<DQK>(pA0, pA1, K_lds, qr, r32, hi);
        finishSM(pB0, pB1, alB, l_reg, pa0, pa1, pa2, pa3); SBAR();
        if (SDEPTH == 1 || j + 3 < NT) SLOAD(SE, (j + 1 + SDEPTH) * KVBLK); SBAR();
        pv_d0(o, vb0 + (int)SHM_V, pa0, pa1, pa2, pa3); partialSM(pA0, pA1, m_reg, mnA, alA, C, thr_raw);
        __syncthreads(); SWAIT(); SWRITE(1, SO);
        RESC(alA); __syncthreads();
    }
    SBAR(); qkt<DQK>(pB0, pB1, K_lds + SHM_K, qr, r32, hi);
    finishSM(pA0, pA1, alA, l_reg, pa0, pa1, pa2, pa3); SBAR();
    pv_d0(o, vb0, pa0, pa1, pa2, pa3); partialSM(pB0, pB1, m_reg, mnB, alB, C, thr_raw);
    __syncthreads(); RESC(alB);
    finishSM(pB0, pB1, alB, l_reg, pa0, pa1, pa2, pa3); SBAR();
    pv_d0(o, vb0 + (int)SHM_V, pa0, pa1, pa2, pa3);
    if (hi == 0) li_l[r32] = l_reg; asm volatile("s_waitcnt lgkmcnt(0)" ::: "memory");
    float rli[16];
#pragma unroll
    for (int r = 0; r < 16; ++r) rli[r] = __builtin_amdgcn_rcpf(li_l[crow(r, hi)]);
    __syncthreads();
    bf16_t* stg = (bf16_t*)(lds + wid * 8192);
#pragma unroll
    for (int r = 0; r < 16; ++r) { const int orow = crow(r, hi);
#pragma unroll
        for (int d0 = 0; d0 < 4; ++d0) stg[orow * 128 + d0 * 32 + r32] = (bf16_t)f2bf(o[d0][r] * rli[r]); }
    asm volatile("s_waitcnt lgkmcnt(0)" ::: "memory");
    TO* Ow = Ob + (long)(wid * QBLK) * ldo;
#pragma unroll
    for (int i = 0; i < 8; ++i) { const int row = i * 4 + (lane >> 4), ch = lane & 15;
        const u32x4 v = *(const u32x4*)(stg + row * 128 + ch * 8); *(u32x4*)(Ow + (long)row * ldo + ch * 8) = v; }
#undef SLOAD
#undef SWRITE
#undef SWAIT
#undef RESC
}
#undef SBAR
}

struct Args { const float* in[N_IN]; float* out; unsigned char* ws; int ph_lo, ph_hi; };

constexpr int RING_BYTES = 131072, MISC_OFF = RING_BYTES, LDS_BYTES = 147456;

struct Frame {
    const Args* a; unsigned char* ws; char* lds; int tid, lane, wave, gw, ngw;
};

__device__ __forceinline__ void transpose_item(const float* W, int N, bf16_t* WT, int ldk, float* scr, int item, int lane) {
    const int nblk = N / 32, kb = item / nblk, nb = item % nblk, k0 = 64 * kb, n0 = 32 * nb;
    float tv[32];
#pragma unroll
    for (int i = 0; i < 32; ++i) { const int kk = 2 * i + (lane >> 5); tv[i] = W[(size_t)(k0 + kk) * N + n0 + (lane & 31)]; }
#pragma unroll
    for (int i = 0; i < 32; ++i) { const int kk = 2 * i + (lane >> 5); scr[kk * 33 + (lane & 31)] = tv[i]; }
    asm volatile("s_waitcnt lgkmcnt(0)" ::: "memory");
    const int c = lane & 7;
#pragma unroll
    for (int j = 0; j < 4; ++j) { const int n = (lane >> 3) + 8 * j; const float* s = scr + (8 * c) * 33 + n;
        u32x4 o; o.x = cvt_pk_bf16(s[0 * 33], s[1 * 33]); o.y = cvt_pk_bf16(s[2 * 33], s[3 * 33]); o.z = cvt_pk_bf16(s[4 * 33], s[5 * 33]); o.w = cvt_pk_bf16(s[6 * 33], s[7 * 33]);
        *(u32x4*)(WT + (size_t)(n0 + n) * ldk + k0 + 8 * c) = o; }
    asm volatile("s_waitcnt lgkmcnt(0)" ::: "memory");
}
__device__ __forceinline__ void convert_weights(const Frame& F, int layer) {
    float* scr = (float*)(F.lds + F.wave * 16384);
    const Args& A = *F.a;
    constexpr int I_IN = (2048 / 64) * (12288 / 32), I_BRX = (768 / 64) * (2048 / 32), I_OUT = (2048 / 64) * (2048 / 32), I_UPX = (2048 / 64) * (FF2 / 32), I_DN = (FF / 64) * (2048 / 32);
    constexpr int NITEMS = I_IN + 3 * I_BRX + I_OUT + I_UPX + I_DN;
    for (int it = F.gw; it < NITEMS; it += F.ngw) {
        int r = it;
        if (r < I_IN) { transpose_item(A.in[I_WIN] + (size_t)layer * 2048 * 12288, 12288, (bf16_t*)(F.ws + W_IN), 2048, scr, r, F.lane); continue; } r -= I_IN;
        if (r < I_BRX) { transpose_item(A.in[I_WBR] + (size_t)layer * 768 * 2048, 2048, (bf16_t*)(F.ws + W_BR), 768, scr, r, F.lane); continue; } r -= I_BRX;
        if (r < I_BRX) { transpose_item(A.in[I_WBG] + (size_t)layer * 768 * 2048, 2048, (bf16_t*)(F.ws + W_BR) + 2048 * 768, 768, scr, r, F.lane); continue; } r -= I_BRX;
        if (r < I_BRX) { transpose_item(A.in[I_WBD] + (size_t)layer * 768 * 2048, 2048, (bf16_t*)(F.ws + W_BR) + 2 * 2048 * 768, 768, scr, r, F.lane); continue; } r -= I_BRX;
        if (r < I_OUT) { transpose_item(A.in[I_WOUT] + (size_t)layer * 2048 * 2048, 2048, (bf16_t*)(F.ws + W_OUT), 2048, scr, r, F.lane); continue; } r -= I_OUT;
        if (r < I_UPX) { transpose_item(A.in[I_UP] + (size_t)layer * 2048 * FF2, FF2, (bf16_t*)(F.ws + W_UP), 2048, scr, r, F.lane); continue; } r -= I_UPX;
        transpose_item(A.in[I_DOWN] + (size_t)layer * FF * 2048, 2048, (bf16_t*)(F.ws + W_DOWN), FF, scr, r, F.lane);
    }
    const float* w2 = A.in[I_W2] + (size_t)layer * 2 * 64 * 768; const float* a2 = A.in[I_A2] + (size_t)layer * 2 * 64 * 768; const float* g2 = A.in[I_G2] + (size_t)layer * 128 * 768;
    for (int n = F.gw; n < 3840 + (layer == 1 ? 768 * 12 : 0); n += F.ngw) {
        if (n < 3840) {
            const int seg = n / 768, c = n % 768; bf16_t* dst = (bf16_t*)(F.ws + W_LR) + (size_t)n * 256;
#pragma unroll
            for (int j = 0; j < 4; ++j) { const int k = j * 64 + F.lane; float v = 0.f;
                if (seg < 2) { if (k < 64) v = w2[((size_t)seg * 64 + k) * 768 + c]; }
                else if (seg < 4) { if (k >= 64 && k < 128) v = a2[((size_t)(seg - 2) * 64 + (k - 64)) * 768 + c]; }
                else { if (k >= 128) v = g2[(size_t)(k - 128) * 768 + c]; }
                dst[k] = (bf16_t)f2bf(v); }
        } else {
            const int q_ = n - 3840, nn = q_ / 12, k = (q_ % 12) * 64 + F.lane;
            const float* v1r = A.in[I_V1] + (size_t)k * 32; const float* v2p = A.in[I_V2] + nn;
            f32x4 a[8]; float b[32];
#pragma unroll
            for (int r4 = 0; r4 < 8; ++r4) a[r4] = *(const f32x4*)(v1r + 4 * r4);
#pragma unroll
            for (int r = 0; r < 32; ++r) b[r] = v2p[(size_t)r * 768];
            float s = 0.f;
#pragma unroll
            for (int r4 = 0; r4 < 8; ++r4) s += a[r4].x * b[4 * r4] + a[r4].y * b[4 * r4 + 1] + a[r4].z * b[4 * r4 + 2] + a[r4].w * b[4 * r4 + 3];
            ((bf16_t*)(F.ws + W_V12))[(size_t)nn * 768 + k] = (bf16_t)f2bf(s);
        }
    }
}
__device__ __forceinline__ void adaln(const Frame& F) {
    const Args& A = *F.a;
    float* sc = (float*)F.lds;
    float* red = (float*)(F.lds + 40960);
    for (int i = F.tid; i < 5 * 2048; i += NTHREADS) { const int cnd = i >> 11, k = i & 2047; const float v = cnd < 4 ? A.in[I_C][cnd * 2048 + k] : A.in[I_CCTX][k]; sc[i] = v / (1.f + __expf(-v)); }
    __syncthreads();
    float* MOD = (float*)(F.ws + O_MOD);
    for (int slab = blockIdx.x; slab < 256; slab += gridDim.x) {
        const int col0 = slab * 96, layer = col0 / MODW, cc = col0 % MODW;
        const float* W = A.in[I_WMOD] + (size_t)layer * 2048 * MODW + cc;
        float a0[5] = {0.f, 0.f, 0.f, 0.f, 0.f}, a1[5] = {0.f, 0.f, 0.f, 0.f, 0.f};
        const int kb = F.wave * 256;
#pragma unroll 8
        for (int k = kb; k < kb + 256; ++k) {
            const float w0 = W[(size_t)k * MODW + F.lane]; const float w1 = F.lane < 32 ? W[(size_t)k * MODW + 64 + F.lane] : 0.f;
#pragma unroll
            for (int c = 0; c < 5; ++c) { const float s = sc[c * 2048 + k]; a0[c] += s * w0; a1[c] += s * w1; }
        }
#pragma unroll
        for (int c = 0; c < 5; ++c) { red[(F.wave * 10 + c * 2) * 64 + F.lane] = a0[c]; red[(F.wave * 10 + c * 2 + 1) * 64 + F.lane] = a1[c]; }
        __syncthreads();
        if (F.tid < 480) { const int c = F.tid / 96, j = F.tid % 96; float s = A.in[I_BMOD][layer * MODW + cc + j];
#pragma unroll
            for (int w = 0; w < 8; ++w) s += red[(w * 10 + c * 2 + (j >> 6)) * 64 + (j & 63)];
            MOD[((size_t)layer * 5 + c) * MODW + cc + j] = s; }
        __syncthreads();
    }
}
__device__ __forceinline__ void norm_rows(const Frame& F, const float* xl, const float* xc, const float* gain, const float* mod  , int sh_off, int sc_off, int nrows) {
    bf16_t* H = (bf16_t*)(F.ws + O_H);
    for (int m0 = F.gw; m0 < nrows; m0 += 2 * F.ngw) {
        const int m1 = m0 + F.ngw < nrows ? m0 + F.ngw : m0;
        const float* xr0 = m0 < TL ? xl + (size_t)m0 * DM : xc + (size_t)(m0 - TL) * DM;
        const float* xr1 = m1 < TL ? xl + (size_t)m1 * DM : xc + (size_t)(m1 - TL) * DM;
        f32x4 v0[8], v1[8]; float s0 = 0.f, s1 = 0.f;
#pragma unroll
        for (int j = 0; j < 8; ++j) { v0[j] = *(const f32x4*)(xr0 + j * 256 + F.lane * 4); v1[j] = *(const f32x4*)(xr1 + j * 256 + F.lane * 4); }
#pragma unroll
        for (int j = 0; j < 8; ++j) { s0 += v0[j].x * v0[j].x + v0[j].y * v0[j].y + v0[j].z * v0[j].z + v0[j].w * v0[j].w; s1 += v1[j].x * v1[j].x + v1[j].y * v1[j].y + v1[j].z * v1[j].z + v1[j].w * v1[j].w; }
        const float rs0 = rsqrtf(wave_sum(s0) * (1.f / DM) + 1e-6f), rs1 = rsqrtf(wave_sum(s1) * (1.f / DM) + 1e-6f);
        const float* mp0 = mod + (size_t)(m0 < TL ? (m0 >> 12) : 4) * MODW; const float* mp1 = mod + (size_t)(m1 < TL ? (m1 >> 12) : 4) * MODW;
#pragma unroll
        for (int j = 0; j < 8; ++j) { const int c = j * 256 + F.lane * 4;
            const f32x4 g = *(const f32x4*)(gain + c);
            { const f32x4 sh = *(const f32x4*)(mp0 + sh_off + c), sc = *(const f32x4*)(mp0 + sc_off + c); const f32x4 y = v0[j] * rs0 * g * (sc + 1.f) + sh;
              u32x2 w; w.x = cvt_pk_bf16(y.x, y.y); w.y = cvt_pk_bf16(y.z, y.w); *(u32x2*)(H + (size_t)m0 * DM + c) = w; }
            if (m1 != m0) { const f32x4 sh = *(const f32x4*)(mp1 + sh_off + c), sc = *(const f32x4*)(mp1 + sc_off + c); const f32x4 y = v1[j] * rs1 * g * (sc + 1.f) + sh;
              u32x2 w; w.x = cvt_pk_bf16(y.x, y.y); w.y = cvt_pk_bf16(y.z, y.w); *(u32x2*)(H + (size_t)m1 * DM + c) = w; }
        }
    }
}
__device__ __forceinline__ void final_norm(const Frame& F) {
    float* X = F.a->out; const float* gain = F.a->in[I_FN];
    for (int m0 = F.gw; m0 < TL; m0 += 2 * F.ngw) {
        const int m1 = m0 + F.ngw < TL ? m0 + F.ngw : m0;
        float* xr0 = X + (size_t)m0 * DM; float* xr1 = X + (size_t)m1 * DM; f32x4 v0[8], v1[8]; float s0 = 0.f, s1 = 0.f;
#pragma unroll
        for (int j = 0; j < 8; ++j) { v0[j] = *(const f32x4*)(xr0 + j * 256 + F.lane * 4); v1[j] = *(const f32x4*)(xr1 + j * 256 + F.lane * 4); }
#pragma unroll
        for (int j = 0; j < 8; ++j) { s0 += v0[j].x * v0[j].x + v0[j].y * v0[j].y + v0[j].z * v0[j].z + v0[j].w * v0[j].w; s1 += v1[j].x * v1[j].x + v1[j].y * v1[j].y + v1[j].z * v1[j].z + v1[j].w * v1[j].w; }
        const float rs0 = rsqrtf(wave_sum(s0) * (1.f / DM) + 1e-6f), rs1 = rsqrtf(wave_sum(s1) * (1.f / DM) + 1e-6f);
#pragma unroll
        for (int j = 0; j < 8; ++j) { const int c = j * 256 + F.lane * 4; const f32x4 g = *(const f32x4*)(gain + c);
            *(f32x4*)(xr0 + c) = v0[j] * rs0 * g; if (m1 != m0) *(f32x4*)(xr1 + c) = v1[j] * rs1 * g; }
    }
}
__device__ __forceinline__ float row16_sum_p(float v) {
    v += __int_as_float(__builtin_amdgcn_update_dpp(0, __float_as_int(v), 0xB1, 0xF, 0xF, true));
    v += __int_as_float(__builtin_amdgcn_update_dpp(0, __float_as_int(v), 0x4E, 0xF, 0xF, true));
    v += __int_as_float(__builtin_amdgcn_update_dpp(0, __float_as_int(v), 0x141, 0xF, 0xF, true));
    v += __int_as_float(__builtin_amdgcn_update_dpp(0, __float_as_int(v), 0x140, 0xF, 0xF, true));
    return v;
}
__device__ __forceinline__ f32x4 unpack4p(u32x2 w) { return (f32x4){bf2f(w.x & 0xffffu), __uint_as_float(w.x & 0xffff0000u), bf2f(w.y & 0xffffu), __uint_as_float(w.y & 0xffff0000u)}; }
__device__ __forceinline__ u32x2 pack4p(f32x4 v) { u32x2 w; w.x = cvt_pk_bf16(v.x, v.y); w.y = cvt_pk_bf16(v.z, v.w); return w; }
__device__ __forceinline__ void rwkv_prep(const Frame& F, int layer) {
    const Args& A = *F.a;
    const bf16_t* PR = (const bf16_t*)(F.ws + A_PR);
    bf16_t* R = (bf16_t*)(F.ws + A_R); bf16_t* K = (bf16_t*)(F.ws + A_K); bf16_t* V = (bf16_t*)(F.ws + (layer == 0 ? O_VF : A_YS));
    bf16_t* KKo = (bf16_t*)(F.ws + A_KKN); bf16_t* LR = (bf16_t*)(F.ws + A_LR);
    const float* mu = A.in[I_MU] + layer * RCOLS; const float* kkw = A.in[I_KK] + layer * RW;
    const int l4 = F.lane * 4;
    for (int m = F.gw; m < TT; m += F.ngw) {
        const bool lat = m < TL; const int t = lat ? (m & 4095) : ((m - TL) & 255), len = lat ? SEQ : CTX;
        const bool hp = t > 0, hn = t < len - 1;
        const bf16_t* p = PR + (size_t)m * RCOLS;
        const u32x2 z2 = {0u, 0u};
        u32x2 rc[10], rp[10], rn[10]; f32x4 rm[10], rk3[3];
#pragma unroll
        for (int it = 0; it < 10; ++it) { const int c = it * 256 + l4;
            rc[it] = *(const u32x2*)(p + c); rp[it] = hp ? *(const u32x2*)(p + c - RCOLS) : z2; rn[it] = hn ? *(const u32x2*)(p + c + RCOLS) : z2; rm[it] = *(const f32x4*)(mu + c); }
#pragma unroll
        for (int j = 0; j < 3; ++j) rk3[j] = *(const f32x4*)(kkw + j * 256 + l4);
        asm volatile("" ::: "memory");
#pragma unroll
        for (int it = 0; it < 10; ++it) { const int c = it * 256 + l4;
            const f32x4 cur = unpack4p(rc[it]), pv = unpack4p(rp[it]), nx = unpack4p(rn[it]);
            const f32x4 xs = cur + rm[it] * ((pv + nx) * 0.5f - cur);
            if (it < 3) { *(u32x2*)(R + (size_t)m * RW + c) = pack4p(xs); }
            else if (it < 6) { const int ck = c - 768; *(u32x2*)(K + (size_t)m * RW + ck) = pack4p(xs);
                const f32x4 kk = xs * rk3[it - 3 < 0 ? 0 : (it - 3 > 2 ? 2 : it - 3)];
                const float ss = row16_sum_p((kk.x * kk.x + kk.y * kk.y) + (kk.z * kk.z + kk.w * kk.w));
                *(u32x2*)(KKo + (size_t)m * RW + ck) = pack4p(kk * (1.f / fmaxf(sqrtf(ss), 1e-12f))); }
            else if (it < 9) { *(u32x2*)(V + (size_t)m * RW + c - 1536) = pack4p(xs); }
            else { f32x4 o;
                if (F.lane < 16) o = (f32x4){tanhf(xs.x), tanhf(xs.y), tanhf(xs.z), tanhf(xs.w)};
                else if (F.lane < 32) o = xs;
                else o = (f32x4){sigmoidf_(xs.x), sigmoidf_(xs.y), sigmoidf_(xs.z), sigmoidf_(xs.w)};
                *(u32x2*)(LR + (size_t)m * 256 + l4) = pack4p(o); }
        }
        asm volatile("" ::: "memory");
    }
}
__device__ __forceinline__ void qk_prep(const Frame& F, int layer) {
    const Args& A = *F.a;
    bf16_t* QG = (bf16_t*)(F.ws + A_QG); bf16_t* KG = (bf16_t*)(F.ws + A_KG); bf16_t* DQ = (bf16_t*)(F.ws + A_DQ); bf16_t* DK = (bf16_t*)(F.ws + A_DK);
    float* TGc = (float*)F.lds; float* TGs = TGc + 2048; float* TDc = TGs + 2048; float* TDs = TDc + 1024;
    __syncthreads();
    for (int i = F.tid; i < 2048; i += NTHREADS) { float s_, c_; sincosf((float)(i >> 5) * powf(10000.f, -(float)(i & 31) / 32.f), &s_, &c_); TGc[i] = c_; TGs[i] = s_; }
    for (int i = F.tid; i < 1024; i += NTHREADS) { float s_, c_; sincosf((float)(i >> 4) * powf(10000.f, -(float)(i & 15) / 16.f), &s_, &c_); TDc[i] = c_; TDs[i] = s_; }
    __syncthreads();
    const int l = F.lane, sub = l & 15, hg = l >> 4, sub8 = l & 7;
    float gq[8], gk[8];
#pragma unroll
    for (int e = 0; e < 8; ++e) { gq[e] = A.in[I_QN][layer * 128 + sub * 8 + e]; gk[e] = A.in[I_KN][layer * 128 + sub * 8 + e]; }
    for (int m = F.gw; m < TT; m += F.ngw) {
        const bool lat = m < TL; const int b = lat ? (m >> 12) : ((m - TL) >> 8), t = lat ? (m & 4095) : ((m - TL) & 255);
        const size_t kvrow = (size_t)b * KVS + (lat ? CTX + t : t);
        const int ridx = t >> 6, cidx = t & 63;
        u32x4 qraw[2], draw[3];
#pragma unroll
        for (int ps = 0; ps < 2; ++ps) { const bool isk = ps == 1 && hg >= 2;
            qraw[ps] = *(const u32x4*)(isk ? KG + kvrow * 256 + (hg - 2) * 128 + sub * 8 : QG + (size_t)m * 768 + (ps * 4 + hg) * 128 + sub * 8); }
#pragma unroll
        for (int ps = 0; ps < 3; ++ps) { const int v = ps * 8 + (l >> 3);
            draw[ps] = lat ? *(const u32x4*)(v < 12 ? DQ + (size_t)m * 768 + v * 64 + sub8 * 8 : DK + kvrow * 768 + (v - 12) * 64 + sub8 * 8) : (u32x4){0u, 0u, 0u, 0u}; }
        asm volatile("" ::: "memory");
#pragma unroll
        for (int ps = 0; ps < 2; ++ps) {
            const bool isk = ps == 1 && hg >= 2;
            bf16_t* ptr = isk ? KG + kvrow * 256 + (hg - 2) * 128 + sub * 8 : QG + (size_t)m * 768 + (ps * 4 + hg) * 128 + sub * 8;
            float x[8]; unpack8(qraw[ps], x);
            float ss = 0.f;
#pragma unroll
            for (int e = 0; e < 8; ++e) ss += x[e] * x[e];
            const float rs = rsqrtf(row16_sum_p(ss) * (1.f / 128.f) + 1e-6f);
#pragma unroll
            for (int e = 0; e < 8; ++e) x[e] *= rs * (isk ? gk[e] : gq[e]);
            if (lat) {
                const int ti = (sub < 8 ? ridx : cidx) * 32 + (sub & 3) * 8; const bool up = (sub & 4) != 0;
                const f32x4 c0 = *(const f32x4*)(TGc + ti), c1 = *(const f32x4*)(TGc + ti + 4), s0 = *(const f32x4*)(TGs + ti), s1 = *(const f32x4*)(TGs + ti + 4);
#pragma unroll
                for (int e = 0; e < 8; ++e) { const float pl_ = __int_as_float(__builtin_amdgcn_update_dpp(0, __float_as_int(x[e]), 0x104, 0xF, 0xF, true)), pr_ = __int_as_float(__builtin_amdgcn_update_dpp(0, __float_as_int(x[e]), 0x114, 0xF, 0xF, true)); const float pz = up ? pr_ : pl_; const float cc = e < 4 ? c0[e & 3] : c1[e & 3], sn = e < 4 ? s0[e & 3] : s1[e & 3];
                    x[e] = up ? pz * sn + x[e] * cc : x[e] * cc - pz * sn; }
            }
            *(u32x4*)ptr = pack8(x);
        }
        if (lat) {
#pragma unroll
            for (int ps = 0; ps < 3; ++ps) { const int v = ps * 8 + (l >> 3);
                bf16_t* ptr = v < 12 ? DQ + (size_t)m * 768 + v * 64 + sub8 * 8 : DK + kvrow * 768 + (v - 12) * 64 + sub8 * 8;
                float x[8]; unpack8(draw[ps], x);
                const int ti = (sub8 < 4 ? ridx : cidx) * 16 + (sub8 & 1) * 8; const bool up = (sub8 & 2) != 0;
                const f32x4 c0 = *(const f32x4*)(TDc + ti), c1 = *(const f32x4*)(TDc + ti + 4), s0 = *(const f32x4*)(TDs + ti), s1 = *(const f32x4*)(TDs + ti + 4);
#pragma unroll
                for (int e = 0; e < 8; ++e) { const float pz = __int_as_float(__builtin_amdgcn_update_dpp(0, __float_as_int(x[e]), 0x4E, 0xF, 0xF, true));
                    const float cc = e < 4 ? c0[e & 3] : c1[e & 3], sn = e < 4 ? s0[e & 3] : s1[e & 3];
                    x[e] = up ? pz * sn + x[e] * cc : x[e] * cc - pz * sn; }
                *(u32x4*)ptr = pack8(x);
            }
        }
    }
}
__device__ __forceinline__ float quad_sum(float v) {
    v += __int_as_float(__builtin_amdgcn_update_dpp(0, __float_as_int(v), 0xB1, 0xF, 0xF, true));
    v += __int_as_float(__builtin_amdgcn_update_dpp(0, __float_as_int(v), 0x4E, 0xF, 0xF, true));
    return v;
}
struct ScanStep { f32x4 w[2], kd[2], kk[2], b[2], r[2]; f32x2 v; };
__device__ __forceinline__ ScanStep scan_ld(const float* cb, const float* vbp, int s) {
    ScanStep d; const float* rec = cb + s * 384;
#pragma unroll
    for (int jj = 0; jj < 2; ++jj) { d.w[jj] = *(const f32x4*)(rec + jj * 4); d.kd[jj] = *(const f32x4*)(rec + 64 + jj * 4); d.kk[jj] = *(const f32x4*)(rec + 128 + jj * 4);
        d.b[jj] = *(const f32x4*)(rec + 192 + jj * 4); d.r[jj] = *(const f32x4*)(rec + 256 + jj * 4); }
    d.v = *(const f32x2*)(vbp + s * 384);
    return d;
}
__device__ __forceinline__ float oct_sum(float v) {
    v += __int_as_float(__builtin_amdgcn_update_dpp(0, __float_as_int(v), 0xB1, 0xF, 0xF, true));
    v += __int_as_float(__builtin_amdgcn_update_dpp(0, __float_as_int(v), 0x4E, 0xF, 0xF, true));
    v += __int_as_float(__builtin_amdgcn_update_dpp(0, __float_as_int(v), 0x141, 0xF, 0xF, true));
    return v;
}
__device__ __forceinline__ int scan_rowof(int g, int b, int dir) { if (g < CTX) { const int tt = dir ? (CTX - 1 - g) : g; return TL + b * CTX + tt; } const int g2 = g - CTX; const int tt = dir ? (SEQ - 1 - g2) : g2; return b * SEQ + tt; }
__device__ __forceinline__ void scan_chain(const Frame& F, int layer, int chain) {
    const Args& A = *F.a;
    const int b = chain / 24, h = (chain >> 1) % 12, dir = chain & 1;
    float* buf = (float*)F.lds;
    float* ybuf = (float*)(F.lds + 49152);
    const bf16_t* R = (const bf16_t*)(F.ws + A_R); const bf16_t* K = (const bf16_t*)(F.ws + A_K); const bf16_t* V = (const bf16_t*)(F.ws + (layer == 0 ? O_VF : A_V));
    const bf16_t* KKp = (const bf16_t*)(F.ws + A_KKN); const bf16_t* EW = (const bf16_t*)(F.ws + A_EW) + (size_t)dir * TT * RW; const bf16_t* AS = (const bf16_t*)(F.ws + A_AS) + (size_t)dir * TT * RW;
    float* YS = (float*)(F.ws + A_YS) + (size_t)dir * TT * RW;
    const bool stager = F.wave >= 4;
    const int t8 = F.tid & 255, s_st = t8 >> 4, part = t8 & 15, seg = part & 7, hrole = part >> 3;
    const int colo = h * 64 + seg * 8;
    float ka[8];
#pragma unroll
    for (int e = 0; e < 8; ++e) ka[e] = A.in[I_KA][layer * RW + colo + e];
    constexpr int NCH = (CTX + SEQ) / 16;
#define rowof(g) scan_rowof((g), b, dir)
    u32x4 z4 = {0u, 0u, 0u, 0u};
    u32x4 a0A = z4, a1A = z4, a2A = z4, a3A = z4, a0B = z4, a1B = z4, a2B = z4, a3B = z4;
#define SC_LOAD(r0, r1, r2, r3, n) do { const size_t ro_ = (size_t)rowof((n) * 16 + s_st) * RW + colo; \
        if (hrole == 0) { r0 = *(const u32x4*)(EW + ro_); r1 = *(const u32x4*)(R + ro_); r2 = *(const u32x4*)(K + ro_); r3 = *(const u32x4*)(AS + ro_); } \
        else { r0 = *(const u32x4*)(KKp + ro_); r1 = *(const u32x4*)(AS + ro_); r2 = *(const u32x4*)(V + ro_); } } while (0)
#define SC_WRITE(r0, r1, r2, r3, bi) do { float* d_ = buf + (bi) * 6144 + s_st * 384 + seg * 8; float x_[8], y_[8]; \
        if (hrole == 0) { unpack8(r0, x_); unpack8(r1, y_); float o_[8]; \
            _Pragma("unroll") for (int e = 0; e < 8; ++e) o_[e] = __expf(-x_[e]); \
            *(f32x4*)(d_) = (f32x4){o_[0], o_[1], o_[2], o_[3]}; *(f32x4*)(d_ + 4) = (f32x4){o_[4], o_[5], o_[6], o_[7]}; \
            *(f32x4*)(d_ + 256) = (f32x4){y_[0], y_[1], y_[2], y_[3]}; *(f32x4*)(d_ + 260) = (f32x4){y_[4], y_[5], y_[6], y_[7]}; \
            unpack8(r2, x_); unpack8(r3, y_); \
            _Pragma("unroll") for (int e = 0; e < 8; ++e) o_[e] = x_[e] * (1.f + (y_[e] - 1.f) * ka[e]); \
            *(f32x4*)(d_ + 64) = (f32x4){o_[0], o_[1], o_[2], o_[3]}; *(f32x4*)(d_ + 68) = (f32x4){o_[4], o_[5], o_[6], o_[7]}; } \
        else { unpack8(r0, x_); unpack8(r1, y_); \
            *(f32x4*)(d_ + 128) = (f32x4){x_[0], x_[1], x_[2], x_[3]}; *(f32x4*)(d_ + 132) = (f32x4){x_[4], x_[5], x_[6], x_[7]}; \
            *(f32x4*)(d_ + 192) = (f32x4){x_[0] * y_[0], x_[1] * y_[1], x_[2] * y_[2], x_[3] * y_[3]}; *(f32x4*)(d_ + 196) = (f32x4){x_[4] * y_[4], x_[5] * y_[5], x_[6] * y_[6], x_[7] * y_[7]}; \
            unpack8(r2, x_); \
            *(f32x4*)(d_ + 320) = (f32x4){x_[0], x_[1], x_[2], x_[3]}; *(f32x4*)(d_ + 324) = (f32x4){x_[4], x_[5], x_[6], x_[7]}; } } while (0)
    const int row_i = (F.wave & 3) * 16 + (F.lane >> 3) * 2, q = F.lane & 7;
    f32x2 S0[4], S1[4];
#pragma unroll
    for (int j = 0; j < 4; ++j) { S0[j] = (f32x2){0.f, 0.f}; S1[j] = (f32x2){0.f, 0.f}; }
    if (stager) { SC_LOAD(a0A, a1A, a2A, a3A, 0); SC_WRITE(a0A, a1A, a2A, a3A, 0); SC_LOAD(a0B, a1B, a2B, a3B, 1); SC_LOAD(a0A, a1A, a2A, a3A, 2); }
    __syncthreads();
#define SC_ITER(n, r0, r1, r2, r3) do { \
        if (!stager) { const float* cb = buf + ((n) & 1) * 6144 + q * 8; const float* vbp = buf + ((n) & 1) * 6144 + 320 + row_i; float* yb = ybuf + ((n) & 1) * 8192 + ((F.wave & 3) * 64 + F.lane) * 2; \
          ScanStep cur = scan_ld(cb, vbp, 0); \
          _Pragma("unroll") for (int hs = 0; hs < 2; ++hs) { f32x2 yreg[8]; \
          _Pragma("unroll") for (int s8 = 0; s8 < 8; ++s8) { const int s = hs * 8 + s8; \
            const ScanStep nx = scan_ld(cb, vbp, s < 15 ? s + 1 : 15); \
            f32x2 a0 = S0[0] * cur.kk[0].xy, a1 = S0[1] * cur.kk[0].zw, c0 = S1[0] * cur.kk[0].xy, c1 = S1[1] * cur.kk[0].zw; \
            a0 += S0[2] * cur.kk[1].xy; a1 += S0[3] * cur.kk[1].zw; c0 += S1[2] * cur.kk[1].xy; c1 += S1[3] * cur.kk[1].zw; \
            a0 += a1; c0 += c1; \
            const float nsa0 = -oct_sum(a0.x + a0.y), nsa1 = -oct_sum(c0.x + c0.y); \
            const float v0 = cur.v.x, v1 = cur.v.y; \
            f32x2 y0 = {0.f, 0.f}, y1 = {0.f, 0.f}, z0 = {0.f, 0.f}, z1 = {0.f, 0.f}; \
            _Pragma("unroll") for (int jj = 0; jj < 2; ++jj) { \
                S0[2 * jj] = S0[2 * jj] * cur.w[jj].xy + (cur.kd[jj].xy * v0 + cur.b[jj].xy * nsa0); \
                S0[2 * jj + 1] = S0[2 * jj + 1] * cur.w[jj].zw + (cur.kd[jj].zw * v0 + cur.b[jj].zw * nsa0); \
                S1[2 * jj] = S1[2 * jj] * cur.w[jj].xy + (cur.kd[jj].xy * v1 + cur.b[jj].xy * nsa1); \
                S1[2 * jj + 1] = S1[2 * jj + 1] * cur.w[jj].zw + (cur.kd[jj].zw * v1 + cur.b[jj].zw * nsa1); \
                y0 += S0[2 * jj] * cur.r[jj].xy; y1 += S0[2 * jj + 1] * cur.r[jj].zw; \
                z0 += S1[2 * jj] * cur.r[jj].xy; z1 += S1[2 * jj + 1] * cur.r[jj].zw; } \
            y0 += y1; z0 += z1; \
            yreg[s8] = (f32x2){y0.x + y0.y, z0.x + z0.y}; \
            cur = nx; } \
          _Pragma("unroll") for (int s8 = 0; s8 < 8; ++s8) *(f32x2*)(yb + (hs * 8 + s8) * 512) = yreg[s8]; } } \
        else { if ((n) + 1 < NCH) SC_WRITE(r0, r1, r2, r3, ((n) + 1) & 1); \
               if ((n) + 3 < NCH) SC_LOAD(r0, r1, r2, r3, (n) + 3); } \
        __syncthreads(); \
        if (stager) { const int s = t8 >> 4, i4 = (t8 & 15) * 4; const float* yb = ybuf + ((n) & 1) * 8192 + s * 512 + (i4 >> 1) * 16; \
          f32x4 o_ = {0.f, 0.f, 0.f, 0.f}; \
          _Pragma("unroll") for (int qq = 0; qq < 4; ++qq) { const f32x4 pa_ = *(const f32x4*)(yb + qq * 4), pb_ = *(const f32x4*)(yb + 16 + qq * 4); \
            o_.x += pa_.x + pa_.z; o_.y += pa_.y + pa_.w; o_.z += pb_.x + pb_.z; o_.w += pb_.y + pb_.w; } \
          *(f32x4*)(YS + (size_t)rowof((n) * 16 + s) * RW + h * 64 + i4) = o_; } } while (0)
    for (int n = 0; n < NCH; n += 2) { SC_ITER(n, a0B, a1B, a2B, a3B); SC_ITER(n + 1, a0A, a1A, a2A, a3A); }
    __syncthreads();
#undef SC_ITER
#undef SC_LOAD
#undef SC_WRITE
#undef rowof
}
__device__ __forceinline__ void ph_mix(const Frame& F, int layer, int rep) {
#ifndef PROBE_SUB
#define PROBE_SUB 0
#endif
    if (!(rep == 1 && PROBE_SUB == 2))
    for (int ch = blockIdx.x; ch < 96; ch += gridDim.x) scan_chain(F, layer, ch);
    unsigned* qbase = (unsigned*)(F.ws + O_CTL) + 64 * (16 + (layer * 2 + rep) * 8);
    volatile unsigned* misc = (volatile unsigned*)(F.lds + MISC_OFF);
    const int NK = (rep == 1 && PROBE_SUB == 1) ? 0 : (layer == 0 ? 144 + 9 : 144);
    const bf16_t* QG = (const bf16_t*)(F.ws + A_QG); const bf16_t* KG = (const bf16_t*)(F.ws + A_KG); const bf16_t* VG = (const bf16_t*)(F.ws + A_VG);
    const bf16_t* DQ = (const bf16_t*)(F.ws + A_DQ); const bf16_t* DK = (const bf16_t*)(F.ws + A_DK); const bf16_t* DV = (const bf16_t*)(F.ws + A_DV);
    bf16_t* YG = (bf16_t*)(F.ws + A_YG); bf16_t* OD = (bf16_t*)(F.ws + A_OD);
    const int x0 = (int)(xb_xcc_id() & 7u);
    int qi = 0;
    for (;;) {
        __syncthreads();
        if (F.tid == 0) { int qq = qi; unsigned uu = 0xFFFFFFFFu;
            while (qq < 8) { const int x = (x0 + qq) & 7; const unsigned k = atomicAdd(qbase + 64 * x, 1u); if ((int)k < NK) { uu = ((unsigned)x << 16) | k; break; } ++qq; }
            misc[0] = uu; misc[1] = (unsigned)qq; }
        __syncthreads();
        const unsigned uu = misc[0]; qi = (int)misc[1];
        if (uu == 0xFFFFFFFFu) break;
        const int x = (int)(uu >> 16), k = (int)(uu & 0xFFFFu);
        const bool isctx = k >= 144;
        const int g = x + 8 * (isctx ? (k - 144) : (k >> 4)), qb = k & 15;
        const bf16_t *qp, *kp, *vp; size_t orow; int kind, seq, oh;
        if (g < 24) { const int b = g / 6, hq = g % 6; orow = isctx ? (size_t)TL + b * CTX : (size_t)b * SEQ + qb * 256; kind = 0; oh = hq;
            qp = QG + orow * 768 + hq * 128; kp = KG + (size_t)b * KVS * 256 + (hq / 3) * 128; vp = VG + (size_t)b * KVS * 256 + (hq / 3) * 128; }
        else { const int d = g - 24, b = d / 12, h = (d >> 1) % 6, mp = d & 1; orow = isctx ? (size_t)TL + b * CTX : (size_t)b * SEQ + qb * 256; kind = 1 + mp; oh = h;
            qp = DQ + orow * 768 + (h * 2 + mp) * 64; kp = DK + (size_t)b * KVS * 768 + (h * 2 + mp) * 64; vp = DV + (size_t)b * KVS * 768 + h * 128; }
        seq = isctx ? CTX : KVS;
        if (kind == 0) att::attn_body<128, 256, bf16_t>(qp, kp, vp, YG + orow * 768 + oh * 128, seq, 0.088388347648318440f, F.lds);
        if (kind != 0) att::attn_body<64, 768, bf16_t>(qp, kp, vp, OD + (size_t)(kind - 1) * TT * 768 + orow * 768 + oh * 128, seq, 0.125f, F.lds);
    }
}
__device__ __forceinline__ float row16_sum(float v) {
    v += __int_as_float(__builtin_amdgcn_update_dpp(0, __float_as_int(v), 0xB1, 0xF, 0xF, true));
    v += __int_as_float(__builtin_amdgcn_update_dpp(0, __float_as_int(v), 0x4E, 0xF, 0xF, true));
    v += __int_as_float(__builtin_amdgcn_update_dpp(0, __float_as_int(v), 0x141, 0xF, 0xF, true));
    v += __int_as_float(__builtin_amdgcn_update_dpp(0, __float_as_int(v), 0x140, 0xF, 0xF, true));
    return v;
}
__device__ __forceinline__ f32x4 unpack4(u32x2 w) { return (f32x4){bf2f(w.x & 0xffffu), __uint_as_float(w.x & 0xffff0000u), bf2f(w.y & 0xffffu), __uint_as_float(w.y & 0xffff0000u)}; }
__device__ __forceinline__ u32x2 pack4(f32x4 v) { u32x2 w; w.x = cvt_pk_bf16(v.x, v.y); w.y = cvt_pk_bf16(v.z, v.w); return w; }
__device__ __forceinline__ void ph_post(const Frame& F, int layer) {
    const Args& A = *F.a; const int l = F.lane;
    const int nrows = layer == 0 ? TT : TL;
    const bf16_t* R = (const bf16_t*)(F.ws + A_R); const bf16_t* K = (const bf16_t*)(F.ws + A_K); const bf16_t* V = (const bf16_t*)(F.ws + (layer == 0 ? O_VF : A_V));
    const bf16_t* AS0 = (const bf16_t*)(F.ws + A_AS); const bf16_t* AS1 = AS0 + (size_t)TT * RW; const bf16_t* G = (const bf16_t*)(F.ws + A_G);
    const float* YS0 = (const float*)(F.ws + A_YS); const float* YS1 = YS0 + (size_t)TT * RW;
    const bf16_t* OD0 = (const bf16_t*)(F.ws + A_OD); const bf16_t* OD1 = OD0 + (size_t)TT * 768;
    bf16_t* YR = (bf16_t*)(F.ws + A_YR); bf16_t* YD = (bf16_t*)(F.ws + A_YD);
    const float* lnw = A.in[I_LNW] + layer * RW; const float* lnb = A.in[I_LNB] + layer * RW; const float* kaw = A.in[I_KA] + layer * RW; const float* rk = A.in[I_RK] + layer * RW;
    const float lam_init = 0.8f - 0.6f * expf(-0.3f * (float)layer);
    const float s1 = wave_sum(A.in[I_LQ1][layer * 64 + l] * A.in[I_LK1][layer * 64 + l]), s2 = wave_sum(A.in[I_LQ2][layer * 64 + l] * A.in[I_LK2][layer * 64 + l]);
    const float lam = expf(s1) - expf(s2) + lam_init;
    const int sub = l & 15, hg = l >> 4;
    const f32x4 sg0 = *(const f32x4*)(A.in[I_SUBLN] + layer * 128 + sub * 8) * (1.f - lam_init), sg1 = *(const f32x4*)(A.in[I_SUBLN] + layer * 128 + sub * 8 + 4) * (1.f - lam_init);
    for (int m = F.gw; m < nrows; m += F.ngw) {
        const size_t ro = (size_t)m * RW;
        f32x4 ly0[3], ly1[3], lw[3], lb[3], lka[3], lrk[3]; u32x2 la0[3], la1[3], lk[3], lr[3], lv[3], lg[3]; u32x4 ld0[2], ld1[2];
#pragma unroll
        for (int it = 0; it < 3; ++it) { const int c = (it * 4 + hg) * 64 + sub * 4;
            ly0[it] = *(const f32x4*)(YS0 + ro + c); ly1[it] = *(const f32x4*)(YS1 + ro + c);
            la0[it] = *(const u32x2*)(AS0 + ro + c); la1[it] = *(const u32x2*)(AS1 + ro + c); lk[it] = *(const u32x2*)(K + ro + c);
            lr[it] = *(const u32x2*)(R + ro + c); lv[it] = *(const u32x2*)(V + ro + c); lg[it] = *(const u32x2*)(G + ro + c);
            lw[it] = *(const f32x4*)(lnw + c); lb[it] = *(const f32x4*)(lnb + c); lka[it] = *(const f32x4*)(kaw + c); lrk[it] = *(const f32x4*)(rk + c); }
#pragma unroll
        for (int ps = 0; ps < 2; ++ps) { const int head = ps * 4 + hg; const int c = (head < 6 ? head : 0) * 128 + sub * 8;
            ld0[ps] = *(const u32x4*)(OD0 + ro + c); ld1[ps] = *(const u32x4*)(OD1 + ro + c); }
        asm volatile("" ::: "memory");
#pragma unroll
        for (int it = 0; it < 3; ++it) { const int c = (it * 4 + hg) * 64 + sub * 4;
            const f32x4 y = ly0[it] + ly1[it];
            const f32x4 a0 = unpack4(la0[it]), a1 = unpack4(la1[it]), k = unpack4(lk[it]), r = unpack4(lr[it]), v = unpack4(lv[it]), g = unpack4(lg[it]);
            const f32x4 w4 = lw[it], b4 = lb[it], ka4 = lka[it], rk4 = lrk[it];
            const float mean = row16_sum((y.x + y.y) + (y.z + y.w)) * (1.f / 64.f);
            const f32x4 d = y - mean;
            const float var = row16_sum((d.x * d.x + d.y * d.y) + (d.z * d.z + d.w * d.w)) * (1.f / 64.f);
            const f32x4 yn = d * rsqrtf(var + 64e-5f) * w4 + b4;
            const f32x4 kd = k * ((a0 + a1 - 2.f) * ka4 + 2.f);
            const f32x4 pr = r * kd * rk4;
            const float bs = row16_sum((pr.x + pr.y) + (pr.z + pr.w));
            *(u32x2*)(YR + ro + c) = pack4((yn + v * bs) * g); }
#pragma unroll
        for (int ps = 0; ps < 2; ++ps) { const int head = ps * 4 + hg;
            if (head < 6) { const int c = head * 128 + sub * 8;
                float pa_[8], pb_[8]; unpack8(ld0[ps], pa_); unpack8(ld1[ps], pb_);
                const f32x4 o0 = (f32x4){pa_[0], pa_[1], pa_[2], pa_[3]} - (f32x4){pb_[0], pb_[1], pb_[2], pb_[3]} * lam, o1 = (f32x4){pa_[4], pa_[5], pa_[6], pa_[7]} - (f32x4){pb_[4], pb_[5], pb_[6], pb_[7]} * lam;
                const float ss = row16_sum(((o0.x * o0.x + o0.y * o0.y) + (o0.z * o0.z + o0.w * o0.w)) + ((o1.x * o1.x + o1.y * o1.y) + (o1.z * o1.z + o1.w * o1.w)));
                const float rs = rsqrtf(ss * (1.f / 128.f) + 1e-5f);
                const f32x4 r0 = o0 * rs * sg0, r1 = o1 * rs * sg1;
                u32x4 w; w.x = cvt_pk_bf16(r0.x, r0.y); w.y = cvt_pk_bf16(r0.z, r0.w); w.z = cvt_pk_bf16(r1.x, r1.y); w.w = cvt_pk_bf16(r1.z, r1.w);
                *(u32x4*)(YD + ro + c) = w; } }
        asm volatile("" ::: "memory");
    }
}
__device__ __forceinline__ void conv_act(const Frame& F, int layer, int nrows) {
    const Args& A = *F.a;
    const bf16_t* U = (const bf16_t*)(F.ws + A_U); bf16_t* ACT = (bf16_t*)(F.ws + A_ACT);
    const float* cw = A.in[I_CW] + (size_t)layer * 3 * FF2; const float* cbias = A.in[I_CB] + (size_t)layer * FF2;
    constexpr int NCK = FF / 8;
    const int nitems = (nrows / 16) * NCK;
    for (int it = blockIdx.x * NTHREADS + F.tid; it < nitems; it += gridDim.x * NTHREADS) {
        const int rg = it / NCK, ck = it % NCK, r0 = rg * 16, c = ck * 8;
        const bool lat = r0 < TL; const int t0 = lat ? (r0 & 4095) : ((r0 - TL) & 255), len = lat ? SEQ : CTX;
        float wv[3][8], wg[3][8], bv[8], bg[8];
#pragma unroll
        for (int e = 0; e < 8; ++e) { bv[e] = cbias[c + e]; bg[e] = cbias[FF + c + e];
#pragma unroll
            for (int k = 0; k < 3; ++k) { wv[k][e] = cw[(size_t)k * FF2 + c + e]; wg[k][e] = cw[(size_t)k * FF2 + FF + c + e]; } }
        float pv[8], pg[8], cv[8], cg[8], nv[8], ng[8];
        const bf16_t* up = U + (size_t)r0 * FF2 + c;
        if (t0 > 0) { unpack8(*(const u32x4*)(up - FF2), pv); unpack8(*(const u32x4*)(up - FF2 + FF), pg); }
        else {
#pragma unroll
            for (int e = 0; e < 8; ++e) { pv[e] = 0.f; pg[e] = 0.f; } }
        unpack8(*(const u32x4*)(up), cv); unpack8(*(const u32x4*)(up + FF), cg);
#pragma unroll 1
        for (int i = 0; i < 16; ++i) {
            if (t0 + i + 1 < len) { unpack8(*(const u32x4*)(up + (size_t)(i + 1) * FF2), nv); unpack8(*(const u32x4*)(up + (size_t)(i + 1) * FF2 + FF), ng); }
            else {
#pragma unroll
                for (int e = 0; e < 8; ++e) { nv[e] = 0.f; ng[e] = 0.f; } }
            float o[8];
#pragma unroll
            for (int e = 0; e < 8; ++e) { const float a = pv[e] * wv[0][e] + cv[e] * wv[1][e] + nv[e] * wv[2][e] + bv[e]; const float g = pg[e] * wg[0][e] + cg[e] * wg[1][e] + ng[e] * wg[2][e] + bg[e];
                o[e] = a * g * sigmoidf_(g); pv[e] = cv[e]; pg[e] = cg[e]; cv[e] = nv[e]; cg[e] = ng[e]; }
            *(u32x4*)(ACT + (size_t)(r0 + i) * FF + c) = pack8(o);
        }
    }
}

enum { S_INIT = 0, S_NORM1, S_IN, S_PREP, S_LR, S_VRES, S_MIX, S_POST, S_GATE, S_MERGE, S_OUT, S_NORM2, S_UP, S_CONV, S_DOWN, S_NEXT, S_FINAL };
constexpr int NPH = 28;
__host__ __device__ inline int phase_code(int p) {
    if (p < 2) return p;
    if (p < 15) { const int s = p - 2; return (s < 3 ? S_IN + s : S_MIX + (s - 3)); }
    { const int s = p - 15; return 256 | (s < 3 ? S_IN + s : S_MIX + (s - 3)); }
}

#ifndef PROBE_MASK
#define PROBE_MASK 0
#endif
__host__ __device__ inline int stage_of_phase(int b) { int code = phase_code(b); int st = code & 255; if ((code >> 8) == 1 && st == S_NEXT) st = S_FINAL; return st; }
__host__ __device__ inline int expand_phase(int p, int& rep) {
    if (PROBE_MASK == 0) { rep = 0; return p; }
    int q = 0;
    for (int b = 0; b < NPH; ++b) { const int n = ((PROBE_MASK >> stage_of_phase(b)) & 1) ? 2 : 1; if (p < q + n) { rep = p - q; return b; } q += n; }
    rep = 0; return NPH - 1;
}
__global__ void __launch_bounds__(NTHREADS, 2) mega_fwd(Args args) {
    extern __shared__ __attribute__((aligned(16))) unsigned char lds_raw[];
    const Args& A = args;
    volatile LAS unsigned* MISC = (volatile LAS unsigned*)((LAS unsigned char*)lds_raw + MISC_OFF);
    if (threadIdx.x < 32) MISC[threadIdx.x] = 0u;
    __syncthreads();
    if ((threadIdx.x & 63) == 0) MISC[16 + (threadIdx.x >> 6)] = (unsigned)__builtin_amdgcn_s_getreg((1 << 11) | (4 << 6) | 4) & 3u;
    __syncthreads();
    if (threadIdx.x == 0) {
        unsigned seen = 0u, nr = 0u;
        for (int w = 0; w < 8; ++w) { const unsigned sd = MISC[16 + w]; if (!((seen >> sd) & 1u) && nr < 4u) { seen |= 1u << sd; MISC[24 + w] = nr++; } else MISC[24 + w] = 0xFFFFFFFFu; }
        for (int w = 0; w < 8; ++w) if (MISC[24 + w] == 0xFFFFFFFFu && nr < 4u) MISC[24 + w] = nr++;
    }
    __syncthreads();
    XcdBarrier bar; bar.bar = (unsigned*)(args.ws + O_CTL) + 4096; bar.x = 0; bar.st = nullptr;
    if (args.ph_hi - args.ph_lo > 1) bar = xcd_barrier_post((unsigned*)(args.ws + O_CTL) + 4096, MISC + 8);
    for (int p = args.ph_lo; p < args.ph_hi; ++p) {
        int rep = 0; int code = phase_code(expand_phase(p, rep)); const int layer = code >> 8; int st = code & 255;
        if (layer == 1 && st == S_NEXT) st = S_FINAL;
        const bool last = layer == 1;
        const int Mrows = last ? TL : TT;
        const int tid_ = lthread();
        size_t zoff_ = 0; asm volatile("" : "+s"(zoff_)); unsigned char* ws_ = args.ws + zoff_;
        Frame F; F.a = &args; F.ws = ws_; F.lds = (char*)lds_raw; F.tid = tid_; F.lane = F.tid & 63; F.wave = __builtin_amdgcn_readfirstlane(F.tid >> 6);
        F.gw = blockIdx.x * NWAVES + F.wave; F.ngw = gridDim.x * NWAVES;
        float* XC = (float*)(F.ws + O_XC);
        const float* MODB = (const float*)(F.ws + O_MOD);
        const float* mod = MODB + (size_t)layer * 5 * MODW;
        int njobs = 0;
        switch (st) {
        case S_INIT: adaln(F); convert_weights(F, 0); break;
        case S_NORM1: norm_rows(F, A.in[I_X], A.in[I_CTX], A.in[I_NORM1], mod, 0, 2048, TT); break;
        case S_PREP: rwkv_prep(F, layer); qk_prep(F, layer); break;
        case S_MIX: ph_mix(F, layer, rep); break;
        case S_POST: ph_post(F, layer); break;
        case S_NORM2: norm_rows(F, A.out, XC, A.in[I_NORM2] + layer * DM, mod, 3 * 2048, 4 * 2048, Mrows); break;
        case S_CONV: conv_act(F, layer, Mrows); break;
        case S_NEXT: convert_weights(F, 1); norm_rows(F, A.out, XC, A.in[I_NORM1] + DM, MODB + (size_t)5 * MODW, 0, 2048, TT); break;
        case S_FINAL: final_norm(F); break;
        case S_LR: njobs = layer == 1 ? 2 : 1; break;
        case S_MERGE: njobs = 3; break;
        default: njobs = 1; break;
        }
        for (int j = 0; j < njobs; ++j) {
            pg8::Gemm g; Epi e{}; e.ws = F.ws; e.layer = layer;
            switch (st) {
            case S_IN: e.mode = EM_ROUTE; g = pg8::Gemm{(const bf16_t*)(F.ws + O_H), (const bf16_t*)(F.ws + W_IN), TT, 6144, 2048}; break;
            case S_LR:
                if (j == 0) { e.mode = EM_LR; e.p0 = A.in[I_W0] + layer * 2 * RW; e.p1 = A.in[I_A0] + layer * 2 * RW; g = pg8::Gemm{(const bf16_t*)(F.ws + A_LR), (const bf16_t*)(F.ws + W_LR), TT, 3840, 256}; }
                else { e.mode = EM_VRES; e.p0 = A.in[I_V0]; g = pg8::Gemm{(const bf16_t*)(F.ws + A_YS), (const bf16_t*)(F.ws + W_V12), TT, 768, 768}; }
                break;
            case S_GATE: e.mode = EM_SIGMOID; e.O = (bf16_t*)(F.ws + A_GATES); e.ldc = 6144;
                g = pg8::Gemm{(const bf16_t*)(F.ws + O_H), (const bf16_t*)(F.ws + W_IN) + (size_t)6144 * 2048, Mrows, 6144, 2048}; break;
            case S_MERGE: e.mode = EM_MERGE; e.aux = j;
                g = pg8::Gemm{(const bf16_t*)(F.ws + (j == 0 ? A_YR : (j == 1 ? A_YG : A_YD))), (const bf16_t*)(F.ws + W_BR) + (size_t)j * 2048 * 768, Mrows, 2048, 768}; break;
            case S_OUT: e.mode = EM_RESID; e.aux = 2 * 2048; e.gmod = mod;
                e.xin_l = layer == 0 ? A.in[I_X] : A.out; e.xin_c = layer == 0 ? A.in[I_CTX] : XC; e.xout_l = A.out; e.xout_c = XC;
                g = pg8::Gemm{(const bf16_t*)(F.ws + O_H), (const bf16_t*)(F.ws + W_OUT), Mrows, 2048, 2048}; break;
            case S_UP: e.mode = EM_BF16; e.O = (bf16_t*)(F.ws + A_U); e.ldc = FF2;
                g = pg8::Gemm{(const bf16_t*)(F.ws + O_H), (const bf16_t*)(F.ws + W_UP), Mrows, FF2, 2048}; break;
            default: e.mode = EM_RESID; e.aux = 5 * 2048; e.gmod = mod; e.xin_l = A.out; e.xin_c = XC; e.xout_l = A.out; e.xout_c = XC;
                g = pg8::Gemm{(const bf16_t*)(F.ws + A_ACT), (const bf16_t*)(F.ws + W_DOWN), Mrows, 2048, FF}; break;
            }
            pg8::StaticOrder S; S.init(g.M, g.N, (int)gridDim.x, (int)blockIdx.x);
            pg8::gemm_phase<Epi, pg8::StaticOrder, true, true>((LAS unsigned char*)lds_raw, g, S, e);
            __syncthreads();
        }
        if (p + 1 < args.ph_hi) { if (args.ph_hi > 1000) { __threadfence(); cg::this_grid().sync(); }
            xcd_barrier(bar); }
    }
}

extern "C" void kernel_launch(void* const* d_in, const int* in_sizes, int n_in, void* d_out, int out_size, void* d_ws, size_t ws_size, hipStream_t stream) {
    static int grid = 0;
    if (grid == 0) {
        if (n_in != N_IN || out_size != TL * DM || ws_size < WS_NEED) { fprintf(stderr, "kernel_launch: unexpected shapes n_in %d out %d ws %zu (need %zu)\n", n_in, out_size, ws_size, (size_t)WS_NEED); grid = -1; return; }
        int dev = 0, cus = 0, per_cu = 0;
        hipGetDevice(&dev); hipDeviceGetAttribute(&cus, hipDeviceAttributeMultiprocessorCount, dev);
        if (hipFuncSetAttribute((const void*)mega_fwd, hipFuncAttributeMaxDynamicSharedMemorySize, LDS_BYTES) != hipSuccess) { fprintf(stderr, "kernel_launch: hipFuncSetAttribute failed\n"); grid = -1; return; }
        hipOccupancyMaxActiveBlocksPerMultiprocessor(&per_cu, (const void*)mega_fwd, NTHREADS, LDS_BYTES);
        (void)hipGetLastError();
        if (per_cu < 1) { fprintf(stderr, "kernel_launch: occupancy query says %d blocks/CU\n", per_cu); per_cu = 1; }
        grid = cus;
        if (grid > 256) grid = 256;
    }
    if (grid < 0) return;
    hipMemsetAsync((char*)d_ws + O_CTL, 0, CTL_BYTES, stream);
    Args a{};
    for (int i = 0; i < N_IN; ++i) a.in[i] = (const float*)d_in[i];
    a.out = (float*)d_out; a.ws = (unsigned char*)d_ws;
#if MK_ONE_LAUNCH
    { int nph = 0; for (int b = 0; b < NPH; ++b) nph += ((PROBE_MASK >> stage_of_phase(b)) & 1) ? 2 : 1; a.ph_lo = 0; a.ph_hi = nph; }
    void* kargs[] = {&a};
    hipError_t e = hipLaunchCooperativeKernel((const void*)mega_fwd, dim3(grid), dim3(NTHREADS), kargs, LDS_BYTES, stream);
    if (e != hipSuccess) fprintf(stderr, "kernel_launch: cooperative launch failed: %s\n", hipGetErrorString(e));
#else
    for (int p = 0; p < NPH; ++p) { a.ph_lo = p; a.ph_hi = p + 1; hipLaunchKernelGGL(mega_fwd, dim3(grid), dim3(NTHREADS), LDS_BYTES, stream, a); }
#endif
}
```

```cpp
#include <hip/hip_runtime.h>
#include <hip/hip_cooperative_groups.h>
#include <cstdio>
#include <cstdint>
namespace cg = cooperative_groups;
#ifndef MK_ONE_LAUNCH
#define MK_ONE_LAUNCH 1
#endif
__device__ __forceinline__ int lthread() { int t = threadIdx.x; asm volatile("" : "+v"(t)); return t; }
namespace pg8 {
#define PG8_LAS __attribute__((address_space(3)))
typedef unsigned short bf16_t;
typedef short bf16x8 __attribute__((ext_vector_type(8)));
typedef float f32x4 __attribute__((ext_vector_type(4)));
typedef unsigned u32x4 __attribute__((ext_vector_type(4)));
constexpr int BM = 256, BK = 64, HALF = 128, HTB = HALF * BK * 2  , STAGE_BYTES = 8 * HTB, NXCD = 8, WGM = 8;

__host__ __device__ __forceinline__ int lds_byte(int r, int c) { const int st = (r >> 4) * 2 + (c >> 5), rr = r & 15, cc = c & 31, ob = rr * 64 + cc * 2; return st * 1024 + (ob ^ (((ob >> 9) & 1) << 5)); }
__host__ __device__ __forceinline__ void stage_rc(int b, int& R, int& C) { const int st = b / 1024, sb = b % 1024, swz = sb ^ (((sb >> 9) & 1) << 5); R = (st >> 1) * 16 + swz / 64; C = (st & 1) * 32 + (swz % 64) / 2; }
__host__ __device__ __forceinline__ int perm32(int rho) { const int n = rho >> 4, i = rho & 15; return 8 * (i >> 2) + 4 * n + (i & 3); }

struct Unit { int pm, pn; };
struct Gemm { const bf16_t* A; const bf16_t* Bt; int M, N, K; };

struct StaticOrder {
    int nM, nN, nwg, G, c;
    __host__ __device__ void init(int M, int N, int G_, int c_) { nM = M / BM; nN = N / BM; nwg = nM * nN; G = G_; c = c_; }
    __host__ __device__ bool next(int i, Unit& u) const {
        const long L = (long)i * G + c; if (L >= nwg) return false;
        int wgid = (int)L; { const int q = nwg / NXCD, r = nwg % NXCD, xcd = wgid % NXCD, off = wgid / NXCD; wgid = (xcd < r ? xcd * (q + 1) : r * (q + 1) + (xcd - r) * q) + off; }
        const int nig = WGM * nN, gid = wgid / nig, fm = gid * WGM, gsz = (nM - fm) < WGM ? (nM - fm) : WGM;
        u.pm = fm + ((wgid % nig) % gsz); u.pn = (wgid % nig) / gsz; return true;
    }
    __device__ __forceinline__ void a_ready(const Unit&) const {}
    __device__ __forceinline__ void done(const Unit&) const {}
};

template <class Epi, class Sched, bool ALIGN_EPI = false, bool SP2 = false>
__device__ __forceinline__ void gemm_phase(PG8_LAS unsigned char* lds, const Gemm g, const Sched& S, const Epi& E) {
    const int tid = lthread(), wid = __builtin_amdgcn_readfirstlane(tid >> 6), lane = tid & 63, wr = wid >> 2, wc = wid & 3, fr = lane & 15, fq = lane >> 4;
    const int K = g.K, nt = K / BK;
    unsigned voffA[2], voffB[2];
#pragma unroll
    for (int i = 0; i < 2; ++i) { int R, C; stage_rc(tid * 16 + i * 8192, R, C); const int Rb = Epi::PERM ? ((R & ~31) + perm32(R & 31)) : R;
        voffA[i] = (unsigned)(R * K + C) * 2u; voffB[i] = (unsigned)(Rb * K + C) * 2u; }
    const size_t kstep = (size_t)(BK * 2);
    const size_t hstep = (size_t)HALF * K * 2;
    const size_t tstep = 2 * hstep;
    const unsigned ldsw = (unsigned)wid * 1024u;
    const int aoff = lds_byte(wr * 64 + fr, fq * 8), boff = lds_byte(wc * 32 + fr, fq * 8);
#define PG8_SA(b, h) (((b) * 2 + (h)) * HTB)
#define PG8_SB(b, h) ((4 + (b) * 2 + (h)) * HTB)
#define PG8_STAGE(bufoff, gbase, voff) do { _Pragma("unroll") for (int _i = 0; _i < 2; ++_i) \
        __builtin_amdgcn_global_load_lds((const unsigned*)((const char*)(gbase) + (voff)[_i]), (PG8_LAS unsigned*)(lds + (bufoff) + ldsw + _i * 8192), 16, 0, 0); } while (0)
#define PG8_LDA(dst, b, h) do { _Pragma("unroll") for (int m = 0; m < 4; ++m) _Pragma("unroll") for (int k = 0; k < 2; ++k) dst[m][k] = *(const PG8_LAS bf16x8*)(lds + PG8_SA(b, h) + aoff + m * 2048 + k * 1024); } while (0)
#define PG8_LDB(dst, b, h) do { _Pragma("unroll") for (int n = 0; n < 2; ++n) _Pragma("unroll") for (int k = 0; k < 2; ++k) dst[n][k] = *(const PG8_LAS bf16x8*)(lds + PG8_SB(b, h) + boff + n * 2048 + k * 1024); } while (0)
#define PG8_MMA(ai, bj, At, Bt) do { __builtin_amdgcn_s_setprio(1); _Pragma("unroll") for (int m = 0; m < 4; ++m) _Pragma("unroll") for (int n = 0; n < 2; ++n) _Pragma("unroll") for (int k = 0; k < 2; ++k) \
        acc[ai][bj][m][n] = __builtin_amdgcn_mfma_f32_16x16x32_bf16(Bt[n][k], At[m][k], acc[ai][bj][m][n], 0, 0, 0); __builtin_amdgcn_s_setprio(0); } while (0)
#define PG8_WAIT_V(n) asm volatile("s_waitcnt vmcnt(" #n ")" ::: "memory")
#define PG8_WAIT_L(n) asm volatile("s_waitcnt lgkmcnt(" #n ")" ::: "memory")
#define PG8_BAR __builtin_amdgcn_s_barrier()
#define PG8_SCHED __builtin_amdgcn_sched_barrier(0)
    Unit cur, nxt; int ui = 0;
    if (!S.next(0, cur)) return;
    f32x4 acc[2][2][4][2];
#pragma unroll
    for (int a = 0; a < 2; ++a)
#pragma unroll
        for (int b = 0; b < 2; ++b)
#pragma unroll
            for (int m = 0; m < 4; ++m)
#pragma unroll
                for (int n = 0; n < 2; ++n) acc[a][b][m][n] = (f32x4){0.f, 0.f, 0.f, 0.f};
    bf16x8 At[4][2], B0[2][2], B1[2][2];
    const char* cA = (const char*)g.A + (size_t)cur.pm * tstep; const char* cB = (const char*)g.Bt + (size_t)cur.pn * tstep;
    S.a_ready(cur);
    if constexpr (SP2) {
        PG8_STAGE(PG8_SB(0, 0), cB, voffB); PG8_STAGE(PG8_SB(0, 1), cB + hstep, voffB); PG8_STAGE(PG8_SA(0, 0), cA, voffA); PG8_STAGE(PG8_SA(0, 1), cA + hstep, voffA);
        if (wr == 1) PG8_BAR;
        PG8_WAIT_V(2); PG8_BAR;
        PG8_STAGE(PG8_SB(1, 0), cB + kstep, voffB); PG8_STAGE(PG8_SA(1, 0), cA + kstep, voffA); PG8_STAGE(PG8_SB(1, 1), cB + hstep + kstep, voffB);
        PG8_WAIT_V(6); PG8_BAR;
    } else {
        PG8_STAGE(PG8_SB(0, 0), cB, voffB); PG8_STAGE(PG8_SA(0, 0), cA, voffA); PG8_STAGE(PG8_SB(0, 1), cB + hstep, voffB); PG8_STAGE(PG8_SA(0, 1), cA + hstep, voffA);
        if (wr == 1) PG8_BAR;
        PG8_WAIT_V(4); PG8_BAR;
        PG8_STAGE(PG8_SB(1, 0), cB + kstep, voffB); PG8_STAGE(PG8_SA(1, 0), cA + kstep, voffA); PG8_STAGE(PG8_SB(1, 1), cB + hstep + kstep, voffB);
        PG8_WAIT_V(6); PG8_BAR;
    }
    for (;;) {
        const bool has_next = S.next(ui + 1, nxt);
        const char* nA = has_next ? (const char*)g.A + (size_t)nxt.pm * tstep : cA; const char* nB = has_next ? (const char*)g.Bt + (size_t)nxt.pn * tstep : cB;
        for (int t = 0; t < nt; t += 2) {
            const bool last = (t == nt - 2);
            const char* a1 = cA + (size_t)(t + 1) * kstep;
            const char* a2 = last ? nA : cA + (size_t)(t + 2) * kstep; const char* b2 = last ? nB : cB + (size_t)(t + 2) * kstep;
            const char* a3 = a2 + kstep; const char* b3 = b2 + kstep;
            if (last && has_next) S.a_ready(nxt);
            if constexpr (SP2) {
            PG8_LDB(B0, 0, 0); PG8_LDB(B1, 0, 1); PG8_SCHED; PG8_LDA(At, 0, 0); PG8_STAGE(PG8_SA(1, 1), a1 + hstep, voffA);
            PG8_WAIT_V(8); PG8_WAIT_L(0); PG8_BAR; PG8_MMA(0, 0, At, B0); PG8_MMA(0, 1, At, B1); PG8_BAR; PG8_SCHED;
            PG8_LDA(At, 0, 1); PG8_STAGE(PG8_SB(0, 0), b2, voffB); PG8_STAGE(PG8_SB(0, 1), b2 + hstep, voffB); PG8_STAGE(PG8_SA(0, 0), a2, voffA);
            PG8_WAIT_V(8); PG8_WAIT_L(0); PG8_BAR; PG8_MMA(1, 0, At, B0); PG8_MMA(1, 1, At, B1); PG8_BAR; PG8_SCHED;
            PG8_LDB(B0, 1, 0); PG8_LDB(B1, 1, 1); PG8_SCHED; PG8_LDA(At, 1, 0); PG8_STAGE(PG8_SA(0, 1), a2 + hstep, voffA);
            PG8_WAIT_V(8); PG8_WAIT_L(0); PG8_BAR; PG8_MMA(0, 0, At, B0); PG8_MMA(0, 1, At, B1); PG8_BAR; PG8_SCHED;
            PG8_LDA(At, 1, 1); PG8_STAGE(PG8_SB(1, 0), b3, voffB); PG8_STAGE(PG8_SB(1, 1), b3 + hstep, voffB); PG8_STAGE(PG8_SA(1, 0), a3, voffA);
            PG8_WAIT_V(8); PG8_WAIT_L(0); PG8_BAR; PG8_MMA(1, 0, At, B0); PG8_MMA(1, 1, At, B1); PG8_BAR; PG8_SCHED;
            } else {
            PG8_LDB(B0, 0, 0); PG8_SCHED; PG8_LDA(At, 0, 0); PG8_STAGE(PG8_SA(1, 1), a1 + hstep, voffA);
            PG8_WAIT_L(8); PG8_BAR; PG8_WAIT_L(0); PG8_MMA(0, 0, At, B0); PG8_BAR; PG8_SCHED;
            PG8_LDB(B1, 0, 1); PG8_STAGE(PG8_SB(0, 0), b2, voffB);
            PG8_BAR; PG8_WAIT_L(0); PG8_MMA(0, 1, At, B1); PG8_BAR;
            PG8_LDA(At, 0, 1); PG8_STAGE(PG8_SA(0, 0), a2, voffA);
            PG8_BAR; PG8_WAIT_L(0); PG8_MMA(1, 0, At, B0); PG8_BAR; PG8_SCHED;
            PG8_STAGE(PG8_SB(0, 1), b2 + hstep, voffB);
            PG8_WAIT_V(6); PG8_BAR; PG8_MMA(1, 1, At, B1); PG8_BAR;
            PG8_LDB(B0, 1, 0); PG8_SCHED; PG8_LDA(At, 1, 0); PG8_STAGE(PG8_SA(0, 1), a2 + hstep, voffA);
            PG8_WAIT_L(8); PG8_BAR; PG8_WAIT_L(0); PG8_MMA(0, 0, At, B0); PG8_BAR; PG8_SCHED;
            PG8_LDB(B1, 1, 1); PG8_STAGE(PG8_SB(1, 0), b3, voffB);
            PG8_BAR; PG8_WAIT_L(0); PG8_MMA(0, 1, At, B1); PG8_BAR;
            PG8_LDA(At, 1, 1); PG8_STAGE(PG8_SA(1, 0), a3, voffA);
            PG8_BAR; PG8_WAIT_L(0); PG8_MMA(1, 0, At, B0); PG8_BAR; PG8_SCHED;
            PG8_STAGE(PG8_SB(1, 1), b3 + hstep, voffB);
            PG8_WAIT_V(6); PG8_BAR; PG8_MMA(1, 1, At, B1); PG8_BAR;
            }
        }
        if constexpr (ALIGN_EPI) { if (wr == 0) PG8_BAR; }
        if constexpr (!Epi::AFTER_DRAIN) { E(acc, cur, wr, wc, fr, fq); S.done(cur); }
        if (!has_next) break;
#pragma unroll
        for (int a = 0; a < 2; ++a)
#pragma unroll
            for (int b = 0; b < 2; ++b)
#pragma unroll
                for (int m = 0; m < 4; ++m)
#pragma unroll
                    for (int n = 0; n < 2; ++n) acc[a][b][m][n] = (f32x4){0.f, 0.f, 0.f, 0.f};
        cur = nxt; cA = nA; cB = nB; ++ui;
        if constexpr (ALIGN_EPI) { if (wr == 1) PG8_BAR; }
    }
    PG8_WAIT_V(0);
    if constexpr (!ALIGN_EPI) { if (wr == 0) PG8_BAR; }
    PG8_BAR;
    if constexpr (Epi::AFTER_DRAIN) { E.fused(acc, cur, wr, wc, fr, fq, lds, wid, lane); S.done(cur); }
#undef PG8_SA
#undef PG8_SB
#undef PG8_STAGE
#undef PG8_LDA
#undef PG8_LDB
#undef PG8_MMA
#undef PG8_WAIT_V
#undef PG8_WAIT_L
#undef PG8_BAR
#undef PG8_SCHED
}
}

#define LAS __attribute__((address_space(3)))
typedef unsigned short bf16_t;
typedef float f32x4 __attribute__((ext_vector_type(4)));
typedef float f32x2 __attribute__((ext_vector_type(2)));
typedef unsigned u32x4 __attribute__((ext_vector_type(4)));
typedef unsigned u32x2 __attribute__((ext_vector_type(2)));
typedef short bf16x8 __attribute__((ext_vector_type(8)));

constexpr int DM = 2048, NB = 4, SEQ = 4096, CTX = 256, TL = NB * SEQ, TC = NB * CTX, TT = TL + TC, KVS = CTX + SEQ;
constexpr int RW = 768, RCOLS = 2560, FF = 5504, FF2 = 11008, MODW = 12288;
constexpr int NTHREADS = 512, NWAVES = 8;

enum { I_X = 0, I_C, I_CTX, I_CCTX, I_WMOD, I_BMOD, I_NORM1, I_WIN, I_MU, I_W0, I_W2, I_A0, I_A2, I_KK, I_KA, I_RK, I_G2, I_LNW, I_LNB,
       I_V0, I_V1, I_V2, I_QN, I_KN, I_LQ1, I_LK1, I_LQ2, I_LK2, I_SUBLN, I_WBR, I_WBG, I_WBD, I_WOUT, I_NORM2, I_UP, I_CW, I_CB, I_DOWN, I_FN, N_IN };

#define XB_TMO      128
#define XB_XCNT(j)  (256  + 64 * (j))
#define XB_XSUB(j)  (1280 + 64 * (j))
#define XB_XGEN(j)  (2304 + 64 * (j))
#define XB_TOP      3328
#define XB_TOPGEN   3392
#define XCD_BAR_WORDS 3456
#define XB_SPIN_CAP (1u << 18)

__device__ __forceinline__ unsigned xb_ld(unsigned* p)              { return __hip_atomic_load(p, __ATOMIC_RELAXED, __HIP_MEMORY_SCOPE_AGENT); }
__device__ __forceinline__ unsigned xb_add(unsigned* p, unsigned v) { return __hip_atomic_fetch_add(p, v, __ATOMIC_RELAXED, __HIP_MEMORY_SCOPE_AGENT); }
__device__ __forceinline__ unsigned xb_xcc_id() { return (unsigned)__builtin_amdgcn_s_getreg((3 << 11) | 20) & 0xFu; }
#define XB_SPIN(cond, bar) do { unsigned _sp = 0; while (cond) { __builtin_amdgcn_s_sleep(1); \
    if ((++_sp & 255u) == 0u) { if (xb_ld(&(bar)[XB_TMO])) break; if (_sp > XB_SPIN_CAP) { atomicAdd(&(bar)[XB_TMO], 1u); break; } } } } while (0)

struct XcdBarrier {
    unsigned* bar; unsigned x;
    volatile LAS unsigned* st;
};

__device__ __forceinline__ XcdBarrier xcd_barrier_post(unsigned* bar, volatile LAS unsigned* st) {
    XcdBarrier b; b.bar = bar; b.x = xb_xcc_id(); b.st = st;
    if (threadIdx.x == 0) (void)xb_add(&bar[XB_XCNT(b.x)], 1u);
    return b;
}
__device__ __forceinline__ void xcd_barrier_complete(unsigned* bar, unsigned x, unsigned& nloc, unsigned& nx) {
    const unsigned G = gridDim.x * gridDim.y * gridDim.z;
    unsigned sum, cnt, mine, sp = 0u;
    for (;;) {
        sum = 0u; cnt = 0u; mine = 0u;
#pragma unroll
        for (unsigned j = 0; j < 16; ++j) { const unsigned c = xb_ld(&bar[XB_XCNT(j)]); sum += c; cnt += (c > 0u) ? 1u : 0u; mine = (j == x) ? c : mine; }
        if (sum == G) break;
        __builtin_amdgcn_s_sleep(1);
        if ((++sp & 255u) == 0u) { if (xb_ld(&bar[XB_TMO])) break; if (sp > XB_SPIN_CAP) { atomicAdd(&bar[XB_TMO], 1u); break; } }
    }
    nloc = mine > 0u ? mine : 1u; nx = cnt > 0u ? cnt : 1u;
}

__device__ __forceinline__ void xcd_barrier(const XcdBarrier& b) {
    asm volatile("s_waitcnt vmcnt(0)" ::: "memory");
    __syncthreads();
    if (threadIdx.x == 0) {
        unsigned* bar = b.bar;
        __builtin_amdgcn_s_waitcnt(0);
        unsigned nloc = b.st[0], nx = b.st[1];
        if (nloc == 0u) { xcd_barrier_complete(bar, b.x, nloc, nx); b.st[0] = nloc; b.st[1] = nx; }
        const unsigned old = xb_add(&bar[XB_XSUB(b.x)], 1u);
        const unsigned gen = old / nloc;
        if (old + 1u == (gen + 1u) * nloc) {
            __builtin_amdgcn_fence(__ATOMIC_RELEASE, "agent");
            asm volatile("s_waitcnt vmcnt(0)" ::: "memory");
            const unsigned og = xb_add(&bar[XB_TOP], 1u);
            const unsigned tg = og / nx;
            if (og + 1u == (tg + 1u) * nx) xb_add(&bar[XB_TOPGEN], 1u);
            else XB_SPIN(xb_ld(&bar[XB_TOPGEN]) == tg, bar);
            __builtin_amdgcn_fence(__ATOMIC_ACQUIRE, "agent");
            xb_add(&bar[XB_XGEN(b.x)], 1u);
            asm volatile("s_waitcnt vmcnt(0)" ::: "memory");
        } else {
            XB_SPIN(xb_ld(&bar[XB_XGEN(b.x)]) == gen, bar);
            __builtin_amdgcn_fence(__ATOMIC_ACQUIRE, "agent");
            asm volatile("s_waitcnt vmcnt(0)" ::: "memory");
        }
    }
    __syncthreads();
}

constexpr size_t MiB = 1u << 20, HMiB = 1u << 19;
constexpr size_t O_CTL = 0, CTL_BYTES = 65536, O_MOD = 1 * MiB, O_XC = 2 * MiB;
constexpr size_t W_IN = 10 * MiB, W_BR = W_IN + 48 * MiB, W_OUT = W_BR + 9 * MiB, W_UP = W_OUT + 8 * MiB, W_DOWN = W_UP + 43 * MiB,
                 W_LR = W_DOWN + 22 * MiB, W_V12 = W_LR + (size_t)3840 * 256 * 2;
constexpr size_t O_H = 143 * MiB, O_VF = 211 * MiB, O_AR = 237 * MiB;
static_assert(W_V12 + (size_t)768 * 768 * 2 == O_H, "weight map");
constexpr size_t A_QG = O_AR, A_KG = O_AR + 51 * HMiB, A_VG = O_AR + 68 * HMiB, A_DQ = O_AR + 85 * HMiB, A_DK = O_AR + 136 * HMiB, A_DV = O_AR + 187 * HMiB;
constexpr size_t A_PR = O_AR + 238 * HMiB, A_EW = A_PR, A_AS = O_AR + 340 * HMiB, A_G = O_AR + 442 * HMiB;
constexpr size_t A_R = O_AR + 493 * HMiB, A_K = O_AR + 544 * HMiB, A_V = O_AR + 595 * HMiB, A_KKN = O_AR + 646 * HMiB;
constexpr size_t A_LR = O_AR + 697 * HMiB, A_T1 = O_AR + 714 * HMiB;
constexpr size_t A_YS = O_AR + 731 * HMiB, A_OD = O_AR + 935 * HMiB, A_YG = O_AR + 1139 * HMiB, A_END1 = O_AR + 1190 * HMiB;
constexpr size_t A_YR = O_AR, A_YD = O_AR + 51 * HMiB, A_GATES = A_PR;
constexpr size_t A_U = O_AR, A_ACT = O_AR + 731 * HMiB;
constexpr size_t WS_NEED = A_END1;
static_assert((size_t)TT * 768 * 2 == 51 * HMiB && (size_t)TT * 2048 * 2 == 68 * MiB && (size_t)TT * FF2 * 2 == 731 * HMiB, "sizes");
static_assert(A_ACT + (size_t)TT * FF * 2 <= A_END1 && A_GATES + (size_t)TT * 6144 * 2 <= A_KKN, "overlays");

__device__ __forceinline__ float bf2f(unsigned v) { return __uint_as_float(v << 16); }
__device__ __forceinline__ unsigned cvt_pk_bf16(float lo, float hi) { unsigned r; asm volatile("v_cvt_pk_bf16_f32 %0, %1, %2" : "=v"(r) : "v"(lo), "v"(hi)); return r; }
__device__ __forceinline__ unsigned f2bf(float f) { return cvt_pk_bf16(f, 0.f) & 0xffffu; }
__device__ __forceinline__ float wave_sum(float v) {
    v += __int_as_float(__builtin_amdgcn_update_dpp(0, __float_as_int(v), 0xB1, 0xF, 0xF, true));
    v += __int_as_float(__builtin_amdgcn_update_dpp(0, __float_as_int(v), 0x4E, 0xF, 0xF, true));
    v += __int_as_float(__builtin_amdgcn_update_dpp(0, __float_as_int(v), 0x141, 0xF, 0xF, true));
    v += __int_as_float(__builtin_amdgcn_update_dpp(0, __float_as_int(v), 0x140, 0xF, 0xF, true));
    { auto r16 = __builtin_amdgcn_permlane16_swap(__float_as_uint(v), __float_as_uint(v), false, false); v = __uint_as_float(r16[0]) + __uint_as_float(r16[1]); }
    { auto r32 = __builtin_amdgcn_permlane32_swap(__float_as_uint(v), __float_as_uint(v), false, false); v = __uint_as_float(r32[0]) + __uint_as_float(r32[1]); }
    return v;
}
__device__ __forceinline__ float sigmoidf_(float x) { return __builtin_amdgcn_rcpf(1.f + __expf(-x)); }
__device__ __forceinline__ void unpack8(u32x4 w, float* f) {
    f[0] = bf2f(w.x & 0xffffu); f[1] = __uint_as_float(w.x & 0xffff0000u); f[2] = bf2f(w.y & 0xffffu); f[3] = __uint_as_float(w.y & 0xffff0000u);
    f[4] = bf2f(w.z & 0xffffu); f[5] = __uint_as_float(w.z & 0xffff0000u); f[6] = bf2f(w.w & 0xffffu); f[7] = __uint_as_float(w.w & 0xffff0000u);
}
__device__ __forceinline__ u32x4 pack8(const float* f) { u32x4 w; w.x = cvt_pk_bf16(f[0], f[1]); w.y = cvt_pk_bf16(f[2], f[3]); w.z = cvt_pk_bf16(f[4], f[5]); w.w = cvt_pk_bf16(f[6], f[7]); return w; }

enum { EM_ROUTE = 0, EM_BF16, EM_SIGMOID, EM_LR, EM_VRES, EM_MERGE, EM_RESID };
struct Epi {
    static constexpr bool PERM = true, AFTER_DRAIN = false;
    int mode, ldc, aux, layer;
    unsigned char* ws; bf16_t* O; const float* p0; const float* p1;
    const float* xin_l; const float* xin_c; float* xout_l; float* xout_c; const float* gmod;
    __device__ __forceinline__ void operator()(const f32x4 (&acc)[2][2][4][2], const pg8::Unit& u, int wr, int wc, int fr, int fq) const {
        int fr_ = fr, fq_ = fq; asm volatile("" : "+v"(fr_), "+v"(fq_));
        size_t zoff_ = 0; asm volatile("" : "+s"(zoff_)); unsigned char* ws = this->ws + zoff_;
        const int rt = wr * 64 + fr_, ct = wc * 32 + 8 * fq_;
        if (mode == EM_ROUTE) {
            const int pn = u.pn, pm = u.pm;
            const int kvrow = pm < 64 ? ((pm >> 4) * KVS + CTX + (pm & 15) * 256) : ((pm - 64) * KVS);
            const int nat = pm * 256;
            size_t off; int ld, rowbase, colb;
            if (pn < 10) { off = A_PR; ld = 2560; rowbase = nat; colb = pn * 256; }
            else if (pn < 13) { off = A_QG; ld = 768; rowbase = nat; colb = (pn - 10) * 256; }
            else if (pn == 13) { off = A_KG; ld = 256; rowbase = kvrow; colb = 0; }
            else if (pn == 14) { off = A_VG; ld = 256; rowbase = kvrow; colb = 0; }
            else if (pn < 18) { off = A_DQ; ld = 768; rowbase = nat; colb = (pn - 15) * 256; }
            else if (pn < 21) { off = A_DK; ld = 768; rowbase = kvrow; colb = (pn - 18) * 256; }
            else { off = A_DV; ld = 768; rowbase = kvrow; colb = (pn - 21) * 256; }
            bf16_t* base = (bf16_t*)(ws + off) + (size_t)(rowbase + rt) * ld + colb + ct;
#pragma unroll
            for (int ai = 0; ai < 2; ++ai)
#pragma unroll
                for (int m = 0; m < 4; ++m) { bf16_t* rp = base + (size_t)(ai * 128 + m * 16) * ld;
#pragma unroll
                    for (int bj = 0; bj < 2; ++bj) { const f32x4 v0 = acc[ai][bj][m][0], v1 = acc[ai][bj][m][1]; u32x4 w;
                        w.x = cvt_pk_bf16(v0[0], v0[1]); w.y = cvt_pk_bf16(v0[2], v0[3]); w.z = cvt_pk_bf16(v1[0], v1[1]); w.w = cvt_pk_bf16(v1[2], v1[3]);
                        *(u32x4*)(rp + bj * 128) = w; } }
        } else if (mode == EM_BF16 || mode == EM_SIGMOID) {
            bf16_t* base = O + (size_t)(u.pm * 256 + rt) * ldc + u.pn * 256 + ct;
            const bool sg = mode == EM_SIGMOID;
#pragma unroll
            for (int ai = 0; ai < 2; ++ai)
#pragma unroll
                for (int m = 0; m < 4; ++m) { bf16_t* rp = base + (size_t)(ai * 128 + m * 16) * ldc;
#pragma unroll
                    for (int bj = 0; bj < 2; ++bj) { f32x4 v0 = acc[ai][bj][m][0], v1 = acc[ai][bj][m][1];
                        if (sg) {
#pragma unroll
                            for (int e = 0; e < 4; ++e) { v0[e] = sigmoidf_(v0[e]); v1[e] = sigmoidf_(v1[e]); } }
                        u32x4 w; w.x = cvt_pk_bf16(v0[0], v0[1]); w.y = cvt_pk_bf16(v0[2], v0[3]); w.z = cvt_pk_bf16(v1[0], v1[1]); w.w = cvt_pk_bf16(v1[2], v1[3]);
                        *(u32x4*)(rp + bj * 128) = w; } }
        } else if (mode == EM_LR) {
            const int seg = u.pn / 3, c768 = (u.pn % 3) * 256 + ct;
            const float* par = seg < 2 ? (p0 + seg * 768) : (seg < 4 ? (p1 + (seg - 2) * 768) : nullptr);
            bf16_t* base = (bf16_t*)(ws + (seg < 2 ? A_EW + (size_t)seg * TT * 768 * 2 : (seg < 4 ? A_AS + (size_t)(seg - 2) * TT * 768 * 2 : A_G))) + (size_t)(u.pm * 256 + rt) * 768 + c768;
            const float mul = seg < 2 ? 0.60653065971263342f : 1.f;
#pragma unroll
            for (int bj = 0; bj < 2; ++bj) {
                f32x4 pa = {0.f, 0.f, 0.f, 0.f}, pb = pa;
                if (par) { pa = *(const f32x4*)(par + c768 + bj * 128); pb = *(const f32x4*)(par + c768 + bj * 128 + 4); }
#pragma unroll
                for (int ai = 0; ai < 2; ++ai)
#pragma unroll
                    for (int m = 0; m < 4; ++m) { f32x4 v0 = acc[ai][bj][m][0] + pa, v1 = acc[ai][bj][m][1] + pb;
                        if (par) {
#pragma unroll
                            for (int e = 0; e < 4; ++e) { v0[e] = mul * sigmoidf_(v0[e]); v1[e] = mul * sigmoidf_(v1[e]); } }
                        u32x4 w; w.x = cvt_pk_bf16(v0[0], v0[1]); w.y = cvt_pk_bf16(v0[2], v0[3]); w.z = cvt_pk_bf16(v1[0], v1[1]); w.w = cvt_pk_bf16(v1[2], v1[3]);
                        *(u32x4*)(base + (size_t)(ai * 128 + m * 16) * 768 + bj * 128) = w; } }
        } else if (mode == EM_VRES) {
            const int c0 = u.pn * 256 + ct;
            bf16_t* V = (bf16_t*)(ws + A_V); const bf16_t* VS = (const bf16_t*)(ws + A_YS); const bf16_t* VF = (const bf16_t*)(ws + O_VF);
#pragma unroll
            for (int bj = 0; bj < 2; ++bj) {
                const f32x4 pa = *(const f32x4*)(p0 + c0 + bj * 128), pb = *(const f32x4*)(p0 + c0 + bj * 128 + 4);
#pragma unroll
                for (int ai = 0; ai < 2; ++ai)
#pragma unroll
                    for (int m = 0; m < 4; ++m) { const size_t o = (size_t)(u.pm * 256 + rt + ai * 128 + m * 16) * 768 + c0 + bj * 128;
                        float vs[8], vf[8], r[8]; unpack8(*(const u32x4*)(VS + o), vs); unpack8(*(const u32x4*)(VF + o), vf);
                        const f32x4 v0 = acc[ai][bj][m][0] + pa, v1 = acc[ai][bj][m][1] + pb;
#pragma unroll
                        for (int e = 0; e < 4; ++e) { r[e] = vs[e] + (vf[e] - vs[e]) * sigmoidf_(v0[e]); r[4 + e] = vs[4 + e] + (vf[4 + e] - vs[4 + e]) * sigmoidf_(v1[e]); }
                        *(u32x4*)(V + o) = pack8(r); } }
        } else if (mode == EM_MERGE) {
            const bf16_t* GT = (const bf16_t*)(ws + A_GATES); bf16_t* Mb = (bf16_t*)(ws + O_H);
            const int c0 = u.pn * 256 + ct;
#pragma unroll
            for (int ai = 0; ai < 2; ++ai) {
                u32x4 gv[4][2], mv[4][2];
#pragma unroll
                for (int m = 0; m < 4; ++m)
#pragma unroll
                    for (int bj = 0; bj < 2; ++bj) { const size_t row = (size_t)(u.pm * 256 + rt + ai * 128 + m * 16); const int c = c0 + bj * 128;
                        gv[m][bj] = *(const u32x4*)(GT + row * 6144 + aux * 2048 + c);
                        if (aux > 0) mv[m][bj] = *(const u32x4*)(Mb + row * 2048 + c); else mv[m][bj] = (u32x4){0u, 0u, 0u, 0u}; }
                asm volatile("" ::: "memory");
#pragma unroll
                for (int m = 0; m < 4; ++m)
#pragma unroll
                    for (int bj = 0; bj < 2; ++bj) { const size_t row = (size_t)(u.pm * 256 + rt + ai * 128 + m * 16); const int c = c0 + bj * 128;
                        float g[8], o[8], r[8]; unpack8(gv[m][bj], g); unpack8(mv[m][bj], o);
                        const f32x4 v0 = acc[ai][bj][m][0], v1 = acc[ai][bj][m][1];
#pragma unroll
                        for (int e2 = 0; e2 < 4; ++e2) { r[e2] = g[e2] * v0[e2] + o[e2]; r[4 + e2] = g[4 + e2] * v1[e2] + o[4 + e2]; }
                        *(u32x4*)(Mb + row * 2048 + c) = pack8(r); }
                asm volatile("" ::: "memory");
            }
        } else {
            const int c0 = u.pn * 256 + ct;
            const bool lat = u.pm < 64;
            const int cond = lat ? (u.pm >> 4) : 4;
            const float* gp = gmod + (size_t)cond * MODW + aux + c0;
            const float* xi = lat ? xin_l + (size_t)(u.pm * 256) * DM : xin_c + (size_t)((u.pm - 64) * 256) * DM;
            float* xo = lat ? xout_l + (size_t)(u.pm * 256) * DM : xout_c + (size_t)((u.pm - 64) * 256) * DM;
            f32x4 ga[2], gb[2];
#pragma unroll
            for (int bj = 0; bj < 2; ++bj) { ga[bj] = *(const f32x4*)(gp + bj * 128); gb[bj] = *(const f32x4*)(gp + bj * 128 + 4); }
#pragma unroll
            for (int ai = 0; ai < 2; ++ai) {
                f32x4 xa[4][2], xb[4][2];
#pragma unroll
                for (int m = 0; m < 4; ++m)
#pragma unroll
                    for (int bj = 0; bj < 2; ++bj) { const size_t o = (size_t)(rt + ai * 128 + m * 16) * DM + c0 + bj * 128; xa[m][bj] = *(const f32x4*)(xi + o); xb[m][bj] = *(const f32x4*)(xi + o + 4); }
                asm volatile("" ::: "memory");
#pragma unroll
                for (int m = 0; m < 4; ++m)
#pragma unroll
                    for (int bj = 0; bj < 2; ++bj) { const size_t o = (size_t)(rt + ai * 128 + m * 16) * DM + c0 + bj * 128;
                        *(f32x4*)(xo + o) = xa[m][bj] + ga[bj] * acc[ai][bj][m][0]; *(f32x4*)(xo + o + 4) = xb[m][bj] + gb[bj] * acc[ai][bj][m][1]; }
                asm volatile("" ::: "memory");
            }
        }
    }
};

namespace att {
using s16x4 = __attribute__((ext_vector_type(4))) short;
using f32x16 = __attribute__((ext_vector_type(16))) float;
constexpr int NW = 8, QBLK = 32, KVBLK = 64;
constexpr float THR = 8.f;
#ifndef ATT_SDEPTH
#define ATT_SDEPTH 1
#endif
constexpr int SDEPTH = ATT_SDEPTH;
constexpr size_t SHM_V = KVBLK * 128 * 2, SHM_KMAX = KVBLK * 128 * 2, SHM_ATTN = 2 * SHM_V + 2 * SHM_KMAX + NW * 64 * 4;
#define SBAR() __builtin_amdgcn_sched_barrier(0)
template <int DQK> __device__ __forceinline__ int kswz(int row, int colB) { return row * (DQK * 2) + (colB ^ ((DQK == 128 ? (row & 15) : ((row >> 1) & 7)) << 4)); }
__device__ __forceinline__ int crow(int r, int hi) { return (r & 3) + 8 * (r >> 2) + 4 * hi; }
__device__ __forceinline__ void partialSM(f32x16& p0, f32x16& p1, float& m_reg, float& mn, float& alpha, const float C, const float thr_raw) {
    float pmax = p0[0];
#pragma unroll
    for (int r = 1; r < 16; ++r) pmax = fmaxf(pmax, p0[r]);
#pragma unroll
    for (int r = 0; r < 16; ++r) pmax = fmaxf(pmax, p1[r]);
    { auto rr = __builtin_amdgcn_permlane32_swap(__float_as_uint(pmax), __float_as_uint(pmax), false, false);
      pmax = fmaxf(__uint_as_float(rr[0]), __uint_as_float(rr[1])); }
    if (__builtin_expect(__all(pmax - m_reg <= thr_raw), 1)) { mn = m_reg; alpha = 1.f; }
    else { mn = fmaxf(m_reg, pmax); alpha = __builtin_amdgcn_exp2f((m_reg - mn) * C); m_reg = mn; }
    const float mnC = -mn * C;
#pragma unroll
    for (int r = 0; r < 16; ++r) p0[r] = fmaf(p0[r], C, mnC);
#pragma unroll
    for (int r = 0; r < 16; ++r) p1[r] = fmaf(p1[r], C, mnC);
#pragma unroll
    for (int r = 0; r < 16; ++r) p0[r] = __builtin_amdgcn_exp2f(p0[r]);
}
__device__ __forceinline__ void finishSM(f32x16& p0, f32x16& p1, float alpha, float& l_reg, bf16x8& pa0, bf16x8& pa1, bf16x8& pa2, bf16x8& pa3) {
#pragma unroll
    for (int r = 0; r < 16; ++r) p1[r] = __builtin_amdgcn_exp2f(p1[r]);
    float ps = 0;
#pragma unroll
    for (int r = 0; r < 16; ++r) ps += p0[r];
#pragma unroll
    for (int r = 0; r < 16; ++r) ps += p1[r];
    { auto rr = __builtin_amdgcn_permlane32_swap(__float_as_uint(ps), __float_as_uint(ps), false, false);
      ps = __uint_as_float(rr[0]) + __uint_as_float(rr[1]); }
    l_reg = l_reg * alpha + ps;
#define PK4(P, BASE, OUT) do { unsigned a0 = cvt_pk_bf16(P[BASE + 0], P[BASE + 1]), a1 = cvt_pk_bf16(P[BASE + 2], P[BASE + 3]);   \
    unsigned b0 = cvt_pk_bf16(P[BASE + 4], P[BASE + 5]), b1 = cvt_pk_bf16(P[BASE + 6], P[BASE + 7]);                              \
    auto r0 = __builtin_amdgcn_permlane32_swap(a0, b0, false, false); auto r1 = __builtin_amdgcn_permlane32_swap(a1, b1, false, false); \
    u32x4 w = {r0[0], r1[0], r0[1], r1[1]}; OUT = *reinterpret_cast<bf16x8*>(&w); } while (0)
    PK4(p0, 0, pa0); PK4(p0, 8, pa1); PK4(p1, 0, pa2); PK4(p1, 8, pa3);
#undef PK4
}
template <int DQK> __device__ __forceinline__ void qkt(f32x16& p0, f32x16& p1, const char* Ks, const bf16x8* qr, int r32, int hi) {
    p0 = f32x16{}; p1 = f32x16{};
#pragma unroll
    for (int d0 = 0; d0 < DQK / 16; ++d0) { const int cb = (d0 * 16 + hi * 8) * 2;
        const bf16x8 b0 = *reinterpret_cast<const bf16x8*>(Ks + kswz<DQK>(r32, cb));
        const bf16x8 b1 = *reinterpret_cast<const bf16x8*>(Ks + kswz<DQK>(32 + r32, cb));
        p0 = __builtin_amdgcn_mfma_f32_32x32x16_bf16(b0, qr[d0], p0, 0, 0, 0);
        p1 = __builtin_amdgcn_mfma_f32_32x32x16_bf16(b1, qr[d0], p1, 0, 0, 0); }
}
__device__ __forceinline__ int v_st(int k, int c) { const int kk = (k & ~0xC) | ((k & 4) << 1) | ((k & 8) >> 1); return ((kk >> 3) * 4 + (c >> 5)) * 512 + ((kk & 7) * 32 + (c & 31)) * 2; }
__device__ __forceinline__ int v_rd_base(int lane) { return ((lane & 3) << 3) | (((lane >> 2) & 3) << 6) | (((lane >> 4) & 1) << 5) | (((lane >> 5) & 1) << 8); }
constexpr int v_rd_off(int d0, int ks, int half) { return d0 * 512 + ks * 4096 + half * 2048; }
template <int OFF> __device__ __forceinline__ s16x4 tr_read(int vb) {
    s16x4 r; asm volatile("ds_read_b64_tr_b16 %0, %1 offset:%2" : "=&v"(r) : "v"(vb), "i"(OFF) : "memory"); return r;
}
template <int D0> __device__ __forceinline__ void pv_one(f32x16& od, int vb, bf16x8 pa0, bf16x8 pa1, bf16x8 pa2, bf16x8 pa3) {
    const s16x4 l0 = tr_read<v_rd_off(D0, 0, 0)>(vb), h0 = tr_read<v_rd_off(D0, 0, 1)>(vb), l1 = tr_read<v_rd_off(D0, 1, 0)>(vb), h1 = tr_read<v_rd_off(D0, 1, 1)>(vb);
    const s16x4 l2 = tr_read<v_rd_off(D0, 2, 0)>(vb), h2 = tr_read<v_rd_off(D0, 2, 1)>(vb), l3 = tr_read<v_rd_off(D0, 3, 0)>(vb), h3 = tr_read<v_rd_off(D0, 3, 1)>(vb);
    asm volatile("s_waitcnt lgkmcnt(0)" ::: "memory"); SBAR();
#define PK(L, H) (bf16x8){L[0], L[1], L[2], L[3], H[0], H[1], H[2], H[3]}
    od = __builtin_amdgcn_mfma_f32_32x32x16_bf16(pa0, PK(l0, h0), od, 0, 0, 0);
    od = __builtin_amdgcn_mfma_f32_32x32x16_bf16(pa1, PK(l1, h1), od, 0, 0, 0);
    od = __builtin_amdgcn_mfma_f32_32x32x16_bf16(pa2, PK(l2, h2), od, 0, 0, 0);
    od = __builtin_amdgcn_mfma_f32_32x32x16_bf16(pa3, PK(l3, h3), od, 0, 0, 0);
#undef PK
}
__device__ __forceinline__ void pv_d0(f32x16* o, int vb, bf16x8 pa0, bf16x8 pa1, bf16x8 pa2, bf16x8 pa3) {
    pv_one<0>(o[0], vb, pa0, pa1, pa2, pa3); pv_one<1>(o[1], vb, pa0, pa1, pa2, pa3); pv_one<2>(o[2], vb, pa0, pa1, pa2, pa3); pv_one<3>(o[3], vb, pa0, pa1, pa2, pa3);
}
__device__ __forceinline__ void store_o(float* p, float v) { *p = v; }
__device__ __forceinline__ void store_o(bf16_t* p, float v) { *p = (bf16_t)f2bf(v); }

template <int DQK, int LDKV, typename TO>
__device__ __forceinline__ void attn_body(const bf16_t* __restrict__ Qb, const bf16_t* __restrict__ Kh, const bf16_t* __restrict__ Vh,
                                          TO* __restrict__ Ob, int seq, float scale, char* lds) {
    constexpr int ldq = 768, ldo = 768, ldk = LDKV, ldv = LDKV;
    constexpr size_t SHM_K = KVBLK * DQK * 2;
    const int tid = lthread(), wid = tid >> 6, lane = tid & 63, r32 = lane & 31, hi = lane >> 5;
    char* V_lds = lds; char* K_lds = lds + 2 * SHM_V;
    float* ws = (float*)(lds + 2 * SHM_V + 2 * SHM_KMAX) + wid * 64; float* li_l = ws; float* al_l = ws + 32;
    const float C = scale * 1.4426950408889634f, thr_raw = THR / scale;
    float m_reg = -1e30f, l_reg = 0; f32x16 o[4] = {}; bf16x8 qr[DQK / 16];
    const bf16_t* Qw = Qb + (long)(wid * QBLK + r32) * ldq + hi * 8;
#pragma unroll
    for (int d0 = 0; d0 < DQK / 16; ++d0) qr[d0] = *reinterpret_cast<const bf16x8*>(Qw + d0 * 16);
    const int sr = tid >> 4, sc = (tid & 15) * 8, vst0 = v_st(sr, sc), vst1 = v_st(32 + sr, sc);
    const int ksr = DQK == 128 ? sr : (tid >> 3), ksc = DQK == 128 ? sc : (tid & 7) * 8;
    const int vb0 = (int)(uintptr_t)V_lds + v_rd_base(lane);
    struct { bf16x8 vs0, vs1, ks0, ks1; } sr_[SDEPTH];
#define SLOAD(i, k0) do { sr_[i].vs0 = *reinterpret_cast<const bf16x8*>(&Vh[(long)((k0) + sr) * ldv + sc]); sr_[i].vs1 = *reinterpret_cast<const bf16x8*>(&Vh[(long)((k0) + 32 + sr) * ldv + sc]); \
    sr_[i].ks0 = *reinterpret_cast<const bf16x8*>(&Kh[(long)((k0) + ksr) * ldk + ksc]); \
    if (DQK == 128) sr_[i].ks1 = *reinterpret_cast<const bf16x8*>(&Kh[(long)((k0) + 32 + ksr) * ldk + ksc]); } while (0)
#define SWRITE(b, i) do { *(bf16x8*)(V_lds + (b) * SHM_V + vst0) = sr_[i].vs0;          \
    *(bf16x8*)(V_lds + (b) * SHM_V + vst1) = sr_[i].vs1; const int kc = ksc * 2;               \
    *(bf16x8*)(K_lds + (b) * SHM_K + kswz<DQK>(ksr, kc)) = sr_[i].ks0;                       \
    if (DQK == 128) *(bf16x8*)(K_lds + (b) * SHM_K + kswz<DQK>(32 + ksr, kc)) = sr_[i].ks1; } while (0)
#define SWAIT() do { if (SDEPTH == 1) asm volatile("s_waitcnt vmcnt(0)" ::: "memory"); else if (DQK == 128) asm volatile("s_waitcnt vmcnt(4)" ::: "memory"); else asm volatile("s_waitcnt vmcnt(3)" ::: "memory"); } while (0)
#define RESC(a) do { if (__any((a) < 1.f)) { if (hi == 0) al_l[r32] = (a); asm volatile("s_waitcnt lgkmcnt(0)" ::: "memory"); \
    _Pragma("unroll") for (int d = 0; d < 4; ++d) _Pragma("unroll") for (int r = 0; r < 16; ++r) o[d][r] *= al_l[crow(r, hi)]; } } while (0)
    f32x16 pA0, pA1, pB0, pB1; float mnA, mnB, alA, alB; bf16x8 pa0, pa1, pa2, pa3; const int NT = seq / KVBLK;
    constexpr int SE = 0, SO = SDEPTH - 1;
    SLOAD(SE, 0); asm volatile("s_waitcnt vmcnt(0)" ::: "memory"); SWRITE(0, SE); __syncthreads();
    qkt<DQK>(pA0, pA1, K_lds, qr, r32, hi); partialSM(pA0, pA1, m_reg, mnA, alA, C, thr_raw);
    SLOAD(SO, KVBLK); if (SDEPTH == 2) { if (2 < NT) SLOAD(SE, 2 * KVBLK); }
    SWAIT(); SWRITE(1, SO); __syncthreads();
    for (int j = 1; j + 1 < NT; j += 2) {
        SBAR(); qkt<DQK>(pB0, pB1, K_lds + SHM_K, qr, r32, hi);
        finishSM(pA0, pA1, alA, l_reg, pa0, pa1, pa2, pa3); SBAR();
        SLOAD(SO, (j + SDEPTH) * KVBLK); SBAR();
        pv_d0(o, vb0, pa0, pa1, pa2, pa3); partialSM(pB0, pB1, m_reg, mnB, alB, C, thr_raw);
        __syncthreads(); SWAIT(); SWRITE(0, SE);
        RESC(alB); __syncthreads();
        SBAR(); qkt<DQK>(pA0, pA1, K_lds, qr, r32, hi);
        finishSM(pB0, pB1, alB, l_reg, pa0, pa1, pa2, pa3); SBAR();
        if (SDEPTH == 1 || j + 3 < NT) SLOAD(SE, (j + 1 + SDEPTH) * KVBLK); SBAR();
        pv_d0(o, vb0 + (int)SHM_V, pa0, pa1, pa2, pa3); partialSM(pA0, pA1, m_reg, mnA, alA, C, thr_raw);
        __syncthreads(); SWAIT(); SWRITE(1, SO);
        RESC(alA); __syncthreads();
    }
    SBAR(); qkt<DQK>(pB0, pB1, K_lds + SHM_K, qr, r32, hi);
    finishSM(pA0, pA1, alA, l_reg, pa0, pa1, pa2, pa3); SBAR();
    pv_d0(o, vb0, pa0, pa1, pa2, pa3); partialSM(pB0, pB1, m_reg, mnB, alB, C, thr_raw);
    __syncthreads(); RESC(alB);
    finishSM(pB0, pB1, alB, l_reg, pa0, pa1, pa2, pa3); SBAR();
    pv_d0(o, vb0 + (int)SHM_V, pa0, pa1, pa2, pa3);
    if (hi == 0) li_l[r32] = l_reg; asm volatile("s_waitcnt lgkmcnt(0)" ::: "memory");
    float rli[16];
#pragma unroll
    for (int r = 0; r < 16; ++r) rli[r] = __builtin_amdgcn_rcpf(li_l[crow(r, hi)]);
    __syncthreads();
    bf16_t* stg = (bf16_t*)(lds + wid * 8192);
#pragma unroll
    for (int r = 0; r < 16; ++r) { const int orow = crow(r, hi);
#pragma unroll
        for (int d0 = 0; d0 < 4; ++d0) stg[orow * 128 + d0 * 32 + r32] = (bf16_t)f2bf(o[d0][r] * rli[r]); }
    asm volatile("s_waitcnt lgkmcnt(0)" ::: "memory");
    TO* Ow = Ob + (long)(wid * QBLK) * ldo;
#pragma unroll
    for (int i = 0; i < 8; ++i) { const int row = i * 4 + (lane >> 4), ch = lane & 15;
        const u32x4 v = *(const u32x4*)(stg + row * 128 + ch * 8); *(u32x4*)(Ow + (long)row * ldo + ch * 8) = v; }
#undef SLOAD
#undef SWRITE
#undef SWAIT
#undef RESC
}
#undef SBAR
}

struct Args { const float* in[N_IN]; float* out; unsigned char* ws; int ph_lo, ph_hi; };

constexpr int RING_BYTES = 131072, MISC_OFF = RING_BYTES, LDS_BYTES = 147456;

struct Frame {
    const Args* a; unsigned char* ws; char* lds; int tid, lane, wave, gw, ngw;
};

__device__ __forceinline__ void transpose_item(const float* W, int N, bf16_t* WT, int ldk, float* scr, int item, int lane) {
    const int nblk = N / 32, kb = item / nblk, nb = item % nblk, k0 = 64 * kb, n0 = 32 * nb;
    float tv[32];
#pragma unroll
    for (int i = 0; i < 32; ++i) { const int kk = 2 * i + (lane >> 5); tv[i] = W[(size_t)(k0 + kk) * N + n0 + (lane & 31)]; }
#pragma unroll
    for (int i = 0; i < 32; ++i) { const int kk = 2 * i + (lane >> 5); scr[kk * 33 + (lane & 31)] = tv[i]; }
    asm volatile("s_waitcnt lgkmcnt(0)" ::: "memory");
    const int c = lane & 7;
#pragma unroll
    for (int j = 0; j < 4; ++j) { const int n = (lane >> 3) + 8 * j; const float* s = scr + (8 * c) * 33 + n;
        u32x4 o; o.x = cvt_pk_bf16(s[0 * 33], s[1 * 33]); o.y = cvt_pk_bf16(s[2 * 33], s[3 * 33]); o.z = cvt_pk_bf16(s[4 * 33], s[5 * 33]); o.w = cvt_pk_bf16(s[6 * 33], s[7 * 33]);
        *(u32x4*)(WT + (size_t)(n0 + n) * ldk + k0 + 8 * c) = o; }
    asm volatile("s_waitcnt lgkmcnt(0)" ::: "memory");
}
__device__ __forceinline__ void convert_weights(const Frame& F, int layer) {
    float* scr = (float*)(F.lds + F.wave * 16384);
    const Args& A = *F.a;
    constexpr int I_IN = (2048 / 64) * (12288 / 32), I_BRX = (768 / 64) * (2048 / 32), I_OUT = (2048 / 64) * (2048 / 32), I_UPX = (2048 / 64) * (FF2 / 32), I_DN = (FF / 64) * (2048 / 32);
    constexpr int NITEMS = I_IN + 3 * I_BRX + I_OUT + I_UPX + I_DN;
    for (int it = F.gw; it < NITEMS; it += F.ngw) {
        int r = it;
        if (r < I_IN) { transpose_item(A.in[I_WIN] + (size_t)layer * 2048 * 12288, 12288, (bf16_t*)(F.ws + W_IN), 2048, scr, r, F.lane); continue; } r -= I_IN;
        if (r < I_BRX) { transpose_item(A.in[I_WBR] + (size_t)layer * 768 * 2048, 2048, (bf16_t*)(F.ws + W_BR), 768, scr, r, F.lane); continue; } r -= I_BRX;
        if (r < I_BRX) { transpose_item(A.in[I_WBG] + (size_t)layer * 768 * 2048, 2048, (bf16_t*)(F.ws + W_BR) + 2048 * 768, 768, scr, r, F.lane); continue; } r -= I_BRX;
        if (r < I_BRX) { transpose_item(A.in[I_WBD] + (size_t)layer * 768 * 2048, 2048, (bf16_t*)(F.ws + W_BR) + 2 * 2048 * 768, 768, scr, r, F.lane); continue; } r -= I_BRX;
        if (r < I_OUT) { transpose_item(A.in[I_WOUT] + (size_t)layer * 2048 * 2048, 2048, (bf16_t*)(F.ws + W_OUT), 2048, scr, r, F.lane); continue; } r -= I_OUT;
        if (r < I_UPX) { transpose_item(A.in[I_UP] + (size_t)layer * 2048 * FF2, FF2, (bf16_t*)(F.ws + W_UP), 2048, scr, r, F.lane); continue; } r -= I_UPX;
        transpose_item(A.in[I_DOWN] + (size_t)layer * FF * 2048, 2048, (bf16_t*)(F.ws + W_DOWN), FF, scr, r, F.lane);
    }
    const float* w2 = A.in[I_W2] + (size_t)layer * 2 * 64 * 768; const float* a2 = A.in[I_A2] + (size_t)layer * 2 * 64 * 768; const float* g2 = A.in[I_G2] + (size_t)layer * 128 * 768;
    for (int n = F.gw; n < 3840 + (layer == 1 ? 768 * 12 : 0); n += F.ngw) {
        if (n < 3840) {
            const int seg = n / 768, c = n % 768; bf16_t* dst = (bf16_t*)(F.ws + W_LR) + (size_t)n * 256;
#pragma unroll
            for (int j = 0; j < 4; ++j) { const int k = j * 64 + F.lane; float v = 0.f;
                if (seg < 2) { if (k < 64) v = w2[((size_t)seg * 64 + k) * 768 + c]; }
                else if (seg < 4) { if (k >= 64 && k < 128) v = a2[((size_t)(seg - 2) * 64 + (k - 64)) * 768 + c]; }
                else { if (k >= 128) v = g2[(size_t)(k - 128) * 768 + c]; }
                dst[k] = (bf16_t)f2bf(v); }
        } else {
            const int q_ = n - 3840, nn = q_ / 12, k = (q_ % 12) * 64 + F.lane;
            const float* v1r = A.in[I_V1] + (size_t)k * 32; const float* v2p = A.in[I_V2] + nn;
            f32x4 a[8]; float b[32];
#pragma unroll
            for (int r4 = 0; r4 < 8; ++r4) a[r4] = *(const f32x4*)(v1r + 4 * r4);
#pragma unroll
            for (int r = 0; r < 32; ++r) b[r] = v2p[(size_t)r * 768];
            float s = 0.f;
#pragma unroll
            for (int r4 = 0; r4 < 8; ++r4) s += a[r4].x * b[4 * r4] + a[r4].y * b[4 * r4 + 1] + a[r4].z * b[4 * r4 + 2] + a[r4].w * b[4 * r4 + 3];
            ((bf16_t*)(F.ws + W_V12))[(size_t)nn * 768 + k] = (bf16_t)f2bf(s);
        }
    }
}
__device__ __forceinline__ void adaln(const Frame& F) {
    const Args& A = *F.a;
    float* sc = (float*)F.lds;
    float* red = (float*)(F.lds + 40960);
    for (int i = F.tid; i < 5 * 2048; i += NTHREADS) { const int cnd = i >> 11, k = i & 2047; const float v = cnd < 4 ? A.in[I_C][cnd * 2048 + k] : A.in[I_CCTX][k]; sc[i] = v * __builtin_amdgcn_rcpf(1.f + __expf(-v)); }
    __syncthreads();
    float* MOD = (float*)(F.ws + O_MOD);
    for (int slab = blockIdx.x; slab < 256; slab += gridDim.x) {
        const int col0 = slab * 96, layer = col0 / MODW, cc = col0 % MODW;
        const float* W = A.in[I_WMOD] + (size_t)layer * 2048 * MODW + cc;
        float a0[5] = {0.f, 0.f, 0.f, 0.f, 0.f}, a1[5] = {0.f, 0.f, 0.f, 0.f, 0.f};
        const int kb = F.wave * 256;
#pragma unroll 8
        for (int k = kb; k < kb + 256; ++k) {
            const float w0 = W[(size_t)k * MODW + F.lane]; const float w1 = F.lane < 32 ? W[(size_t)k * MODW + 64 + F.lane] : 0.f;
#pragma unroll
            for (int c = 0; c < 5; ++c) { const float s = sc[c * 2048 + k]; a0[c] += s * w0; a1[c] += s * w1; }
        }
#pragma unroll
        for (int c = 0; c < 5; ++c) { red[(F.wave * 10 + c * 2) * 64 + F.lane] = a0[c]; red[(F.wave * 10 + c * 2 + 1) * 64 + F.lane] = a1[c]; }
        __syncthreads();
        if (F.tid < 480) { const int c = F.tid / 96, j = F.tid % 96; float s = A.in[I_BMOD][layer * MODW + cc + j];
#pragma unroll
            for (int w = 0; w < 8; ++w) s += red[(w * 10 + c * 2 + (j >> 6)) * 64 + (j & 63)];
            MOD[((size_t)layer * 5 + c) * MODW + cc + j] = s; }
        __syncthreads();
    }
}
__device__ __forceinline__ void norm_rows(const Frame& F, const float* xl, const float* xc, const float* gain, const float* mod  , int sh_off, int sc_off, int nrows) {
    bf16_t* H = (bf16_t*)(F.ws + O_H);
    for (int m0 = F.gw; m0 < nrows; m0 += 2 * F.ngw) {
        const int m1 = m0 + F.ngw < nrows ? m0 + F.ngw : m0;
        const float* xr0 = m0 < TL ? xl + (size_t)m0 * DM : xc + (size_t)(m0 - TL) * DM;
        const float* xr1 = m1 < TL ? xl + (size_t)m1 * DM : xc + (size_t)(m1 - TL) * DM;
        f32x4 v0[8], v1[8]; float s0 = 0.f, s1 = 0.f;
#pragma unroll
        for (int j = 0; j < 8; ++j) { v0[j] = *(const f32x4*)(xr0 + j * 256 + F.lane * 4); v1[j] = *(const f32x4*)(xr1 + j * 256 + F.lane * 4); }
#pragma unroll
        for (int j = 0; j < 8; ++j) { s0 += v0[j].x * v0[j].x + v0[j].y * v0[j].y + v0[j].z * v0[j].z + v0[j].w * v0[j].w; s1 += v1[j].x * v1[j].x + v1[j].y * v1[j].y + v1[j].z * v1[j].z + v1[j].w * v1[j].w; }
        const float rs0 = rsqrtf(wave_sum(s0) * (1.f / DM) + 1e-6f), rs1 = rsqrtf(wave_sum(s1) * (1.f / DM) + 1e-6f);
        const float* mp0 = mod + (size_t)(m0 < TL ? (m0 >> 12) : 4) * MODW; const float* mp1 = mod + (size_t)(m1 < TL ? (m1 >> 12) : 4) * MODW;
#pragma unroll
        for (int j = 0; j < 8; ++j) { const int c = j * 256 + F.lane * 4;
            const f32x4 g = *(const f32x4*)(gain + c);
            { const f32x4 sh = *(const f32x4*)(mp0 + sh_off + c), sc = *(const f32x4*)(mp0 + sc_off + c); const f32x4 y = v0[j] * rs0 * g * (sc + 1.f) + sh;
              u32x2 w; w.x = cvt_pk_bf16(y.x, y.y); w.y = cvt_pk_bf16(y.z, y.w); *(u32x2*)(H + (size_t)m0 * DM + c) = w; }
            if (m1 != m0) { const f32x4 sh = *(const f32x4*)(mp1 + sh_off + c), sc = *(const f32x4*)(mp1 + sc_off + c); const f32x4 y = v1[j] * rs1 * g * (sc + 1.f) + sh;
              u32x2 w; w.x = cvt_pk_bf16(y.x, y.y); w.y = cvt_pk_bf16(y.z, y.w); *(u32x2*)(H + (size_t)m1 * DM + c) = w; }
        }
    }
}
__device__ __forceinline__ void final_norm(const Frame& F) {
    float* X = F.a->out; const float* gain = F.a->in[I_FN];
    for (int m0 = F.gw; m0 < TL; m0 += 2 * F.ngw) {
        const int m1 = m0 + F.ngw < TL ? m0 + F.ngw : m0;
        float* xr0 = X + (size_t)m0 * DM; float* xr1 = X + (size_t)m1 * DM; f32x4 v0[8], v1[8]; float s0 = 0.f, s1 = 0.f;
#pragma unroll
        for (int j = 0; j < 8; ++j) { v0[j] = *(const f32x4*)(xr0 + j * 256 + F.lane * 4); v1[j] = *(const f32x4*)(xr1 + j * 256 + F.lane * 4); }
#pragma unroll
        for (int j = 0; j < 8; ++j) { s0 += v0[j].x * v0[j].x + v0[j].y * v0[j].y + v0[j].z * v0[j].z + v0[j].w * v0[j].w; s1 += v1[j].x * v1[j].x + v1[j].y * v1[j].y + v1[j].z * v1[j].z + v1[j].w * v1[j].w; }
        const float rs0 = rsqrtf(wave_sum(s0) * (1.f / DM) + 1e-6f), rs1 = rsqrtf(wave_sum(s1) * (1.f / DM) + 1e-6f);
#pragma unroll
        for (int j = 0; j < 8; ++j) { const int c = j * 256 + F.lane * 4; const f32x4 g = *(const f32x4*)(gain + c);
            *(f32x4*)(xr0 + c) = v0[j] * rs0 * g; if (m1 != m0) *(f32x4*)(xr1 + c) = v1[j] * rs1 * g; }
    }
}
__device__ __forceinline__ float row16_sum_p(float v) {
    v += __int_as_float(__builtin_amdgcn_update_dpp(0, __float_as_int(v), 0xB1, 0xF, 0xF, true));
    v += __int_as_float(__builtin_amdgcn_update_dpp(0, __float_as_int(v), 0x4E, 0xF, 0xF, true));
    v += __int_as_float(__builtin_amdgcn_update_dpp(0, __float_as_int(v), 0x141, 0xF, 0xF, true));
    v += __int_as_float(__builtin_amdgcn_update_dpp(0, __float_as_int(v), 0x140, 0xF, 0xF, true));
    return v;
}
__device__ __forceinline__ f32x4 unpack4p(u32x2 w) { return (f32x4){bf2f(w.x & 0xffffu), __uint_as_float(w.x & 0xffff0000u), bf2f(w.y & 0xffffu), __uint_as_float(w.y & 0xffff0000u)}; }
__device__ __forceinline__ u32x2 pack4p(f32x4 v) { u32x2 w; w.x = cvt_pk_bf16(v.x, v.y); w.y = cvt_pk_bf16(v.z, v.w); return w; }
__device__ __forceinline__ void rwkv_prep(const Frame& F, int layer) {
    const Args& A = *F.a;
    const bf16_t* PR = (const bf16_t*)(F.ws + A_PR);
    bf16_t* R = (bf16_t*)(F.ws + A_R); bf16_t* K = (bf16_t*)(F.ws + A_K); bf16_t* V = (bf16_t*)(F.ws + (layer == 0 ? O_VF : A_YS));
    bf16_t* KKo = (bf16_t*)(F.ws + A_KKN); bf16_t* LR = (bf16_t*)(F.ws + A_LR);
    const float* mu = A.in[I_MU] + layer * RCOLS; const float* kkw = A.in[I_KK] + layer * RW;
    const int l4 = F.lane * 4;
    for (int m = F.gw; m < TT; m += F.ngw) {
        const bool lat = m < TL; const int t = lat ? (m & 4095) : ((m - TL) & 255), len = lat ? SEQ : CTX;
        const bool hp = t > 0, hn = t < len - 1;
        const bf16_t* p = PR + (size_t)m * RCOLS;
        const u32x2 z2 = {0u, 0u};
        u32x2 rc[10], rp[10], rn[10]; f32x4 rm[10], rk3[3];
#pragma unroll
        for (int it = 0; it < 10; ++it) { const int c = it * 256 + l4;
            rc[it] = *(const u32x2*)(p + c); rp[it] = hp ? *(const u32x2*)(p + c - RCOLS) : z2; rn[it] = hn ? *(const u32x2*)(p + c + RCOLS) : z2; rm[it] = *(const f32x4*)(mu + c); }
#pragma unroll
        for (int j = 0; j < 3; ++j) rk3[j] = *(const f32x4*)(kkw + j * 256 + l4);
        asm volatile("" ::: "memory");
#pragma unroll
        for (int it = 0; it < 10; ++it) { const int c = it * 256 + l4;
            const f32x4 cur = unpack4p(rc[it]), pv = unpack4p(rp[it]), nx = unpack4p(rn[it]);
            const f32x4 xs = cur + rm[it] * ((pv + nx) * 0.5f - cur);
            if (it < 3) { *(u32x2*)(R + (size_t)m * RW + c) = pack4p(xs); }
            else if (it < 6) { const int ck = c - 768; *(u32x2*)(K + (size_t)m * RW + ck) = pack4p(xs);
                const f32x4 kk = xs * rk3[it - 3 < 0 ? 0 : (it - 3 > 2 ? 2 : it - 3)];
                const float ss = row16_sum_p((kk.x * kk.x + kk.y * kk.y) + (kk.z * kk.z + kk.w * kk.w));
                *(u32x2*)(KKo + (size_t)m * RW + ck) = pack4p(kk * __builtin_amdgcn_rsqf(fmaxf(ss, 1e-24f))); }
            else if (it < 9) { *(u32x2*)(V + (size_t)m * RW + c - 1536) = pack4p(xs); }
            else { f32x4 o;
                if (F.lane < 16) o = (f32x4){tanhf(xs.x), tanhf(xs.y), tanhf(xs.z), tanhf(xs.w)};
                else if (F.lane < 32) o = xs;
                else o = (f32x4){sigmoidf_(xs.x), sigmoidf_(xs.y), sigmoidf_(xs.z), sigmoidf_(xs.w)};
                *(u32x2*)(LR + (size_t)m * 256 + l4) = pack4p(o); }
        }
        asm volatile("" ::: "memory");
    }
}
__device__ __forceinline__ void qk_prep(const Frame& F, int layer) {
    const Args& A = *F.a;
    bf16_t* QG = (bf16_t*)(F.ws + A_QG); bf16_t* KG = (bf16_t*)(F.ws + A_KG); bf16_t* DQ = (bf16_t*)(F.ws + A_DQ); bf16_t* DK = (bf16_t*)(F.ws + A_DK);
    float* TGc = (float*)F.lds; float* TGs = TGc + 2048; float* TDc = TGs + 2048; float* TDs = TDc + 1024;
    __syncthreads();
    for (int i = F.tid; i < 2048; i += NTHREADS) { float s_, c_; sincosf((float)(i >> 5) * powf(10000.f, -(float)(i & 31) / 32.f), &s_, &c_); TGc[i] = c_; TGs[i] = s_; }
    for (int i = F.tid; i < 1024; i += NTHREADS) { float s_, c_; sincosf((float)(i >> 4) * powf(10000.f, -(float)(i & 15) / 16.f), &s_, &c_); TDc[i] = c_; TDs[i] = s_; }
    __syncthreads();
    const int l = F.lane, sub = l & 15, hg = l >> 4, sub8 = l & 7;
    float gq[8], gk[8];
#pragma unroll
    for (int e = 0; e < 8; ++e) { gq[e] = A.in[I_QN][layer * 128 + sub * 8 + e]; gk[e] = A.in[I_KN][layer * 128 + sub * 8 + e]; }
    for (int m = F.gw; m < TT; m += F.ngw) {
        const bool lat = m < TL; const int b = lat ? (m >> 12) : ((m - TL) >> 8), t = lat ? (m & 4095) : ((m - TL) & 255);
        const size_t kvrow = (size_t)b * KVS + (lat ? CTX + t : t);
        const int ridx = t >> 6, cidx = t & 63;
        u32x4 qraw[2], draw[3];
#pragma unroll
        for (int ps = 0; ps < 2; ++ps) { const bool isk = ps == 1 && hg >= 2;
            qraw[ps] = *(const u32x4*)(isk ? KG + kvrow * 256 + (hg - 2) * 128 + sub * 8 : QG + (size_t)m * 768 + (ps * 4 + hg) * 128 + sub * 8); }
#pragma unroll
        for (int ps = 0; ps < 3; ++ps) { const int v = ps * 8 + (l >> 3);
            draw[ps] = lat ? *(const u32x4*)(v < 12 ? DQ + (size_t)m * 768 + v * 64 + sub8 * 8 : DK + kvrow * 768 + (v - 12) * 64 + sub8 * 8) : (u32x4){0u, 0u, 0u, 0u}; }
        asm volatile("" ::: "memory");
#pragma unroll
        for (int ps = 0; ps < 2; ++ps) {
            const bool isk = ps == 1 && hg >= 2;
            bf16_t* ptr = isk ? KG + kvrow * 256 + (hg - 2) * 128 + sub * 8 : QG + (size_t)m * 768 + (ps * 4 + hg) * 128 + sub * 8;
            float x[8]; unpack8(qraw[ps], x);
            float ss = 0.f;
#pragma unroll
            for (int e = 0; e < 8; ++e) ss += x[e] * x[e];
            const float rs = rsqrtf(row16_sum_p(ss) * (1.f / 128.f) + 1e-6f);
#pragma unroll
            for (int e = 0; e < 8; ++e) x[e] *= rs * (isk ? gk[e] : gq[e]);
            if (lat) {
                const int ti = (sub < 8 ? ridx : cidx) * 32 + (sub & 3) * 8; const bool up = (sub & 4) != 0;
                const f32x4 c0 = *(const f32x4*)(TGc + ti), c1 = *(const f32x4*)(TGc + ti + 4), s0 = *(const f32x4*)(TGs + ti), s1 = *(const f32x4*)(TGs + ti + 4);
#pragma unroll
                for (int e = 0; e < 8; ++e) { const float pl_ = __int_as_float(__builtin_amdgcn_update_dpp(0, __float_as_int(x[e]), 0x104, 0xF, 0xF, true)), pr_ = __int_as_float(__builtin_amdgcn_update_dpp(0, __float_as_int(x[e]), 0x114, 0xF, 0xF, true)); const float pz = up ? pr_ : pl_; const float cc = e < 4 ? c0[e & 3] : c1[e & 3], sn = e < 4 ? s0[e & 3] : s1[e & 3];
                    x[e] = up ? pz * sn + x[e] * cc : x[e] * cc - pz * sn; }
            }
            *(u32x4*)ptr = pack8(x);
        }
        if (lat) {
#pragma unroll
            for (int ps = 0; ps < 3; ++ps) { const int v = ps * 8 + (l >> 3);
                bf16_t* ptr = v < 12 ? DQ + (size_t)m * 768 + v * 64 + sub8 * 8 : DK + kvrow * 768 + (v - 12) * 64 + sub8 * 8;
                float x[8]; unpack8(draw[ps], x);
                const int ti = (sub8 < 4 ? ridx : cidx) * 16 + (sub8 & 1) * 8; const bool up = (sub8 & 2) != 0;
                const f32x4 c0 = *(const f32x4*)(TDc + ti), c1 = *(const f32x4*)(TDc + ti + 4), s0 = *(const f32x4*)(TDs + ti), s1 = *(const f32x4*)(TDs + ti + 4);
#pragma unroll
                for (int e = 0; e < 8; ++e) { const float pz = __int_as_float(__builtin_amdgcn_update_dpp(0, __float_as_int(x[e]), 0x4E, 0xF, 0xF, true));
                    const float cc = e < 4 ? c0[e & 3] : c1[e & 3], sn = e < 4 ? s0[e & 3] : s1[e & 3];
                    x[e] = up ? pz * sn + x[e] * cc : x[e] * cc - pz * sn; }
                *(u32x4*)ptr = pack8(x);
            }
        }
    }
}
__device__ __forceinline__ float quad_sum(float v) {
    v += __int_as_float(__builtin_amdgcn_update_dpp(0, __float_as_int(v), 0xB1, 0xF, 0xF, true));
    v += __int_as_float(__builtin_amdgcn_update_dpp(0, __float_as_int(v), 0x4E, 0xF, 0xF, true));
    return v;
}
struct ScanStep { f32x4 w[2], kd[2], kk[2], b[2], r[2]; f32x2 v; };
__device__ __forceinline__ ScanStep scan_ld(const float* cb, const float* vbp, int s) {
    ScanStep d; const float* rec = cb + s * 384;
#pragma unroll
    for (int jj = 0; jj < 2; ++jj) { d.w[jj] = *(const f32x4*)(rec + jj * 4); d.kd[jj] = *(const f32x4*)(rec + 64 + jj * 4); d.kk[jj] = *(const f32x4*)(rec + 128 + jj * 4);
        d.b[jj] = *(const f32x4*)(rec + 192 + jj * 4); d.r[jj] = *(const f32x4*)(rec + 256 + jj * 4); }
    d.v = *(const f32x2*)(vbp + s * 384);
    return d;
}
__device__ __forceinline__ float oct_sum(float v) {
    v += __int_as_float(__builtin_amdgcn_update_dpp(0, __float_as_int(v), 0xB1, 0xF, 0xF, true));
    v += __int_as_float(__builtin_amdgcn_update_dpp(0, __float_as_int(v), 0x4E, 0xF, 0xF, true));
    v += __int_as_float(__builtin_amdgcn_update_dpp(0, __float_as_int(v), 0x141, 0xF, 0xF, true));
    return v;
}
__device__ __forceinline__ int scan_rowof(int g, int b, int dir) { if (g < CTX) { const int tt = dir ? (CTX - 1 - g) : g; return TL + b * CTX + tt; } const int g2 = g - CTX; const int tt = dir ? (SEQ - 1 - g2) : g2; return b * SEQ + tt; }
__device__ __forceinline__ void scan_chain(const Frame& F, int layer, int chain) {
    const Args& A = *F.a;
    const int b = chain / 24, h = (chain >> 1) % 12, dir = chain & 1;
    float* buf = (float*)F.lds;
    float* ybuf = (float*)(F.lds + 49152);
    const bf16_t* R = (const bf16_t*)(F.ws + A_R); const bf16_t* K = (const bf16_t*)(F.ws + A_K); const bf16_t* V = (const bf16_t*)(F.ws + (layer == 0 ? O_VF : A_V));
    const bf16_t* KKp = (const bf16_t*)(F.ws + A_KKN); const bf16_t* EW = (const bf16_t*)(F.ws + A_EW) + (size_t)dir * TT * RW; const bf16_t* AS = (const bf16_t*)(F.ws + A_AS) + (size_t)dir * TT * RW;
    float* YS = (float*)(F.ws + A_YS) + (size_t)dir * TT * RW;
    const bool stager = F.wave >= 4;
    const int t8 = F.tid & 255, s_st = t8 >> 4, part = t8 & 15, seg = part & 7, hrole = part >> 3;
    const int colo = h * 64 + seg * 8;
    float ka[8];
#pragma unroll
    for (int e = 0; e < 8; ++e) ka[e] = A.in[I_KA][layer * RW + colo + e];
    constexpr int NCH = (CTX + SEQ) / 16;
#define rowof(g) scan_rowof((g), b, dir)
    u32x4 z4 = {0u, 0u, 0u, 0u};
    u32x4 a0A = z4, a1A = z4, a2A = z4, a3A = z4, a0B = z4, a1B = z4, a2B = z4, a3B = z4;
#define SC_LOAD(r0, r1, r2, r3, n) do { const size_t ro_ = (size_t)rowof((n) * 16 + s_st) * RW + colo; \
        if (hrole == 0) { r0 = *(const u32x4*)(EW + ro_); r1 = *(const u32x4*)(R + ro_); r2 = *(const u32x4*)(K + ro_); r3 = *(const u32x4*)(AS + ro_); } \
        else { r0 = *(const u32x4*)(KKp + ro_); r1 = *(const u32x4*)(AS + ro_); r2 = *(const u32x4*)(V + ro_); } } while (0)
#define SC_WRITE(r0, r1, r2, r3, bi) do { float* d_ = buf + (bi) * 6144 + s_st * 384 + seg * 8; float x_[8], y_[8]; \
        if (hrole == 0) { unpack8(r0, x_); unpack8(r1, y_); float o_[8]; \
            _Pragma("unroll") for (int e = 0; e < 8; ++e) o_[e] = __expf(-x_[e]); \
            *(f32x4*)(d_) = (f32x4){o_[0], o_[1], o_[2], o_[3]}; *(f32x4*)(d_ + 4) = (f32x4){o_[4], o_[5], o_[6], o_[7]}; \
            *(f32x4*)(d_ + 256) = (f32x4){y_[0], y_[1], y_[2], y_[3]}; *(f32x4*)(d_ + 260) = (f32x4){y_[4], y_[5], y_[6], y_[7]}; \
            unpack8(r2, x_); unpack8(r3, y_); \
            _Pragma("unroll") for (int e = 0; e < 8; ++e) o_[e] = x_[e] * (1.f + (y_[e] - 1.f) * ka[e]); \
            *(f32x4*)(d_ + 64) = (f32x4){o_[0], o_[1], o_[2], o_[3]}; *(f32x4*)(d_ + 68) = (f32x4){o_[4], o_[5], o_[6], o_[7]}; } \
        else { unpack8(r0, x_); unpack8(r1, y_); \
            *(f32x4*)(d_ + 128) = (f32x4){x_[0], x_[1], x_[2], x_[3]}; *(f32x4*)(d_ + 132) = (f32x4){x_[4], x_[5], x_[6], x_[7]}; \
            *(f32x4*)(d_ + 192) = (f32x4){x_[0] * y_[0], x_[1] * y_[1], x_[2] * y_[2], x_[3] * y_[3]}; *(f32x4*)(d_ + 196) = (f32x4){x_[4] * y_[4], x_[5] * y_[5], x_[6] * y_[6], x_[7] * y_[7]}; \
            unpack8(r2, x_); \
            *(f32x4*)(d_ + 320) = (f32x4){x_[0], x_[1], x_[2], x_[3]}; *(f32x4*)(d_ + 324) = (f32x4){x_[4], x_[5], x_[6], x_[7]}; } } while (0)
    const int row_i = (F.wave & 3) * 16 + (F.lane >> 3) * 2, q = F.lane & 7;
    f32x2 S0[4], S1[4];
#pragma unroll
    for (int j = 0; j < 4; ++j) { S0[j] = (f32x2){0.f, 0.f}; S1[j] = (f32x2){0.f, 0.f}; }
    if (stager) { SC_LOAD(a0A, a1A, a2A, a3A, 0); SC_WRITE(a0A, a1A, a2A, a3A, 0); SC_LOAD(a0B, a1B, a2B, a3B, 1); SC_LOAD(a0A, a1A, a2A, a3A, 2); }
    __syncthreads();
#define SC_ITER(n, r0, r1, r2, r3) do { \
        if (!stager) { const float* cb = buf + ((n) & 1) * 6144 + q * 8; const float* vbp = buf + ((n) & 1) * 6144 + 320 + row_i; float* yb = ybuf + ((n) & 1) * 8192 + ((F.wave & 3) * 64 + F.lane) * 2; \
          ScanStep cur = scan_ld(cb, vbp, 0); \
          _Pragma("unroll") for (int hs = 0; hs < 2; ++hs) { f32x2 yreg[8]; \
          _Pragma("unroll") for (int s8 = 0; s8 < 8; ++s8) { const int s = hs * 8 + s8; \
            const ScanStep nx = scan_ld(cb, vbp, s < 15 ? s + 1 : 15); \
            f32x2 a0 = S0[0] * cur.kk[0].xy, a1 = S0[1] * cur.kk[0].zw, c0 = S1[0] * cur.kk[0].xy, c1 = S1[1] * cur.kk[0].zw; \
            a0 += S0[2] * cur.kk[1].xy; a1 += S0[3] * cur.kk[1].zw; c0 += S1[2] * cur.kk[1].xy; c1 += S1[3] * cur.kk[1].zw; \
            a0 += a1; c0 += c1; \
            const float nsa0 = -oct_sum(a0.x + a0.y), nsa1 = -oct_sum(c0.x + c0.y); \
            const float v0 = cur.v.x, v1 = cur.v.y; \
            f32x2 y0 = {0.f, 0.f}, y1 = {0.f, 0.f}, z0 = {0.f, 0.f}, z1 = {0.f, 0.f}; \
            _Pragma("unroll") for (int jj = 0; jj < 2; ++jj) { \
                S0[2 * jj] = S0[2 * jj] * cur.w[jj].xy + (cur.kd[jj].xy * v0 + cur.b[jj].xy * nsa0); \
                S0[2 * jj + 1] = S0[2 * jj + 1] * cur.w[jj].zw + (cur.kd[jj].zw * v0 + cur.b[jj].zw * nsa0); \
                S1[2 * jj] = S1[2 * jj] * cur.w[jj].xy + (cur.kd[jj].xy * v1 + cur.b[jj].xy * nsa1); \
                S1[2 * jj + 1] = S1[2 * jj + 1] * cur.w[jj].zw + (cur.kd[jj].zw * v1 + cur.b[jj].zw * nsa1); \
                y0 += S0[2 * jj] * cur.r[jj].xy; y1 += S0[2 * jj + 1] * cur.r[jj].zw; \
                z0 += S1[2 * jj] * cur.r[jj].xy; z1 += S1[2 * jj + 1] * cur.r[jj].zw; } \
            y0 += y1; z0 += z1; \
            yreg[s8] = (f32x2){y0.x + y0.y, z0.x + z0.y}; \
            cur = nx; } \
          _Pragma("unroll") for (int s8 = 0; s8 < 8; ++s8) *(f32x2*)(yb + (hs * 8 + s8) * 512) = yreg[s8]; } } \
        else { if ((n) + 1 < NCH) SC_WRITE(r0, r1, r2, r3, ((n) + 1) & 1); \
               if ((n) + 3 < NCH) SC_LOAD(r0, r1, r2, r3, (n) + 3); } \
        __syncthreads(); \
        if (stager) { const int s = t8 >> 4, i4 = (t8 & 15) * 4; const float* yb = ybuf + ((n) & 1) * 8192 + s * 512 + (i4 >> 1) * 16; \
          f32x4 o_ = {0.f, 0.f, 0.f, 0.f}; \
          _Pragma("unroll") for (int qq = 0; qq < 4; ++qq) { const f32x4 pa_ = *(const f32x4*)(yb + qq * 4), pb_ = *(const f32x4*)(yb + 16 + qq * 4); \
            o_.x += pa_.x + pa_.z; o_.y += pa_.y + pa_.w; o_.z += pb_.x + pb_.z; o_.w += pb_.y + pb_.w; } \
          *(f32x4*)(YS + (size_t)rowof((n) * 16 + s) * RW + h * 64 + i4) = o_; } } while (0)
    for (int n = 0; n < NCH; n += 2) { SC_ITER(n, a0B, a1B, a2B, a3B); SC_ITER(n + 1, a0A, a1A, a2A, a3A); }
    __syncthreads();
#undef SC_ITER
#undef SC_LOAD
#undef SC_WRITE
#undef rowof
}
__device__ __forceinline__ void ph_mix(const Frame& F, int layer, int rep) {
#ifndef PROBE_SUB
#define PROBE_SUB 0
#endif
    if (!(rep == 1 && PROBE_SUB == 2))
    for (int ch = blockIdx.x; ch < 96; ch += gridDim.x) scan_chain(F, layer, ch);
    unsigned* qbase = (unsigned*)(F.ws + O_CTL) + 64 * (16 + (layer * 2 + rep) * 8);
    volatile unsigned* misc = (volatile unsigned*)(F.lds + MISC_OFF);
    const int NK = (rep == 1 && PROBE_SUB == 1) ? 0 : (layer == 0 ? 144 + 9 : 144);
    const bf16_t* QG = (const bf16_t*)(F.ws + A_QG); const bf16_t* KG = (const bf16_t*)(F.ws + A_KG); const bf16_t* VG = (const bf16_t*)(F.ws + A_VG);
    const bf16_t* DQ = (const bf16_t*)(F.ws + A_DQ); const bf16_t* DK = (const bf16_t*)(F.ws + A_DK); const bf16_t* DV = (const bf16_t*)(F.ws + A_DV);
    bf16_t* YG = (bf16_t*)(F.ws + A_YG); bf16_t* OD = (bf16_t*)(F.ws + A_OD);
    const int x0 = (int)(xb_xcc_id() & 7u);
    int qi = 0;
    for (;;) {
        __syncthreads();
        if (F.tid == 0) { int qq = qi; unsigned uu = 0xFFFFFFFFu;
            while (qq < 8) { const int x = (x0 + qq) & 7; const unsigned k = atomicAdd(qbase + 64 * x, 1u); if ((int)k < NK) { uu = ((unsigned)x << 16) | k; break; } ++qq; }
            misc[0] = uu; misc[1] = (unsigned)qq; }
        __syncthreads();
        const unsigned uu = misc[0]; qi = (int)misc[1];
        if (uu == 0xFFFFFFFFu) break;
        const int x = (int)(uu >> 16), k = (int)(uu & 0xFFFFu);
        const bool isctx = k >= 144;
        const int g = x + 8 * (isctx ? (k - 144) : (k >> 4)), qb = k & 15;
        const bf16_t *qp, *kp, *vp; size_t orow; int kind, seq, oh;
        if (g < 24) { const int b = g / 6, hq = g % 6; orow = isctx ? (size_t)TL + b * CTX : (size_t)b * SEQ + qb * 256; kind = 0; oh = hq;
            qp = QG + orow * 768 + hq * 128; kp = KG + (size_t)b * KVS * 256 + (hq / 3) * 128; vp = VG + (size_t)b * KVS * 256 + (hq / 3) * 128; }
        else { const int d = g - 24, b = d / 12, h = (d >> 1) % 6, mp = d & 1; orow = isctx ? (size_t)TL + b * CTX : (size_t)b * SEQ + qb * 256; kind = 1 + mp; oh = h;
            qp = DQ + orow * 768 + (h * 2 + mp) * 64; kp = DK + (size_t)b * KVS * 768 + (h * 2 + mp) * 64; vp = DV + (size_t)b * KVS * 768 + h * 128; }
        seq = isctx ? CTX : KVS;
        if (kind == 0) att::attn_body<128, 256, bf16_t>(qp, kp, vp, YG + orow * 768 + oh * 128, seq, 0.088388347648318440f, F.lds);
        if (kind != 0) att::attn_body<64, 768, bf16_t>(qp, kp, vp, OD + (size_t)(kind - 1) * TT * 768 + orow * 768 + oh * 128, seq, 0.125f, F.lds);
    }
}
__device__ __forceinline__ float row16_sum(float v) {
    v += __int_as_float(__builtin_amdgcn_update_dpp(0, __float_as_int(v), 0xB1, 0xF, 0xF, true));
    v += __int_as_float(__builtin_amdgcn_update_dpp(0, __float_as_int(v), 0x4E, 0xF, 0xF, true));
    v += __int_as_float(__builtin_amdgcn_update_dpp(0, __float_as_int(v), 0x141, 0xF, 0xF, true));
    v += __int_as_float(__builtin_amdgcn_update_dpp(0, __float_as_int(v), 0x140, 0xF, 0xF, true));
    return v;
}
__device__ __forceinline__ f32x4 unpack4(u32x2 w) { return (f32x4){bf2f(w.x & 0xffffu), __uint_as_float(w.x & 0xffff0000u), bf2f(w.y & 0xffffu), __uint_as_float(w.y & 0xffff0000u)}; }
__device__ __forceinline__ u32x2 pack4(f32x4 v) { u32x2 w; w.x = cvt_pk_bf16(v.x, v.y); w.y = cvt_pk_bf16(v.z, v.w); return w; }
__device__ __forceinline__ void ph_post(const Frame& F, int layer) {
    const Args& A = *F.a; const int l = F.lane;
    const int nrows = layer == 0 ? TT : TL;
    const bf16_t* R = (const bf16_t*)(F.ws + A_R); const bf16_t* K = (const bf16_t*)(F.ws + A_K); const bf16_t* V = (const bf16_t*)(F.ws + (layer == 0 ? O_VF : A_V));
    const bf16_t* AS0 = (const bf16_t*)(F.ws + A_AS); const bf16_t* AS1 = AS0 + (size_t)TT * RW; const bf16_t* G = (const bf16_t*)(F.ws + A_G);
    const float* YS0 = (const float*)(F.ws + A_YS); const float* YS1 = YS0 + (size_t)TT * RW;
    const bf16_t* OD0 = (const bf16_t*)(F.ws + A_OD); const bf16_t* OD1 = OD0 + (size_t)TT * 768;
    bf16_t* YR = (bf16_t*)(F.ws + A_YR); bf16_t* YD = (bf16_t*)(F.ws + A_YD);
    const float* lnw = A.in[I_LNW] + layer * RW; const float* lnb = A.in[I_LNB] + layer * RW; const float* kaw = A.in[I_KA] + layer * RW; const float* rk = A.in[I_RK] + layer * RW;
    const float lam_init = 0.8f - 0.6f * expf(-0.3f * (float)layer);
    const float s1 = wave_sum(A.in[I_LQ1][layer * 64 + l] * A.in[I_LK1][layer * 64 + l]), s2 = wave_sum(A.in[I_LQ2][layer * 64 + l] * A.in[I_LK2][layer * 64 + l]);
    const float lam = expf(s1) - expf(s2) + lam_init;
    const int sub = l & 15, hg = l >> 4;
    const f32x4 sg0 = *(const f32x4*)(A.in[I_SUBLN] + layer * 128 + sub * 8) * (1.f - lam_init), sg1 = *(const f32x4*)(A.in[I_SUBLN] + layer * 128 + sub * 8 + 4) * (1.f - lam_init);
    for (int m = F.gw; m < nrows; m += F.ngw) {
        const size_t ro = (size_t)m * RW;
        f32x4 ly0[3], ly1[3], lw[3], lb[3], lka[3], lrk[3]; u32x2 la0[3], la1[3], lk[3], lr[3], lv[3], lg[3]; u32x4 ld0[2], ld1[2];
#pragma unroll
        for (int it = 0; it < 3; ++it) { const int c = (it * 4 + hg) * 64 + sub * 4;
            ly0[it] = *(const f32x4*)(YS0 + ro + c); ly1[it] = *(const f32x4*)(YS1 + ro + c);
            la0[it] = *(const u32x2*)(AS0 + ro + c); la1[it] = *(const u32x2*)(AS1 + ro + c); lk[it] = *(const u32x2*)(K + ro + c);
            lr[it] = *(const u32x2*)(R + ro + c); lv[it] = *(const u32x2*)(V + ro + c); lg[it] = *(const u32x2*)(G + ro + c);
            lw[it] = *(const f32x4*)(lnw + c); lb[it] = *(const f32x4*)(lnb + c); lka[it] = *(const f32x4*)(kaw + c); lrk[it] = *(const f32x4*)(rk + c); }
#pragma unroll
        for (int ps = 0; ps < 2; ++ps) { const int head = ps * 4 + hg; const int c = (head < 6 ? head : 0) * 128 + sub * 8;
            ld0[ps] = *(const u32x4*)(OD0 + ro + c); ld1[ps] = *(const u32x4*)(OD1 + ro + c); }
        asm volatile("" ::: "memory");
#pragma unroll
        for (int it = 0; it < 3; ++it) { const int c = (it * 4 + hg) * 64 + sub * 4;
            const f32x4 y = ly0[it] + ly1[it];
            const f32x4 a0 = unpack4(la0[it]), a1 = unpack4(la1[it]), k = unpack4(lk[it]), r = unpack4(lr[it]), v = unpack4(lv[it]), g = unpack4(lg[it]);
            const f32x4 w4 = lw[it], b4 = lb[it], ka4 = lka[it], rk4 = lrk[it];
            const float mean = row16_sum((y.x + y.y) + (y.z + y.w)) * (1.f / 64.f);
            const f32x4 d = y - mean;
            const float var = row16_sum((d.x * d.x + d.y * d.y) + (d.z * d.z + d.w * d.w)) * (1.f / 64.f);
            const f32x4 yn = d * rsqrtf(var + 64e-5f) * w4 + b4;
            const f32x4 kd = k * ((a0 + a1 - 2.f) * ka4 + 2.f);
            const f32x4 pr = r * kd * rk4;
            const float bs = row16_sum((pr.x + pr.y) + (pr.z + pr.w));
            *(u32x2*)(YR + ro + c) = pack4((yn + v * bs) * g); }
#pragma unroll
        for (int ps = 0; ps < 2; ++ps) { const int head = ps * 4 + hg;
            if (head < 6) { const int c = head * 128 + sub * 8;
                float pa_[8], pb_[8]; unpack8(ld0[ps], pa_); unpack8(ld1[ps], pb_);
                const f32x4 o0 = (f32x4){pa_[0], pa_[1], pa_[2], pa_[3]} - (f32x4){pb_[0], pb_[1], pb_[2], pb_[3]} * lam, o1 = (f32x4){pa_[4], pa_[5], pa_[6], pa_[7]} - (f32x4){pb_[4], pb_[5], pb_[6], pb_[7]} * lam;
                const float ss = row16_sum(((o0.x * o0.x + o0.y * o0.y) + (o0.z * o0.z + o0.w * o0.w)) + ((o1.x * o1.x + o1.y * o1.y) + (o1.z * o1.z + o1.w * o1.w)));
                const float rs = rsqrtf(ss * (1.f / 128.f) + 1e-5f);
                const f32x4 r0 = o0 * rs * sg0, r1 = o1 * rs * sg1;
                u32x4 w; w.x = cvt_pk_bf16(r0.x, r0.y); w.y = cvt_pk_bf16(r0.z, r0.w); w.z = cvt_pk_bf16(r1.x, r1.y); w.w = cvt_pk_bf16(r1.z, r1.w);
                *(u32x4*)(YD + ro + c) = w; } }
        asm volatile("" ::: "memory");
    }
}
__device__ __forceinline__ void conv_act(const Frame& F, int layer, int nrows) {
    const Args& A = *F.a;
    const bf16_t* U = (const bf16_t*)(F.ws + A_U); bf16_t* ACT = (bf16_t*)(F.ws + A_ACT);
    const float* cw = A.in[I_CW] + (size_t)layer * 3 * FF2; const float* cbias = A.in[I_CB] + (size_t)layer * FF2;
    constexpr int NCK = FF / 8;
    const int nitems = (nrows / 16) * NCK;
    for (int it = blockIdx.x * NTHREADS + F.tid; it < nitems; it += gridDim.x * NTHREADS) {
        const int rg = it / NCK, ck = it % NCK, r0 = rg * 16, c = ck * 8;
        const bool lat = r0 < TL; const int t0 = lat ? (r0 & 4095) : ((r0 - TL) & 255), len = lat ? SEQ : CTX;
        float wv[3][8], wg[3][8], bv[8], bg[8];
#pragma unroll
        for (int e = 0; e < 8; ++e) { bv[e] = cbias[c + e]; bg[e] = cbias[FF + c + e];
#pragma unroll
            for (int k = 0; k < 3; ++k) { wv[k][e] = cw[(size_t)k * FF2 + c + e]; wg[k][e] = cw[(size_t)k * FF2 + FF + c + e]; } }
        float pv[8], pg[8], cv[8], cg[8], nv[8], ng[8];
        const bf16_t* up = U + (size_t)r0 * FF2 + c;
        if (t0 > 0) { unpack8(*(const u32x4*)(up - FF2), pv); unpack8(*(const u32x4*)(up - FF2 + FF), pg); }
        else {
#pragma unroll
            for (int e = 0; e < 8; ++e) { pv[e] = 0.f; pg[e] = 0.f; } }
        unpack8(*(const u32x4*)(up), cv); unpack8(*(const u32x4*)(up + FF), cg);
#pragma unroll 1
        for (int i = 0; i < 16; ++i) {
            if (t0 + i + 1 < len) { unpack8(*(const u32x4*)(up + (size_t)(i + 1) * FF2), nv); unpack8(*(const u32x4*)(up + (size_t)(i + 1) * FF2 + FF), ng); }
            else {
#pragma unroll
                for (int e = 0; e < 8; ++e) { nv[e] = 0.f; ng[e] = 0.f; } }
            float o[8];
#pragma unroll
            for (int e = 0; e < 8; ++e) { const float a = pv[e] * wv[0][e] + cv[e] * wv[1][e] + nv[e] * wv[2][e] + bv[e]; const float g = pg[e] * wg[0][e] + cg[e] * wg[1][e] + ng[e] * wg[2][e] + bg[e];
                o[e] = a * g * sigmoidf_(g); pv[e] = cv[e]; pg[e] = cg[e]; cv[e] = nv[e]; cg[e] = ng[e]; }
            *(u32x4*)(ACT + (size_t)(r0 + i) * FF + c) = pack8(o);
        }
    }
}

enum { S_INIT = 0, S_NORM1, S_IN, S_PREP, S_LR, S_VRES, S_MIX, S_POST, S_GATE, S_MERGE, S_OUT, S_NORM2, S_UP, S_CONV, S_DOWN, S_NEXT, S_FINAL };
constexpr int NPH = 28;
__host__ __device__ inline int phase_code(int p) {
    if (p < 2) return p;
    if (p < 15) { const int s = p - 2; return (s < 3 ? S_IN + s : S_MIX + (s - 3)); }
    { const int s = p - 15; return 256 | (s < 3 ? S_IN + s : S_MIX + (s - 3)); }
}

#ifndef PROBE_MASK
#define PROBE_MASK 0
#endif
__host__ __device__ inline int stage_of_phase(int b) { int code = phase_code(b); int st = code & 255; if ((code >> 8) == 1 && st == S_NEXT) st = S_FINAL; return st; }
__host__ __device__ inline int expand_phase(int p, int& rep) {
    if (PROBE_MASK == 0) { rep = 0; return p; }
    int q = 0;
    for (int b = 0; b < NPH; ++b) { const int n = ((PROBE_MASK >> stage_of_phase(b)) & 1) ? 2 : 1; if (p < q + n) { rep = p - q; return b; } q += n; }
    rep = 0; return NPH - 1;
}
__global__ void __launch_bounds__(NTHREADS, 2) mega_fwd(Args args) {
    extern __shared__ __attribute__((aligned(16))) unsigned char lds_raw[];
    const Args& A = args;
    volatile LAS unsigned* MISC = (volatile LAS unsigned*)((LAS unsigned char*)lds_raw + MISC_OFF);
    if (threadIdx.x < 32) MISC[threadIdx.x] = 0u;
    __syncthreads();
    if ((threadIdx.x & 63) == 0) MISC[16 + (threadIdx.x >> 6)] = (unsigned)__builtin_amdgcn_s_getreg((1 << 11) | (4 << 6) | 4) & 3u;
    __syncthreads();
    if (threadIdx.x == 0) {
        unsigned seen = 0u, nr = 0u;
        for (int w = 0; w < 8; ++w) { const unsigned sd = MISC[16 + w]; if (!((seen >> sd) & 1u) && nr < 4u) { seen |= 1u << sd; MISC[24 + w] = nr++; } else MISC[24 + w] = 0xFFFFFFFFu; }
        for (int w = 0; w < 8; ++w) if (MISC[24 + w] == 0xFFFFFFFFu && nr < 4u) MISC[24 + w] = nr++;
    }
    __syncthreads();
    XcdBarrier bar; bar.bar = (unsigned*)(args.ws + O_CTL) + 4096; bar.x = 0; bar.st = nullptr;
    if (args.ph_hi - args.ph_lo > 1) bar = xcd_barrier_post((unsigned*)(args.ws + O_CTL) + 4096, MISC + 8);
    for (int p = args.ph_lo; p < args.ph_hi; ++p) {
        int rep = 0; int code = phase_code(expand_phase(p, rep)); const int layer = code >> 8; int st = code & 255;
        if (layer == 1 && st == S_NEXT) st = S_FINAL;
        const bool last = layer == 1;
        const int Mrows = last ? TL : TT;
        const int tid_ = lthread();
        size_t zoff_ = 0; asm volatile("" : "+s"(zoff_)); unsigned char* ws_ = args.ws + zoff_;
        Frame F; F.a = &args; F.ws = ws_; F.lds = (char*)lds_raw; F.tid = tid_; F.lane = F.tid & 63; F.wave = __builtin_amdgcn_readfirstlane(F.tid >> 6);
        F.gw = blockIdx.x * NWAVES + F.wave; F.ngw = gridDim.x * NWAVES;
        float* XC = (float*)(F.ws + O_XC);
        const float* MODB = (const float*)(F.ws + O_MOD);
        const float* mod = MODB + (size_t)layer * 5 * MODW;
        int njobs = 0;
        switch (st) {
        case S_INIT: adaln(F); convert_weights(F, 0); break;
        case S_NORM1: norm_rows(F, A.in[I_X], A.in[I_CTX], A.in[I_NORM1], mod, 0, 2048, TT); break;
        case S_PREP: rwkv_prep(F, layer); qk_prep(F, layer); break;
        case S_MIX: ph_mix(F, layer, rep); break;
        case S_POST: ph_post(F, layer); break;
        case S_NORM2: norm_rows(F, A.out, XC, A.in[I_NORM2] + layer * DM, mod, 3 * 2048, 4 * 2048, Mrows); break;
        case S_CONV: conv_act(F, layer, Mrows); break;
        case S_NEXT: convert_weights(F, 1); norm_rows(F, A.out, XC, A.in[I_NORM1] + DM, MODB + (size_t)5 * MODW, 0, 2048, TT); break;
        case S_FINAL: final_norm(F); break;
        case S_LR: njobs = layer == 1 ? 2 : 1; break;
        case S_MERGE: njobs = 3; break;
        default: njobs = 1; break;
        }
        for (int j = 0; j < njobs; ++j) {
            pg8::Gemm g; Epi e{}; e.ws = F.ws; e.layer = layer;
            switch (st) {
            case S_IN: e.mode = EM_ROUTE; g = pg8::Gemm{(const bf16_t*)(F.ws + O_H), (const bf16_t*)(F.ws + W_IN), TT, 6144, 2048}; break;
            case S_LR:
                if (j == 0) { e.mode = EM_LR; e.p0 = A.in[I_W0] + layer * 2 * RW; e.p1 = A.in[I_A0] + layer * 2 * RW; g = pg8::Gemm{(const bf16_t*)(F.ws + A_LR), (const bf16_t*)(F.ws + W_LR), TT, 3840, 256}; }
                else { e.mode = EM_VRES; e.p0 = A.in[I_V0]; g = pg8::Gemm{(const bf16_t*)(F.ws + A_YS), (const bf16_t*)(F.ws + W_V12), TT, 768, 768}; }
                break;
            case S_GATE: e.mode = EM_SIGMOID; e.O = (bf16_t*)(F.ws + A_GATES); e.ldc = 6144;
                g = pg8::Gemm{(const bf16_t*)(F.ws + O_H), (const bf16_t*)(F.ws + W_IN) + (size_t)6144 * 2048, Mrows, 6144, 2048}; break;
            case S_MERGE: e.mode = EM_MERGE; e.aux = j;
                g = pg8::Gemm{(const bf16_t*)(F.ws + (j == 0 ? A_YR : (j == 1 ? A_YG : A_YD))), (const bf16_t*)(F.ws + W_BR) + (size_t)j * 2048 * 768, Mrows, 2048, 768}; break;
            case S_OUT: e.mode = EM_RESID; e.aux = 2 * 2048; e.gmod = mod;
                e.xin_l = layer == 0 ? A.in[I_X] : A.out; e.xin_c = layer == 0 ? A.in[I_CTX] : XC; e.xout_l = A.out; e.xout_c = XC;
                g = pg8::Gemm{(const bf16_t*)(F.ws + O_H), (const bf16_t*)(F.ws + W_OUT), Mrows, 2048, 2048}; break;
            case S_UP: e.mode = EM_BF16; e.O = (bf16_t*)(F.ws + A_U); e.ldc = FF2;
                g = pg8::Gemm{(const bf16_t*)(F.ws + O_H), (const bf16_t*)(F.ws + W_UP), Mrows, FF2, 2048}; break;
            default: e.mode = EM_RESID; e.aux = 5 * 2048; e.gmod = mod; e.xin_l = A.out; e.xin_c = XC; e.xout_l = A.out; e.xout_c = XC;
                g = pg8::Gemm{(const bf16_t*)(F.ws + A_ACT), (const bf16_t*)(F.ws + W_DOWN), Mrows, 2048, FF}; break;
            }
            pg8::StaticOrder S; S.init(g.M, g.N, (int)gridDim.x, (int)blockIdx.x);
            pg8::gemm_phase<Epi, pg8::StaticOrder, true, true>((LAS unsigned char*)lds_raw, g, S, e);
            __syncthreads();
        }
        if (p + 1 < args.ph_hi) { if (args.ph_hi > 1000) { __threadfence(); cg::this_grid().sync(); }
            xcd_barrier(bar); }
    }
}

extern "C" void kernel_launch(void* const* d_in, const int* in_sizes, int n_in, void* d_out, int out_size, void* d_ws, size_t ws_size, hipStream_t stream) {
    static int grid = 0;
    if (grid == 0) {
        if (n_in != N_IN || out_size != TL * DM || ws_size < WS_NEED) { fprintf(stderr, "kernel_launch: unexpected shapes n_in %d out %d ws %zu (need %zu)\n", n_in, out_size, ws_size, (size_t)WS_NEED); grid = -1; return; }
        int dev = 0, cus = 0, per_cu = 0;
        hipGetDevice(&dev); hipDeviceGetAttribute(&cus, hipDeviceAttributeMultiprocessorCount, dev);
        if (hipFuncSetAttribute((const void*)mega_fwd, hipFuncAttributeMaxDynamicSharedMemorySize, LDS_BYTES) != hipSuccess) { fprintf(stderr, "kernel_launch: hipFuncSetAttribute failed\n"); grid = -1; return; }
        hipOccupancyMaxActiveBlocksPerMultiprocessor(&per_cu, (const void*)mega_fwd, NTHREADS, LDS_BYTES);
        (void)hipGetLastError();
        if (per_cu < 1) { fprintf(stderr, "kernel_launch: occupancy query says %d blocks/CU\n", per_cu); per_cu = 1; }
        grid = cus;
        if (grid > 256) grid = 256;
    }
    if (grid < 0) return;
    hipMemsetAsync((char*)d_ws + O_CTL, 0, CTL_BYTES, stream);
    Args a{};
    for (int i = 0; i < N_IN; ++i) a.in[i] = (const float*)d_in[i];
    a.out = (float*)d_out; a.ws = (unsigned char*)d_ws;
#if MK_ONE_LAUNCH
    { int nph = 0; for (int b = 0; b < NPH; ++b) nph += ((PROBE_MASK >> stage_of_phase(b)) & 1) ? 2 : 1; a.ph_lo = 0; a.ph_hi = nph; }
    void* kargs[] = {&a};
    hipError_t e = hipLaunchCooperativeKernel((const void*)mega_fwd, dim3(grid), dim3(NTHREADS), kargs, LDS_BYTES, stream);
    if (e != hipSuccess) fprintf(stderr, "kernel_launch: cooperative launch failed: %s\n", hipGetErrorString(e));
#else
    for (int p = 0; p < NPH; ++p) { a.ph_lo = p; a.ph_hi = p + 1; hipLaunchKernelGGL(mega_fwd, dim3(grid), dim3(NTHREADS), LDS_BYTES, stream, a); }
#endif
}
```

```cpp
#include <hip/hip_runtime.h>
#include <hip/hip_cooperative_groups.h>
#include <cstdio>
#include <cstdint>
namespace cg = cooperative_groups;
#ifndef MK_ONE_LAUNCH
#define MK_ONE_LAUNCH 1
#endif
__device__ __forceinline__ int lthread() { int t = threadIdx.x; asm volatile("" : "+v"(t)); return t; }
namespace pg8 {
#define PG8_LAS __attribute__((address_space(3)))
typedef unsigned short bf16_t;
typedef short bf16x8 __attribute__((ext_vector_type(8)));
typedef float f32x4 __attribute__((ext_vector_type(4)));
typedef unsigned u32x4 __attribute__((ext_vector_type(4)));
constexpr int BM = 256, BK = 64, HALF = 128, HTB = HALF * BK * 2  , STAGE_BYTES = 8 * HTB, NXCD = 8, WGM = 8;

__host__ __device__ __forceinline__ int lds_byte(int r, int c) { const int st = (r >> 4) * 2 + (c >> 5), rr = r & 15, cc = c & 31, ob = rr * 64 + cc * 2; return st * 1024 + (ob ^ (((ob >> 9) & 1) << 5)); }
__host__ __device__ __forceinline__ void stage_rc(int b, int& R, int& C) { const int st = b / 1024, sb = b % 1024, swz = sb ^ (((sb >> 9) & 1) << 5); R = (st >> 1) * 16 + swz / 64; C = (st & 1) * 32 + (swz % 64) / 2; }
__host__ __device__ __forceinline__ int perm32(int rho) { const int n = rho >> 4, i = rho & 15; return 8 * (i >> 2) + 4 * n + (i & 3); }

struct Unit { int pm, pn; };
struct Gemm { const bf16_t* A; const bf16_t* Bt; int M, N, K; };

struct StaticOrder {
    int nM, nN, nwg, G, c;
    __host__ __device__ void init(int M, int N, int G_, int c_) { nM = M / BM; nN = N / BM; nwg = nM * nN; G = G_; c = c_; }
    __host__ __device__ bool next(int i, Unit& u) const {
        const long L = (long)i * G + c; if (L >= nwg) return false;
        int wgid = (int)L; { const int q = nwg / NXCD, r = nwg % NXCD, xcd = wgid % NXCD, off = wgid / NXCD; wgid = (xcd < r ? xcd * (q + 1) : r * (q + 1) + (xcd - r) * q) + off; }
        const int nig = WGM * nN, gid = wgid / nig, fm = gid * WGM, gsz = (nM - fm) < WGM ? (nM - fm) : WGM;
        u.pm = fm + ((wgid % nig) % gsz); u.pn = (wgid % nig) / gsz; return true;
    }
    __device__ __forceinline__ void a_ready(const Unit&) const {}
    __device__ __forceinline__ void done(const Unit&) const {}
};

template <class Epi, class Sched, bool ALIGN_EPI = false, bool SP2 = false>
__device__ __forceinline__ void gemm_phase(PG8_LAS unsigned char* lds, const Gemm g, const Sched& S, const Epi& E) {
    const int tid = lthread(), wid = __builtin_amdgcn_readfirstlane(tid >> 6), lane = tid & 63, wr = wid >> 2, wc = wid & 3, fr = lane & 15, fq = lane >> 4;
    const int K = g.K, nt = K / BK;
    unsigned voffA[2], voffB[2];
#pragma unroll
    for (int i = 0; i < 2; ++i) { int R, C; stage_rc(tid * 16 + i * 8192, R, C); const int Rb = Epi::PERM ? ((R & ~31) + perm32(R & 31)) : R;
        voffA[i] = (unsigned)(R * K + C) * 2u; voffB[i] = (unsigned)(Rb * K + C) * 2u; }
    const size_t kstep = (size_t)(BK * 2);
    const size_t hstep = (size_t)HALF * K * 2;
    const size_t tstep = 2 * hstep;
    const unsigned ldsw = (unsigned)wid * 1024u;
    const int aoff = lds_byte(wr * 64 + fr, fq * 8), boff = lds_byte(wc * 32 + fr, fq * 8);
#define PG8_SA(b, h) (((b) * 2 + (h)) * HTB)
#define PG8_SB(b, h) ((4 + (b) * 2 + (h)) * HTB)
#define PG8_STAGE(bufoff, gbase, voff) do { _Pragma("unroll") for (int _i = 0; _i < 2; ++_i) \
        __builtin_amdgcn_global_load_lds((const unsigned*)((const char*)(gbase) + (voff)[_i]), (PG8_LAS unsigned*)(lds + (bufoff) + ldsw + _i * 8192), 16, 0, 0); } while (0)
#define PG8_LDA(dst, b, h) do { _Pragma("unroll") for (int m = 0; m < 4; ++m) _Pragma("unroll") for (int k = 0; k < 2; ++k) dst[m][k] = *(const PG8_LAS bf16x8*)(lds + PG8_SA(b, h) + aoff + m * 2048 + k * 1024); } while (0)
#define PG8_LDB(dst, b, h) do { _Pragma("unroll") for (int n = 0; n < 2; ++n) _Pragma("unroll") for (int k = 0; k < 2; ++k) dst[n][k] = *(const PG8_LAS bf16x8*)(lds + PG8_SB(b, h) + boff + n * 2048 + k * 1024); } while (0)
#define PG8_MMA(ai, bj, At, Bt) do { __builtin_amdgcn_s_setprio(1); _Pragma("unroll") for (int m = 0; m < 4; ++m) _Pragma("unroll") for (int n = 0; n < 2; ++n) _Pragma("unroll") for (int k = 0; k < 2; ++k) \
        acc[ai][bj][m][n] = __builtin_amdgcn_mfma_f32_16x16x32_bf16(Bt[n][k], At[m][k], acc[ai][bj][m][n], 0, 0, 0); __builtin_amdgcn_s_setprio(0); } while (0)
#define PG8_WAIT_V(n) asm volatile("s_waitcnt vmcnt(" #n ")" ::: "memory")
#define PG8_WAIT_L(n) asm volatile("s_waitcnt lgkmcnt(" #n ")" ::: "memory")
#define PG8_BAR __builtin_amdgcn_s_barrier()
#define PG8_SCHED __builtin_amdgcn_sched_barrier(0)
    Unit cur, nxt; int ui = 0;
    if (!S.next(0, cur)) return;
    f32x4 acc[2][2][4][2];
#pragma unroll
    for (int a = 0; a < 2; ++a)
#pragma unroll
        for (int b = 0; b < 2; ++b)
#pragma unroll
            for (int m = 0; m < 4; ++m)
#pragma unroll
                for (int n = 0; n < 2; ++n) acc[a][b][m][n] = (f32x4){0.f, 0.f, 0.f, 0.f};
    bf16x8 At[4][2], B0[2][2], B1[2][2];
    const char* cA = (const char*)g.A + (size_t)cur.pm * tstep; const char* cB = (const char*)g.Bt + (size_t)cur.pn * tstep;
    S.a_ready(cur);
    if constexpr (SP2) {
        PG8_STAGE(PG8_SB(0, 0), cB, voffB); PG8_STAGE(PG8_SB(0, 1), cB + hstep, voffB); PG8_STAGE(PG8_SA(0, 0), cA, voffA); PG8_STAGE(PG8_SA(0, 1), cA + hstep, voffA);
        if (wr == 1) PG8_BAR;
        PG8_WAIT_V(2); PG8_BAR;
        PG8_STAGE(PG8_SB(1, 0), cB + kstep, voffB); PG8_STAGE(PG8_SA(1, 0), cA + kstep, voffA); PG8_STAGE(PG8_SB(1, 1), cB + hstep + kstep, voffB);
        PG8_WAIT_V(6); PG8_BAR;
    } else {
        PG8_STAGE(PG8_SB(0, 0), cB, voffB); PG8_STAGE(PG8_SA(0, 0), cA, voffA); PG8_STAGE(PG8_SB(0, 1), cB + hstep, voffB); PG8_STAGE(PG8_SA(0, 1), cA + hstep, voffA);
        if (wr == 1) PG8_BAR;
        PG8_WAIT_V(4); PG8_BAR;
        PG8_STAGE(PG8_SB(1, 0), cB + kstep, voffB); PG8_STAGE(PG8_SA(1, 0), cA + kstep, voffA); PG8_STAGE(PG8_SB(1, 1), cB + hstep + kstep, voffB);
        PG8_WAIT_V(6); PG8_BAR;
    }
    for (;;) {
        const bool has_next = S.next(ui + 1, nxt);
        const char* nA = has_next ? (const char*)g.A + (size_t)nxt.pm * tstep : cA; const char* nB = has_next ? (const char*)g.Bt + (size_t)nxt.pn * tstep : cB;
        for (int t = 0; t < nt; t += 2) {
            const bool last = (t == nt - 2);
            const char* a1 = cA + (size_t)(t + 1) * kstep;
            const char* a2 = last ? nA : cA + (size_t)(t + 2) * kstep; const char* b2 = last ? nB : cB + (size_t)(t + 2) * kstep;
            const char* a3 = a2 + kstep; const char* b3 = b2 + kstep;
            if (last && has_next) S.a_ready(nxt);
            if constexpr (SP2) {
            PG8_LDB(B0, 0, 0); PG8_LDB(B1, 0, 1); PG8_SCHED; PG8_LDA(At, 0, 0); PG8_STAGE(PG8_SA(1, 1), a1 + hstep, voffA);
            PG8_WAIT_V(8); PG8_WAIT_L(0); PG8_BAR; PG8_MMA(0, 0, At, B0); PG8_MMA(0, 1, At, B1); PG8_BAR; PG8_SCHED;
            PG8_LDA(At, 0, 1); PG8_STAGE(PG8_SB(0, 0), b2, voffB); PG8_STAGE(PG8_SB(0, 1), b2 + hstep, voffB); PG8_STAGE(PG8_SA(0, 0), a2, voffA);
            PG8_WAIT_V(8); PG8_WAIT_L(0); PG8_BAR; PG8_MMA(1, 0, At, B0); PG8_MMA(1, 1, At, B1); PG8_BAR; PG8_SCHED;
            PG8_LDB(B0, 1, 0); PG8_LDB(B1, 1, 1); PG8_SCHED; PG8_LDA(At, 1, 0); PG8_STAGE(PG8_SA(0, 1), a2 + hstep, voffA);
            PG8_WAIT_V(8); PG8_WAIT_L(0); PG8_BAR; PG8_MMA(0, 0, At, B0); PG8_MMA(0, 1, At, B1); PG8_BAR; PG8_SCHED;
            PG8_LDA(At, 1, 1); PG8_STAGE(PG8_SB(1, 0), b3, voffB); PG8_STAGE(PG8_SB(1, 1), b3 + hstep, voffB); PG8_STAGE(PG8_SA(1, 0), a3, voffA);
            PG8_WAIT_V(8); PG8_WAIT_L(0); PG8_BAR; PG8_MMA(1, 0, At, B0); PG8_MMA(1, 1, At, B1); PG8_BAR; PG8_SCHED;
            } else {
            PG8_LDB(B0, 0, 0); PG8_SCHED; PG8_LDA(At, 0, 0); PG8_STAGE(PG8_SA(1, 1), a1 + hstep, voffA);
            PG8_WAIT_L(8); PG8_BAR; PG8_WAIT_L(0); PG8_MMA(0, 0, At, B0); PG8_BAR; PG8_SCHED;
            PG8_LDB(B1, 0, 1); PG8_STAGE(PG8_SB(0, 0), b2, voffB);
            PG8_BAR; PG8_WAIT_L(0); PG8_MMA(0, 1, At, B1); PG8_BAR;
            PG8_LDA(At, 0, 1); PG8_STAGE(PG8_SA(0, 0), a2, voffA);
            PG8_BAR; PG8_WAIT_L(0); PG8_MMA(1, 0, At, B0); PG8_BAR; PG8_SCHED;
            PG8_STAGE(PG8_SB(0, 1), b2 + hstep, voffB);
            PG8_WAIT_V(6); PG8_BAR; PG8_MMA(1, 1, At, B1); PG8_BAR;
            PG8_LDB(B0, 1, 0); PG8_SCHED; PG8_LDA(At, 1, 0); PG8_STAGE(PG8_SA(0, 1), a2 + hstep, voffA);
            PG8_WAIT_L(8); PG8_BAR; PG8_WAIT_L(0); PG8_MMA(0, 0, At, B0); PG8_BAR; PG8_SCHED;
            PG8_LDB(B1, 1, 1); PG8_STAGE(PG8_SB(1, 0), b3, voffB);
            PG8_BAR; PG8_WAIT_L(0); PG8_MMA(0, 1, At, B1); PG8_BAR;
            PG8_LDA(At, 1, 1); PG8_STAGE(PG8_SA(1, 0), a3, voffA);
            PG8_BAR; PG8_WAIT_L(0); PG8_MMA(1, 0, At, B0); PG8_BAR; PG8_SCHED;
            PG8_STAGE(PG8_SB(1, 1), b3 + hstep, voffB);
            PG8_WAIT_V(6); PG8_BAR; PG8_MMA(1, 1, At, B1); PG8_BAR;
            }
        }
        if constexpr (ALIGN_EPI) { if (wr == 0) PG8_BAR; }
        if constexpr (!Epi::AFTER_DRAIN) { E(acc, cur, wr, wc, fr, fq); S.done(cur); }
        if (!has_next) break;
#pragma unroll
        for (int a = 0; a < 2; ++a)
#pragma unroll
            for (int b = 0; b < 2; ++b)
#pragma unroll
                for (int m = 0; m < 4; ++m)
#pragma unroll
                    for (int n = 0; n < 2; ++n) acc[a][b][m][n] = (f32x4){0.f, 0.f, 0.f, 0.f};
        cur = nxt; cA = nA; cB = nB; ++ui;
        if constexpr (ALIGN_EPI) { if (wr == 1) PG8_BAR; }
    }
    PG8_WAIT_V(0);
    if constexpr (!ALIGN_EPI) { if (wr == 0) PG8_BAR; }
    PG8_BAR;
    if constexpr (Epi::AFTER_DRAIN) { E.fused(acc, cur, wr, wc, fr, fq, lds, wid, lane); S.done(cur); }
#undef PG8_SA
#undef PG8_SB
#undef PG8_STAGE
#undef PG8_LDA
#undef PG8_LDB
#undef PG8_MMA
#undef PG8_WAIT_V
#undef PG8_WAIT_L
#undef PG8_BAR
#undef PG8_SCHED
}
}

#define LAS __attribute__((address_space(3)))
typedef unsigned short bf16_t;
typedef float f32x4 __attribute__((ext_vector_type(4)));
typedef float f32x2 __attribute__((ext_vector_type(2)));
typedef unsigned u32x4 __attribute__((ext_vector_type(4)));
typedef unsigned u32x2 __attribute__((ext_vector_type(2)));
typedef short bf16x8 __attribute__((ext_vector_type(8)));

constexpr int DM = 2048, NB = 4, SEQ = 4096, CTX = 256, TL = NB * SEQ, TC = NB * CTX, TT = TL + TC, KVS = CTX + SEQ;
constexpr int RW = 768, RCOLS = 2560, FF = 5504, FF2 = 11008, MODW = 12288;
constexpr int NTHREADS = 512, NWAVES = 8;

enum { I_X = 0, I_C, I_CTX, I_CCTX, I_WMOD, I_BMOD, I_NORM1, I_WIN, I_MU, I_W0, I_W2, I_A0, I_A2, I_KK, I_KA, I_RK, I_G2, I_LNW, I_LNB,
       I_V0, I_V1, I_V2, I_QN, I_KN, I_LQ1, I_LK1, I_LQ2, I_LK2, I_SUBLN, I_WBR, I_WBG, I_WBD, I_WOUT, I_NORM2, I_UP, I_CW, I_CB, I_DOWN, I_FN, N_IN };

#define XB_TMO      128
#define XB_XCNT(j)  (256  + 64 * (j))
#define XB_XSUB(j)  (1280 + 64 * (j))
#define XB_XGEN(j)  (2304 + 64 * (j))
#define XB_TOP      3328
#define XB_TOPGEN   3392
#define XCD_BAR_WORDS 3456
#define XB_SPIN_CAP (1u << 18)

__device__ __forceinline__ unsigned xb_ld(unsigned* p)              { return __hip_atomic_load(p, __ATOMIC_RELAXED, __HIP_MEMORY_SCOPE_AGENT); }
__device__ __forceinline__ unsigned xb_add(unsigned* p, unsigned v) { return __hip_atomic_fetch_add(p, v, __ATOMIC_RELAXED, __HIP_MEMORY_SCOPE_AGENT); }
__device__ __forceinline__ unsigned xb_xcc_id() { return (unsigned)__builtin_amdgcn_s_getreg((3 << 11) | 20) & 0xFu; }
#define XB_SPIN(cond, bar) do { unsigned _sp = 0; while (cond) { __builtin_amdgcn_s_sleep(1); \
    if ((++_sp & 255u) == 0u) { if (xb_ld(&(bar)[XB_TMO])) break; if (_sp > XB_SPIN_CAP) { atomicAdd(&(bar)[XB_TMO], 1u); break; } } } } while (0)

struct XcdBarrier {
    unsigned* bar; unsigned x;
    volatile LAS unsigned* st;
};

__device__ __forceinline__ XcdBarrier xcd_barrier_post(unsigned* bar, volatile LAS unsigned* st) {
    XcdBarrier b; b.bar = bar; b.x = xb_xcc_id(); b.st = st;
    if (threadIdx.x == 0) (void)xb_add(&bar[XB_XCNT(b.x)], 1u);
    return b;
}
__device__ __forceinline__ void xcd_barrier_complete(unsigned* bar, unsigned x, unsigned& nloc, unsigned& nx) {
    const unsigned G = gridDim.x * gridDim.y * gridDim.z;
    unsigned sum, cnt, mine, sp = 0u;
    for (;;) {
        sum = 0u; cnt = 0u; mine = 0u;
#pragma unroll
        for (unsigned j = 0; j < 16; ++j) { const unsigned c = xb_ld(&bar[XB_XCNT(j)]); sum += c; cnt += (c > 0u) ? 1u : 0u; mine = (j == x) ? c : mine; }
        if (sum == G) break;
        __builtin_amdgcn_s_sleep(1);
        if ((++sp & 255u) == 0u) { if (xb_ld(&bar[XB_TMO])) break; if (sp > XB_SPIN_CAP) { atomicAdd(&bar[XB_TMO], 1u); break; } }
    }
    nloc = mine > 0u ? mine : 1u; nx = cnt > 0u ? cnt : 1u;
}

__device__ __forceinline__ void xcd_barrier(const XcdBarrier& b) {
    asm volatile("s_waitcnt vmcnt(0)" ::: "memory");
    __syncthreads();
    if (threadIdx.x == 0) {
        unsigned* bar = b.bar;
        __builtin_amdgcn_s_waitcnt(0);
        unsigned nloc = b.st[0], nx = b.st[1];
        if (nloc == 0u) { xcd_barrier_complete(bar, b.x, nloc, nx); b.st[0] = nloc; b.st[1] = nx; }
        const unsigned old = xb_add(&bar[XB_XSUB(b.x)], 1u);
        const unsigned gen = old / nloc;
        if (old + 1u == (gen + 1u) * nloc) {
            __builtin_amdgcn_fence(__ATOMIC_RELEASE, "agent");
            asm volatile("s_waitcnt vmcnt(0)" ::: "memory");
            const unsigned og = xb_add(&bar[XB_TOP], 1u);
            const unsigned tg = og / nx;
            if (og + 1u == (tg + 1u) * nx) xb_add(&bar[XB_TOPGEN], 1u);
            else XB_SPIN(xb_ld(&bar[XB_TOPGEN]) == tg, bar);
            __builtin_amdgcn_fence(__ATOMIC_ACQUIRE, "agent");
            xb_add(&bar[XB_XGEN(b.x)], 1u);
            asm volatile("s_waitcnt vmcnt(0)" ::: "memory");
        } else {
            XB_SPIN(xb_ld(&bar[XB_XGEN(b.x)]) == gen, bar);
            __builtin_amdgcn_fence(__ATOMIC_ACQUIRE, "agent");
            asm volatile("s_waitcnt vmcnt(0)" ::: "memory");
        }
    }
    __syncthreads();
}

constexpr size_t MiB = 1u << 20, HMiB = 1u << 19;
constexpr size_t O_CTL = 0, CTL_BYTES = 65536, O_MOD = 1 * MiB, O_XC = 2 * MiB;
constexpr size_t W_IN = 10 * MiB, W_BR = W_IN + 48 * MiB, W_OUT = W_BR + 9 * MiB, W_UP = W_OUT + 8 * MiB, W_DOWN = W_UP + 43 * MiB,
                 W_LR = W_DOWN + 22 * MiB, W_V12 = W_LR + (size_t)3840 * 256 * 2;
constexpr size_t O_H = 143 * MiB, O_VF = 211 * MiB, O_AR = 237 * MiB;
static_assert(W_V12 + (size_t)768 * 768 * 2 == O_H, "weight map");
constexpr size_t A_QG = O_AR, A_KG = O_AR + 51 * HMiB, A_VG = O_AR + 68 * HMiB, A_DQ = O_AR + 85 * HMiB, A_DK = O_AR + 136 * HMiB, A_DV = O_AR + 187 * HMiB;
constexpr size_t A_PR = O_AR + 238 * HMiB, A_EW = A_PR, A_AS = O_AR + 340 * HMiB, A_G = O_AR + 442 * HMiB;
constexpr size_t A_R = O_AR + 493 * HMiB, A_K = O_AR + 544 * HMiB, A_V = O_AR + 595 * HMiB, A_KKN = O_AR + 646 * HMiB;
constexpr size_t A_LR = O_AR + 697 * HMiB, A_T1 = O_AR + 714 * HMiB;
constexpr size_t A_YS = O_AR + 731 * HMiB, A_OD = O_AR + 935 * HMiB, A_YG = O_AR + 1139 * HMiB, A_END1 = O_AR + 1190 * HMiB;
constexpr size_t A_YR = O_AR, A_YD = O_AR + 51 * HMiB, A_GATES = A_PR;
constexpr size_t A_U = O_AR, A_ACT = O_AR + 731 * HMiB;
constexpr size_t WS_NEED = A_END1;
static_assert((size_t)TT * 768 * 2 == 51 * HMiB && (size_t)TT * 2048 * 2 == 68 * MiB && (size_t)TT * FF2 * 2 == 731 * HMiB, "sizes");
static_assert(A_ACT + (size_t)TT * FF * 2 <= A_END1 && A_GATES + (size_t)TT * 6144 * 2 <= A_KKN, "overlays");

__device__ __forceinline__ float bf2f(unsigned v) { return __uint_as_float(v << 16); }
__device__ __forceinline__ unsigned cvt_pk_bf16(float lo, float hi) { unsigned r; asm volatile("v_cvt_pk_bf16_f32 %0, %1, %2" : "=v"(r) : "v"(lo), "v"(hi)); return r; }
__device__ __forceinline__ unsigned f2bf(float f) { return cvt_pk_bf16(f, 0.f) & 0xffffu; }
__device__ __forceinline__ float wave_sum(float v) {
    v += __int_as_float(__builtin_amdgcn_update_dpp(0, __float_as_int(v), 0xB1, 0xF, 0xF, true));
    v += __int_as_float(__builtin_amdgcn_update_dpp(0, __float_as_int(v), 0x4E, 0xF, 0xF, true));
    v += __int_as_float(__builtin_amdgcn_update_dpp(0, __float_as_int(v), 0x141, 0xF, 0xF, true));
    v += __int_as_float(__builtin_amdgcn_update_dpp(0, __float_as_int(v), 0x140, 0xF, 0xF, true));
    { auto r16 = __builtin_amdgcn_permlane16_swap(__float_as_uint(v), __float_as_uint(v), false, false); v = __uint_as_float(r16[0]) + __uint_as_float(r16[1]); }
    { auto r32 = __builtin_amdgcn_permlane32_swap(__float_as_uint(v), __float_as_uint(v), false, false); v = __uint_as_float(r32[0]) + __uint_as_float(r32[1]); }
    return v;
}
__device__ __forceinline__ float sigmoidf_(float x) { return __builtin_amdgcn_rcpf(1.f + __expf(-x)); }
__device__ __forceinline__ void unpack8(u32x4 w, float* f) {
    f[0] = bf2f(w.x & 0xffffu); f[1] = __uint_as_float(w.x & 0xffff0000u); f[2] = bf2f(w.y & 0xffffu); f[3] = __uint_as_float(w.y & 0xffff0000u);
    f[4] = bf2f(w.z & 0xffffu); f[5] = __uint_as_float(w.z & 0xffff0000u); f[6] = bf2f(w.w & 0xffffu); f[7] = __uint_as_float(w.w & 0xffff0000u);
}
__device__ __forceinline__ u32x4 pack8(const float* f) { u32x4 w; w.x = cvt_pk_bf16(f[0], f[1]); w.y = cvt_pk_bf16(f[2], f[3]); w.z = cvt_pk_bf16(f[4], f[5]); w.w = cvt_pk_bf16(f[6], f[7]); return w; }

enum { EM_ROUTE = 0, EM_BF16, EM_SIGMOID, EM_LR, EM_VRES, EM_MERGE, EM_RESID };
struct Epi {
    static constexpr bool PERM = true, AFTER_DRAIN = false;
    int mode, ldc, aux, layer;
    unsigned char* ws; bf16_t* O; const float* p0; const float* p1;
    const float* xin_l; const float* xin_c; float* xout_l; float* xout_c; const float* gmod;
    __device__ __forceinline__ void operator()(const f32x4 (&acc)[2][2][4][2], const pg8::Unit& u, int wr, int wc, int fr, int fq) const {
        int fr_ = fr, fq_ = fq; asm volatile("" : "+v"(fr_), "+v"(fq_));
        size_t zoff_ = 0; asm volatile("" : "+s"(zoff_)); unsigned char* ws = this->ws + zoff_;
        const int rt = wr * 64 + fr_, ct = wc * 32 + 8 * fq_;
        if (mode == EM_ROUTE) {
            const int pn = u.pn, pm = u.pm;
            const int kvrow = pm < 64 ? ((pm >> 4) * KVS + CTX + (pm & 15) * 256) : ((pm - 64) * KVS);
            const int nat = pm * 256;
            size_t off; int ld, rowbase, colb;
            if (pn < 10) { off = A_PR; ld = 2560; rowbase = nat; colb = pn * 256; }
            else if (pn < 13) { off = A_QG; ld = 768; rowbase = nat; colb = (pn - 10) * 256; }
            else if (pn == 13) { off = A_KG; ld = 256; rowbase = kvrow; colb = 0; }
            else if (pn == 14) { off = A_VG; ld = 256; rowbase = kvrow; colb = 0; }
            else if (pn < 18) { off = A_DQ; ld = 768; rowbase = nat; colb = (pn - 15) * 256; }
            else if (pn < 21) { off = A_DK; ld = 768; rowbase = kvrow; colb = (pn - 18) * 256; }
            else { off = A_DV; ld = 768; rowbase = kvrow; colb = (pn - 21) * 256; }
            bf16_t* base = (bf16_t*)(ws + off) + (size_t)(rowbase + rt) * ld + colb + ct;
#pragma unroll
            for (int ai = 0; ai < 2; ++ai)
#pragma unroll
                for (int m = 0; m < 4; ++m) { bf16_t* rp = base + (size_t)(ai * 128 + m * 16) * ld;
#pragma unroll
                    for (int bj = 0; bj < 2; ++bj) { const f32x4 v0 = acc[ai][bj][m][0], v1 = acc[ai][bj][m][1]; u32x4 w;
                        w.x = cvt_pk_bf16(v0[0], v0[1]); w.y = cvt_pk_bf16(v0[2], v0[3]); w.z = cvt_pk_bf16(v1[0], v1[1]); w.w = cvt_pk_bf16(v1[2], v1[3]);
                        *(u32x4*)(rp + bj * 128) = w; } }
        } else if (mode == EM_BF16 || mode == EM_SIGMOID) {
            bf16_t* base = O + (size_t)(u.pm * 256 + rt) * ldc + u.pn * 256 + ct;
            const bool sg = mode == EM_SIGMOID;
#pragma unroll
            for (int ai = 0; ai < 2; ++ai)
#pragma unroll
                for (int m = 0; m < 4; ++m) { bf16_t* rp = base + (size_t)(ai * 128 + m * 16) * ldc;
#pragma unroll
                    for (int bj = 0; bj < 2; ++bj) { f32x4 v0 = acc[ai][bj][m][0], v1 = acc[ai][bj][m][1];
                        if (sg) {
#pragma unroll
                            for (int e = 0; e < 4; ++e) { v0[e] = sigmoidf_(v0[e]); v1[e] = sigmoidf_(v1[e]); } }
                        u32x4 w; w.x = cvt_pk_bf16(v0[0], v0[1]); w.y = cvt_pk_bf16(v0[2], v0[3]); w.z = cvt_pk_bf16(v1[0], v1[1]); w.w = cvt_pk_bf16(v1[2], v1[3]);
                        *(u32x4*)(rp + bj * 128) = w; } }
        } else if (mode == EM_LR) {
            const int seg = u.pn / 3, c768 = (u.pn % 3) * 256 + ct;
            const float* par = seg < 2 ? (p0 + seg * 768) : (seg < 4 ? (p1 + (seg - 2) * 768) : nullptr);
            bf16_t* base = (bf16_t*)(ws + (seg < 2 ? A_EW + (size_t)seg * TT * 768 * 2 : (seg < 4 ? A_AS + (size_t)(seg - 2) * TT * 768 * 2 : A_G))) + (size_t)(u.pm * 256 + rt) * 768 + c768;
            const float mul = seg < 2 ? 0.60653065971263342f : 1.f;
#pragma unroll
            for (int bj = 0; bj < 2; ++bj) {
                f32x4 pa = {0.f, 0.f, 0.f, 0.f}, pb = pa;
                if (par) { pa = *(const f32x4*)(par + c768 + bj * 128); pb = *(const f32x4*)(par + c768 + bj * 128 + 4); }
#pragma unroll
                for (int ai = 0; ai < 2; ++ai)
#pragma unroll
                    for (int m = 0; m < 4; ++m) { f32x4 v0 = acc[ai][bj][m][0] + pa, v1 = acc[ai][bj][m][1] + pb;
                        if (par) {
#pragma unroll
                            for (int e = 0; e < 4; ++e) { v0[e] = mul * sigmoidf_(v0[e]); v1[e] = mul * sigmoidf_(v1[e]); } }
                        u32x4 w; w.x = cvt_pk_bf16(v0[0], v0[1]); w.y = cvt_pk_bf16(v0[2], v0[3]); w.z = cvt_pk_bf16(v1[0], v1[1]); w.w = cvt_pk_bf16(v1[2], v1[3]);
                        *(u32x4*)(base + (size_t)(ai * 128 + m * 16) * 768 + bj * 128) = w; } }
        } else if (mode == EM_VRES) {
            const int c0 = u.pn * 256 + ct;
            bf16_t* V = (bf16_t*)(ws + A_V); const bf16_t* VS = (const bf16_t*)(ws + A_YS); const bf16_t* VF = (const bf16_t*)(ws + O_VF);
#pragma unroll
            for (int bj = 0; bj < 2; ++bj) {
                const f32x4 pa = *(const f32x4*)(p0 + c0 + bj * 128), pb = *(const f32x4*)(p0 + c0 + bj * 128 + 4);
#pragma unroll
                for (int ai = 0; ai < 2; ++ai)
#pragma unroll
                    for (int m = 0; m < 4; ++m) { const size_t o = (size_t)(u.pm * 256 + rt + ai * 128 + m * 16) * 768 + c0 + bj * 128;
                        float vs[8], vf[8], r[8]; unpack8(*(const u32x4*)(VS + o), vs); unpack8(*(const u32x4*)(VF + o), vf);
                        const f32x4 v0 = acc[ai][bj][m][0] + pa, v1 = acc[ai][bj][m][1] + pb;
#pragma unroll
                        for (int e = 0; e < 4; ++e) { r[e] = vs[e] + (vf[e] - vs[e]) * sigmoidf_(v0[e]); r[4 + e] = vs[4 + e] + (vf[4 + e] - vs[4 + e]) * sigmoidf_(v1[e]); }
                        *(u32x4*)(V + o) = pack8(r); } }
        } else if (mode == EM_MERGE) {
            const bf16_t* GT = (const bf16_t*)(ws + A_GATES); bf16_t* Mb = (bf16_t*)(ws + O_H);
            const int c0 = u.pn * 256 + ct;
#pragma unroll
            for (int ai = 0; ai < 2; ++ai) {
                u32x4 gv[4][2], mv[4][2];
#pragma unroll
                for (int m = 0; m < 4; ++m)
#pragma unroll
                    for (int bj = 0; bj < 2; ++bj) { const size_t row = (size_t)(u.pm * 256 + rt + ai * 128 + m * 16); const int c = c0 + bj * 128;
                        gv[m][bj] = *(const u32x4*)(GT + row * 6144 + aux * 2048 + c);
                        if (aux > 0) mv[m][bj] = *(const u32x4*)(Mb + row * 2048 + c); else mv[m][bj] = (u32x4){0u, 0u, 0u, 0u}; }
                asm volatile("" ::: "memory");
#pragma unroll
                for (int m = 0; m < 4; ++m)
#pragma unroll
                    for (int bj = 0; bj < 2; ++bj) { const size_t row = (size_t)(u.pm * 256 + rt + ai * 128 + m * 16); const int c = c0 + bj * 128;
                        float g[8], o[8], r[8]; unpack8(gv[m][bj], g); unpack8(mv[m][bj], o);
                        const f32x4 v0 = acc[ai][bj][m][0], v1 = acc[ai][bj][m][1];
#pragma unroll
                        for (int e2 = 0; e2 < 4; ++e2) { r[e2] = g[e2] * v0[e2] + o[e2]; r[4 + e2] = g[4 + e2] * v1[e2] + o[4 + e2]; }
                        *(u32x4*)(Mb + row * 2048 + c) = pack8(r); }
                asm volatile("" ::: "memory");
            }
        } else {
            const int c0 = u.pn * 256 + ct;
            const bool lat = u.pm < 64;
            const int cond = lat ? (u.pm >> 4) : 4;
            const float* gp = gmod + (size_t)cond * MODW + aux + c0;
            const float* xi = lat ? xin_l + (size_t)(u.pm * 256) * DM : xin_c + (size_t)((u.pm - 64) * 256) * DM;
            float* xo = lat ? xout_l + (size_t)(u.pm * 256) * DM : xout_c + (size_t)((u.pm - 64) * 256) * DM;
            f32x4 ga[2], gb[2];
#pragma unroll
            for (int bj = 0; bj < 2; ++bj) { ga[bj] = *(const f32x4*)(gp + bj * 128); gb[bj] = *(const f32x4*)(gp + bj * 128 + 4); }
#pragma unroll
            for (int ai = 0; ai < 2; ++ai) {
                f32x4 xa[4][2], xb[4][2];
#pragma unroll
                for (int m = 0; m < 4; ++m)
#pragma unroll
                    for (int bj = 0; bj < 2; ++bj) { const size_t o = (size_t)(rt + ai * 128 + m * 16) * DM + c0 + bj * 128; xa[m][bj] = *(const f32x4*)(xi + o); xb[m][bj] = *(const f32x4*)(xi + o + 4); }
                asm volatile("" ::: "memory");
#pragma unroll
                for (int m = 0; m < 4; ++m)
#pragma unroll
                    for (int bj = 0; bj < 2; ++bj) { const size_t o = (size_t)(rt + ai * 128 + m * 16) * DM + c0 + bj * 128;
                        *(f32x4*)(xo + o) = xa[m][bj] + ga[bj] * acc[ai][bj][m][0]; *(f32x4*)(xo + o + 4) = xb[m][bj] + gb[bj] * acc[ai][bj][m][1]; }
                asm volatile("" ::: "memory");
            }
        }
    }
};

namespace att {
using s16x4 = __attribute__((ext_vector_type(4))) short;
using f32x16 = __attribute__((ext_vector_type(16))) float;
constexpr int NW = 8, QBLK = 32, KVBLK = 64;
constexpr float THR = 8.f;
#ifndef ATT_SDEPTH
#define ATT_SDEPTH 1
#endif
constexpr int SDEPTH = ATT_SDEPTH;
constexpr size_t SHM_V = KVBLK * 128 * 2, SHM_KMAX = KVBLK * 128 * 2, SHM_ATTN = 2 * SHM_V + 2 * SHM_KMAX + NW * 64 * 4;
#define SBAR() __builtin_amdgcn_sched_barrier(0)
template <int DQK> __device__ __forceinline__ int kswz(int row, int colB) { return row * (DQK * 2) + (colB ^ ((DQK == 128 ? (row & 15) : ((row >> 1) & 7)) << 4)); }
__device__ __forceinline__ int crow(int r, int hi) { return (r & 3) + 8 * (r >> 2) + 4 * hi; }
__device__ __forceinline__ void partialSM(f32x16& p0, f32x16& p1, float& m_reg, float& mn, float& alpha, const float C, const float thr_raw) {
    float pmax = p0[0];
#pragma unroll
    for (int r = 1; r < 16; ++r) pmax = fmaxf(pmax, p0[r]);
#pragma unroll
    for (int r = 0; r < 16; ++r) pmax = fmaxf(pmax, p1[r]);
    { auto rr = __builtin_amdgcn_permlane32_swap(__float_as_uint(pmax), __float_as_uint(pmax), false, false);
      pmax = fmaxf(__uint_as_float(rr[0]), __uint_as_float(rr[1])); }
    if (__builtin_expect(__all(pmax - m_reg <= thr_raw), 1)) { mn = m_reg; alpha = 1.f; }
    else { mn = fmaxf(m_reg, pmax); alpha = __builtin_amdgcn_exp2f((m_reg - mn) * C); m_reg = mn; }
    const float mnC = -mn * C;
#pragma unroll
    for (int r = 0; r < 16; ++r) p0[r] = fmaf(p0[r], C, mnC);
#pragma unroll
    for (int r = 0; r < 16; ++r) p1[r] = fmaf(p1[r], C, mnC);
#pragma unroll
    for (int r = 0; r < 16; ++r) p0[r] = __builtin_amdgcn_exp2f(p0[r]);
}
__device__ __forceinline__ void finishSM(f32x16& p0, f32x16& p1, float alpha, float& l_reg, bf16x8& pa0, bf16x8& pa1, bf16x8& pa2, bf16x8& pa3) {
#pragma unroll
    for (int r = 0; r < 16; ++r) p1[r] = __builtin_amdgcn_exp2f(p1[r]);
    float ps = 0;
#pragma unroll
    for (int r = 0; r < 16; ++r) ps += p0[r];
#pragma unroll
    for (int r = 0; r < 16; ++r) ps += p1[r];
    { auto rr = __builtin_amdgcn_permlane32_swap(__float_as_uint(ps), __float_as_uint(ps), false, false);
      ps = __uint_as_float(rr[0]) + __uint_as_float(rr[1]); }
    l_reg = l_reg * alpha + ps;
#define PK4(P, BASE, OUT) do { unsigned a0 = cvt_pk_bf16(P[BASE + 0], P[BASE + 1]), a1 = cvt_pk_bf16(P[BASE + 2], P[BASE + 3]);   \
    unsigned b0 = cvt_pk_bf16(P[BASE + 4], P[BASE + 5]), b1 = cvt_pk_bf16(P[BASE + 6], P[BASE + 7]);                              \
    auto r0 = __builtin_amdgcn_permlane32_swap(a0, b0, false, false); auto r1 = __builtin_amdgcn_permlane32_swap(a1, b1, false, false); \
    u32x4 w = {r0[0], r1[0], r0[1], r1[1]}; OUT = *reinterpret_cast<bf16x8*>(&w); } while (0)
    PK4(p0, 0, pa0); PK4(p0, 8, pa1); PK4(p1, 0, pa2); PK4(p1, 8, pa3);
#undef PK4
}
template <int DQK> __device__ __forceinline__ void qkt(f32x16& p0, f32x16& p1, const char* Ks, const bf16x8* qr, int r32, int hi) {
    p0 = f32x16{}; p1 = f32x16{};
#pragma unroll
    for (int d0 = 0; d0 < DQK / 16; ++d0) { const int cb = (d0 * 16 + hi * 8) * 2;
        const bf16x8 b0 = *reinterpret_cast<const bf16x8*>(Ks + kswz<DQK>(r32, cb));
        const bf16x8 b1 = *reinterpret_cast<const bf16x8*>(Ks + kswz<DQK>(32 + r32, cb));
        p0 = __builtin_amdgcn_mfma_f32_32x32x16_bf16(b0, qr[d0], p0, 0, 0, 0);
        p1 = __builtin_amdgcn_mfma_f32_32x32x16_bf16(b1, qr[d0], p1, 0, 0, 0); }
}
__device__ __forceinline__ int v_st(int k, int c) { const int kk = (k & ~0xC) | ((k & 4) << 1) | ((k & 8) >> 1); return ((kk >> 3) * 4 + (c >> 5)) * 512 + ((kk & 7) * 32 + (c & 31)) * 2; }
__device__ __forceinline__ int v_rd_base(int lane) { return ((lane & 3) << 3) | (((lane >> 2) & 3) << 6) | (((lane >> 4) & 1) << 5) | (((lane >> 5) & 1) << 8); }
constexpr int v_rd_off(int d0, int ks, int half) { return d0 * 512 + ks * 4096 + half * 2048; }
template <int OFF> __device__ __forceinline__ s16x4 tr_read(int vb) {
    s16x4 r; asm volatile("ds_read_b64_tr_b16 %0, %1 offset:%2" : "=&v"(r) : "v"(vb), "i"(OFF) : "memory"); return r;
}
template <int D0> __device__ __forceinline__ void pv_one(f32x16& od, int vb, bf16x8 pa0, bf16x8 pa1, bf16x8 pa2, bf16x8 pa3) {
    const s16x4 l0 = tr_read<v_rd_off(D0, 0, 0)>(vb), h0 = tr_read<v_rd_off(D0, 0, 1)>(vb), l1 = tr_read<v_rd_off(D0, 1, 0)>(vb), h1 = tr_read<v_rd_off(D0, 1, 1)>(vb);
    const s16x4 l2 = tr_read<v_rd_off(D0, 2, 0)>(vb), h2 = tr_read<v_rd_off(D0, 2, 1)>(vb), l3 = tr_read<v_rd_off(D0, 3, 0)>(vb), h3 = tr_read<v_rd_off(D0, 3, 1)>(vb);
    asm volatile("s_waitcnt lgkmcnt(0)" ::: "memory"); SBAR();
#define PK(L, H) (bf16x8){L[0], L[1], L[2], L[3], H[0], H[1], H[2], H[3]}
    od = __builtin_amdgcn_mfma_f32_32x32x16_bf16(pa0, PK(l0, h0), od, 0, 0, 0);
    od = __builtin_amdgcn_mfma_f32_32x32x16_bf16(pa1, PK(l1, h1), od, 0, 0, 0);
    od = __builtin_amdgcn_mfma_f32_32x32x16_bf16(pa2, PK(l2, h2), od, 0, 0, 0);
    od = __builtin_amdgcn_mfma_f32_32x32x16_bf16(pa3, PK(l3, h3), od, 0, 0, 0);
#undef PK
}
__device__ __forceinline__ void pv_d0(f32x16* o, int vb, bf16x8 pa0, bf16x8 pa1, bf16x8 pa2, bf16x8 pa3) {
    pv_one<0>(o[0], vb, pa0, pa1, pa2, pa3); pv_one<1>(o[1], vb, pa0, pa1, pa2, pa3); pv_one<2>(o[2], vb, pa0, pa1, pa2, pa3); pv_one<3>(o[3], vb, pa0, pa1, pa2, pa3);
}
__device__ __forceinline__ void store_o(float* p, float v) { *p = v; }
__device__ __forceinline__ void store_o(bf16_t* p, float v) { *p = (bf16_t)f2bf(v); }

template <int DQK, int LDKV, typename TO>
__device__ __forceinline__ void attn_body(const bf16_t* __restrict__ Qb, const bf16_t* __restrict__ Kh, const bf16_t* __restrict__ Vh,
                                          TO* __restrict__ Ob, int seq, float scale, char* lds) {
    constexpr int ldq = 768, ldo = 768, ldk = LDKV, ldv = LDKV;
    constexpr size_t SHM_K = KVBLK * DQK * 2;
    const int tid = lthread(), wid = tid >> 6, lane = tid & 63, r32 = lane & 31, hi = lane >> 5;
    char* V_lds = lds; char* K_lds = lds + 2 * SHM_V;
    float* ws = (float*)(lds + 2 * SHM_V + 2 * SHM_KMAX) + wid * 64; float* li_l = ws; float* al_l = ws + 32;
    const float C = scale * 1.4426950408889634f, thr_raw = THR / scale;
    float m_reg = -1e30f, l_reg = 0; f32x16 o[4] = {}; bf16x8 qr[DQK / 16];
    const bf16_t* Qw = Qb + (long)(wid * QBLK + r32) * ldq + hi * 8;
#pragma unroll
    for (int d0 = 0; d0 < DQK / 16; ++d0) qr[d0] = *reinterpret_cast<const bf16x8*>(Qw + d0 * 16);
    const int sr = tid >> 4, sc = (tid & 15) * 8, vst0 = v_st(sr, sc), vst1 = v_st(32 + sr, sc);
    const int ksr = DQK == 128 ? sr : (tid >> 3), ksc = DQK == 128 ? sc : (tid & 7) * 8;
    const int vb0 = (int)(uintptr_t)V_lds + v_rd_base(lane);
    struct { bf16x8 vs0, vs1, ks0, ks1; } sr_[SDEPTH];
#define SLOAD(i, k0) do { sr_[i].vs0 = *reinterpret_cast<const bf16x8*>(&Vh[(long)((k0) + sr) * ldv + sc]); sr_[i].vs1 = *reinterpret_cast<const bf16x8*>(&Vh[(long)((k0) + 32 + sr) * ldv + sc]); \
    sr_[i].ks0 = *reinterpret_cast<const bf16x8*>(&Kh[(long)((k0) + ksr) * ldk + ksc]); \
    if (DQK == 128) sr_[i].ks1 = *reinterpret_cast<const bf16x8*>(&Kh[(long)((k0) + 32 + ksr) * ldk + ksc]); } while (0)
#define SWRITE(b, i) do { *(bf16x8*)(V_lds + (b) * SHM_V + vst0) = sr_[i].vs0;          \
    *(bf16x8*)(V_lds + (b) * SHM_V + vst1) = sr_[i].vs1; const int kc = ksc * 2;               \
    *(bf16x8*)(K_lds + (b) * SHM_K + kswz<DQK>(ksr, kc)) = sr_[i].ks0;                       \
    if (DQK == 128) *(bf16x8*)(K_lds + (b) * SHM_K + kswz<DQK>(32 + ksr, kc)) = sr_[i].ks1; } while (0)
#define SWAIT() do { if (SDEPTH == 1) asm volatile("s_waitcnt vmcnt(0)" ::: "memory"); else if (DQK == 128) asm volatile("s_waitcnt vmcnt(4)" ::: "memory"); else asm volatile("s_waitcnt vmcnt(3)" ::: "memory"); } while (0)
#define RESC(a) do { if (__any((a) < 1.f)) { if (hi == 0) al_l[r32] = (a); asm volatile("s_waitcnt lgkmcnt(0)" ::: "memory"); \
    _Pragma("unroll") for (int d = 0; d < 4; ++d) _Pragma("unroll") for (int r = 0; r < 16; ++r) o[d][r] *= al_l[crow(r, hi)]; } } while (0)
    f32x16 pA0, pA1, pB0, pB1; float mnA, mnB, alA, alB; bf16x8 pa0, pa1, pa2, pa3; const int NT = seq / KVBLK;
    constexpr int SE = 0, SO = SDEPTH - 1;
    SLOAD(SE, 0); asm volatile("s_waitcnt vmcnt(0)" ::: "memory"); SWRITE(0, SE); __syncthreads();
    qkt<DQK>(pA0, pA1, K_lds, qr, r32, hi); partialSM(pA0, pA1, m_reg, mnA, alA, C, thr_raw);
    SLOAD(SO, KVBLK); if (SDEPTH == 2) { if (2 < NT) SLOAD(SE, 2 * KVBLK); }
    SWAIT(); SWRITE(1, SO); __syncthreads();
    for (int j = 1; j + 1 < NT; j += 2) {
        SBAR(); qkt<DQK>(pB0, pB1, K_lds + SHM_K, qr, r32, hi);
        finishSM(pA0, pA1, alA, l_reg, pa0, pa1, pa2, pa3); SBAR();
        SLOAD(SO, (j + SDEPTH) * KVBLK); SBAR();
        pv_d0(o, vb0, pa0, pa1, pa2, pa3); partialSM(pB0, pB1, m_reg, mnB, alB, C, thr_raw);
        __syncthreads(); SWAIT(); SWRITE(0, SE);
        RESC(alB); __syncthreads();
        SBAR(); qkt<DQK>(pA0, pA1, K_lds, qr, r32, hi);
        finishSM(pB0, pB1, alB, l_reg, pa0, pa1, pa2, pa3); SBAR();
        if (SDEPTH == 1 || j + 3 < NT) SLOAD(SE, (j + 1 + SDEPTH) * KVBLK); SBAR();
        pv_d0(o, vb0 + (int)SHM_V, pa0, pa1, pa2, pa3); partialSM(pA0, pA1, m_reg, mnA, alA, C, thr_raw);
        __syncthreads(); SWAIT(); SWRITE(1, SO);
        RESC(alA); __syncthreads();
    }
    SBAR(); qkt<DQK>(pB0, pB1, K_lds + SHM_K, qr, r32, hi);
    finishSM(pA0, pA1, alA, l_reg, pa0, pa1, pa2, pa3); SBAR();
    pv_d0(o, vb0, pa0, pa1, pa2, pa3); partialSM(pB0, pB1, m_reg, mnB, alB, C, thr_raw);
    __syncthreads(); RESC(alB);
    finishSM(pB0, pB1, alB, l_reg, pa0, pa1, pa2, pa3); SBAR();
    pv_d0(o, vb0 + (int)SHM_V, pa0, pa1, pa2, pa3);
    if (hi == 0) li_l[r32] = l_reg; asm volatile("s_waitcnt lgkmcnt(0)" ::: "memory");
    float rli[16];
#pragma unroll
    for (int r = 0; r < 16; ++r) rli[r] = __builtin_amdgcn_rcpf(li_l[crow(r, hi)]);
    __syncthreads();
    bf16_t* stg = (bf16_t*)(lds + wid * 8192);
#pragma unroll
    for (int r = 0; r < 16; ++r) { const int orow = crow(r, hi);
#pragma unroll
        for (int d0 = 0; d0 < 4; ++d0) stg[orow * 128 + d0 * 32 + r32] = (bf16_t)f2bf(o[d0][r] * rli[r]); }
    asm volatile("s_waitcnt lgkmcnt(0)" ::: "memory");
    TO* Ow = Ob + (long)(wid * QBLK) * ldo;
#pragma unroll
    for (int i = 0; i < 8; ++i) { const int row = i * 4 + (lane >> 4), ch = lane & 15;
        const u32x4 v = *(const u32x4*)(stg + row * 128 + ch * 8); *(u32x4*)(Ow + (long)row * ldo + ch * 8) = v; }
#undef SLOAD
#undef SWRITE
#undef SWAIT
#undef RESC
}
#undef SBAR
}

struct Args { const float* in[N_IN]; float* out; unsigned char* ws; int ph_lo, ph_hi; };

constexpr int RING_BYTES = 131072, MISC_OFF = RING_BYTES, LDS_BYTES = 147456;

struct Frame {
    const Args* a; unsigned char* ws; char* lds; int tid, lane, wave, gw, ngw;
};

__device__ __forceinline__ void transpose_item(const float* W, int N, bf16_t* WT, int ldk, float* scr, int item, int lane) {
    const int nblk = N / 32, kb = item / nblk, nb = item % nblk, k0 = 64 * kb, n0 = 32 * nb;
    float tv[32];
#pragma unroll
    for (int i = 0; i < 32; ++i) { const int kk = 2 * i + (lane >> 5); tv[i] = W[(size_t)(k0 + kk) * N + n0 + (lane & 31)]; }
#pragma unroll
    for (int i = 0; i < 32; ++i) { const int kk = 2 * i + (lane >> 5); scr[kk * 33 + (lane & 31)] = tv[i]; }
    asm volatile("s_waitcnt lgkmcnt(0)" ::: "memory");
    const int c = lane & 7;
#pragma unroll
    for (int j = 0; j < 4; ++j) { const int n = (lane >> 3) + 8 * j; const float* s = scr + (8 * c) * 33 + n;
        u32x4 o; o.x = cvt_pk_bf16(s[0 * 33], s[1 * 33]); o.y = cvt_pk_bf16(s[2 * 33], s[3 * 33]); o.z = cvt_pk_bf16(s[4 * 33], s[5 * 33]); o.w = cvt_pk_bf16(s[6 * 33], s[7 * 33]);
        *(u32x4*)(WT + (size_t)(n0 + n) * ldk + k0 + 8 * c) = o; }
    asm volatile("s_waitcnt lgkmcnt(0)" ::: "memory");
}
__device__ __forceinline__ void convert_weights(const Frame& F, int layer) {
    float* scr = (float*)(F.lds + F.wave * 16384);
    const Args& A = *F.a;
    constexpr int I_IN = (2048 / 64) * (12288 / 32), I_BRX = (768 / 64) * (2048 / 32), I_OUT = (2048 / 64) * (2048 / 32), I_UPX = (2048 / 64) * (FF2 / 32), I_DN = (FF / 64) * (2048 / 32);
    constexpr int NITEMS = I_IN + 3 * I_BRX + I_OUT + I_UPX + I_DN;
    for (int it = F.gw; it < NITEMS; it += F.ngw) {
        int r = it;
        if (r < I_IN) { transpose_item(A.in[I_WIN] + (size_t)layer * 2048 * 12288, 12288, (bf16_t*)(F.ws + W_IN), 2048, scr, r, F.lane); continue; } r -= I_IN;
        if (r < I_BRX) { transpose_item(A.in[I_WBR] + (size_t)layer * 768 * 2048, 2048, (bf16_t*)(F.ws + W_BR), 768, scr, r, F.lane); continue; } r -= I_BRX;
        if (r < I_BRX) { transpose_item(A.in[I_WBG] + (size_t)layer * 768 * 2048, 2048, (bf16_t*)(F.ws + W_BR) + 2048 * 768, 768, scr, r, F.lane); continue; } r -= I_BRX;
        if (r < I_BRX) { transpose_item(A.in[I_WBD] + (size_t)layer * 768 * 2048, 2048, (bf16_t*)(F.ws + W_BR) + 2 * 2048 * 768, 768, scr, r, F.lane); continue; } r -= I_BRX;
        if (r < I_OUT) { transpose_item(A.in[I_WOUT] + (size_t)layer * 2048 * 2048, 2048, (bf16_t*)(F.ws + W_OUT), 2048, scr, r, F.lane); continue; } r -= I_OUT;
        if (r < I_UPX) { transpose_item(A.in[I_UP] + (size_t)layer * 2048 * FF2, FF2, (bf16_t*)(F.ws + W_UP), 2048, scr, r, F.lane); continue; } r -= I_UPX;
        transpose_item(A.in[I_DOWN] + (size_t)layer * FF * 2048, 2048, (bf16_t*)(F.ws + W_DOWN), FF, scr, r, F.lane);
    }
    const float* w2 = A.in[I_W2] + (size_t)layer * 2 * 64 * 768; const float* a2 = A.in[I_A2] + (size_t)layer * 2 * 64 * 768; const float* g2 = A.in[I_G2] + (size_t)layer * 128 * 768;
    for (int n = F.gw; n < 3840 + (layer == 1 ? 768 * 12 : 0); n += F.ngw) {
        if (n < 3840) {
            const int seg = n / 768, c = n % 768; bf16_t* dst = (bf16_t*)(F.ws + W_LR) + (size_t)n * 256;
#pragma unroll
            for (int j = 0; j < 4; ++j) { const int k = j * 64 + F.lane; float v = 0.f;
                if (seg < 2) { if (k < 64) v = w2[((size_t)seg * 64 + k) * 768 + c]; }
                else if (seg < 4) { if (k >= 64 && k < 128) v = a2[((size_t)(seg - 2) * 64 + (k - 64)) * 768 + c]; }
                else { if (k >= 128) v = g2[(size_t)(k - 128) * 768 + c]; }
                dst[k] = (bf16_t)f2bf(v); }
        } else {
            const int q_ = n - 3840, nn = q_ / 12, k = (q_ % 12) * 64 + F.lane;
            const float* v1r = A.in[I_V1] + (size_t)k * 32; const float* v2p = A.in[I_V2] + nn;
            f32x4 a[8]; float b[32];
#pragma unroll
            for (int r4 = 0; r4 < 8; ++r4) a[r4] = *(const f32x4*)(v1r + 4 * r4);
#pragma unroll
            for (int r = 0; r < 32; ++r) b[r] = v2p[(size_t)r * 768];
            float s = 0.f;
#pragma unroll
            for (int r4 = 0; r4 < 8; ++r4) s += a[r4].x * b[4 * r4] + a[r4].y * b[4 * r4 + 1] + a[r4].z * b[4 * r4 + 2] + a[r4].w * b[4 * r4 + 3];
            ((bf16_t*)(F.ws + W_V12))[(size_t)nn * 768 + k] = (bf16_t)f2bf(s);
        }
    }
}
__device__ __forceinline__ void adaln(const Frame& F) {
    const Args& A = *F.a;
    float* sc = (float*)F.lds;
    float* red = (float*)(F.lds + 40960);
    for (int i = F.tid; i < 5 * 2048; i += NTHREADS) { const int cnd = i >> 11, k = i & 2047; const float v = cnd < 4 ? A.in[I_C][cnd * 2048 + k] : A.in[I_CCTX][k]; sc[i] = v * __builtin_amdgcn_rcpf(1.f + __expf(-v)); }
    __syncthreads();
    float* MOD = (float*)(F.ws + O_MOD);
    for (int slab = blockIdx.x; slab < 256; slab += gridDim.x) {
        const int col0 = slab * 96, layer = col0 / MODW, cc = col0 % MODW;
        const float* W = A.in[I_WMOD] + (size_t)layer * 2048 * MODW + cc;
        float a0[5] = {0.f, 0.f, 0.f, 0.f, 0.f}, a1[5] = {0.f, 0.f, 0.f, 0.f, 0.f};
        const int kb = F.wave * 256;
#pragma unroll 8
        for (int k = kb; k < kb + 256; ++k) {
            const float w0 = W[(size_t)k * MODW + F.lane]; const float w1 = F.lane < 32 ? W[(size_t)k * MODW + 64 + F.lane] : 0.f;
#pragma unroll
            for (int c = 0; c < 5; ++c) { const float s = sc[c * 2048 + k]; a0[c] += s * w0; a1[c] += s * w1; }
        }
#pragma unroll
        for (int c = 0; c < 5; ++c) { red[(F.wave * 10 + c * 2) * 64 + F.lane] = a0[c]; red[(F.wave * 10 + c * 2 + 1) * 64 + F.lane] = a1[c]; }
        __syncthreads();
        if (F.tid < 480) { const int c = F.tid / 96, j = F.tid % 96; float s = A.in[I_BMOD][layer * MODW + cc + j];
#pragma unroll
            for (int w = 0; w < 8; ++w) s += red[(w * 10 + c * 2 + (j >> 6)) * 64 + (j & 63)];
            MOD[((size_t)layer * 5 + c) * MODW + cc + j] = s; }
        __syncthreads();
    }
}
__device__ __forceinline__ void norm_rows(const Frame& F, const float* xl, const float* xc, const float* gain, const float* mod  , int sh_off, int sc_off, int nrows) {
    bf16_t* H = (bf16_t*)(F.ws + O_H);
    for (int m0 = F.gw; m0 < nrows; m0 += 2 * F.ngw) {
        const int m1 = m0 + F.ngw < nrows ? m0 + F.ngw : m0;
        const float* xr0 = m0 < TL ? xl + (size_t)m0 * DM : xc + (size_t)(m0 - TL) * DM;
        const float* xr1 = m1 < TL ? xl + (size_t)m1 * DM : xc + (size_t)(m1 - TL) * DM;
        f32x4 v0[8], v1[8]; float s0 = 0.f, s1 = 0.f;
#pragma unroll
        for (int j = 0; j < 8; ++j) { v0[j] = *(const f32x4*)(xr0 + j * 256 + F.lane * 4); v1[j] = *(const f32x4*)(xr1 + j * 256 + F.lane * 4); }
#pragma unroll
        for (int j = 0; j < 8; ++j) { s0 += v0[j].x * v0[j].x + v0[j].y * v0[j].y + v0[j].z * v0[j].z + v0[j].w * v0[j].w; s1 += v1[j].x * v1[j].x + v1[j].y * v1[j].y + v1[j].z * v1[j].z + v1[j].w * v1[j].w; }
        const float rs0 = rsqrtf(wave_sum(s0) * (1.f / DM) + 1e-6f), rs1 = rsqrtf(wave_sum(s1) * (1.f / DM) + 1e-6f);
        const float* mp0 = mod + (size_t)(m0 < TL ? (m0 >> 12) : 4) * MODW; const float* mp1 = mod + (size_t)(m1 < TL ? (m1 >> 12) : 4) * MODW;
#pragma unroll
        for (int j = 0; j < 8; ++j) { const int c = j * 256 + F.lane * 4;
            const f32x4 g = *(const f32x4*)(gain + c);
            { const f32x4 sh = *(const f32x4*)(mp0 + sh_off + c), sc = *(const f32x4*)(mp0 + sc_off + c); const f32x4 y = v0[j] * rs0 * g * (sc + 1.f) + sh;
              u32x2 w; w.x = cvt_pk_bf16(y.x, y.y); w.y = cvt_pk_bf16(y.z, y.w); *(u32x2*)(H + (size_t)m0 * DM + c) = w; }
            if (m1 != m0) { const f32x4 sh = *(const f32x4*)(mp1 + sh_off + c), sc = *(const f32x4*)(mp1 + sc_off + c); const f32x4 y = v1[j] * rs1 * g * (sc + 1.f) + sh;
              u32x2 w; w.x = cvt_pk_bf16(y.x, y.y); w.y = cvt_pk_bf16(y.z, y.w); *(u32x2*)(H + (size_t)m1 * DM + c) = w; }
        }
    }
}
__device__ __forceinline__ void final_norm(const Frame& F) {
    float* X = F.a->out; const float* gain = F.a->in[I_FN];
    for (int m0 = F.gw; m0 < TL; m0 += 2 * F.ngw) {
        const int m1 = m0 + F.ngw < TL ? m0 + F.ngw : m0;
        float* xr0 = X + (size_t)m0 * DM; float* xr1 = X + (size_t)m1 * DM; f32x4 v0[8], v1[8]; float s0 = 0.f, s1 = 0.f;
#pragma unroll
        for (int j = 0; j < 8; ++j) { v0[j] = *(const f32x4*)(xr0 + j * 256 + F.lane * 4); v1[j] = *(const f32x4*)(xr1 + j * 256 + F.lane * 4); }
#pragma unroll
        for (int j = 0; j < 8; ++j) { s0 += v0[j].x * v0[j].x + v0[j].y * v0[j].y + v0[j].z * v0[j].z + v0[j].w * v0[j].w; s1 += v1[j].x * v1[j].x + v1[j].y * v1[j].y + v1[j].z * v1[j].z + v1[j].w * v1[j].w; }
        const float rs0 = rsqrtf(wave_sum(s0) * (1.f / DM) + 1e-6f), rs1 = rsqrtf(wave_sum(s1) * (1.f / DM) + 1e-6f);
#pragma unroll
        for (int j = 0; j < 8; ++j) { const int c = j * 256 + F.lane * 4; const f32x4 g = *(const f32x4*)(gain + c);
            *(f32x4*)(xr0 + c) = v0[j] * rs0 * g; if (m1 != m0) *(f32x4*)(xr1 + c) = v1[j] * rs1 * g; }
    }
}
__device__ __forceinline__ float row16_sum_p(float v) {
    v += __int_as_float(__builtin_amdgcn_update_dpp(0, __float_as_int(v), 0xB1, 0xF, 0xF, true));
    v += __int_as_float(__builtin_amdgcn_update_dpp(0, __float_as_int(v), 0x4E, 0xF, 0xF, true));
    v += __int_as_float(__builtin_amdgcn_update_dpp(0, __float_as_int(v), 0x141, 0xF, 0xF, true));
    v += __int_as_float(__builtin_amdgcn_update_dpp(0, __float_as_int(v), 0x140, 0xF, 0xF, true));
    return v;
}
__device__ __forceinline__ f32x4 unpack4p(u32x2 w) { return (f32x4){bf2f(w.x & 0xffffu), __uint_as_float(w.x & 0xffff0000u), bf2f(w.y & 0xffffu), __uint_as_float(w.y & 0xffff0000u)}; }
__device__ __forceinline__ u32x2 pack4p(f32x4 v) { u32x2 w; w.x = cvt_pk_bf16(v.x, v.y); w.y = cvt_pk_bf16(v.z, v.w); return w; }
__device__ __forceinline__ void rwkv_prep(const Frame& F, int layer) {
    const Args& A = *F.a;
    const bf16_t* PR = (const bf16_t*)(F.ws + A_PR);
    bf16_t* R = (bf16_t*)(F.ws + A_R); bf16_t* K = (bf16_t*)(F.ws + A_K); bf16_t* V = (bf16_t*)(F.ws + (layer == 0 ? O_VF : A_YS));
    bf16_t* KKo = (bf16_t*)(F.ws + A_KKN); bf16_t* LR = (bf16_t*)(F.ws + A_LR);
    const float* mu = A.in[I_MU] + layer * RCOLS; const float* kkw = A.in[I_KK] + layer * RW;
    const int l4 = F.lane * 4;
    for (int m = F.gw; m < TT; m += F.ngw) {
        const bool lat = m < TL; const int t = lat ? (m & 4095) : ((m - TL) & 255), len = lat ? SEQ : CTX;
        const bool hp = t > 0, hn = t < len - 1;
        const bf16_t* p = PR + (size_t)m * RCOLS;
        const u32x2 z2 = {0u, 0u};
        u32x2 rc[10], rp[10], rn[10]; f32x4 rm[10], rk3[3];
#pragma unroll
        for (int it = 0; it < 10; ++it) { const int c = it * 256 + l4;
            rc[it] = *(const u32x2*)(p + c); rp[it] = hp ? *(const u32x2*)(p + c - RCOLS) : z2; rn[it] = hn ? *(const u32x2*)(p + c + RCOLS) : z2; rm[it] = *(const f32x4*)(mu + c); }
#pragma unroll
        for (int j = 0; j < 3; ++j) rk3[j] = *(const f32x4*)(kkw + j * 256 + l4);
        asm volatile("" ::: "memory");
#pragma unroll
        for (int it = 0; it < 10; ++it) { const int c = it * 256 + l4;
            const f32x4 cur = unpack4p(rc[it]), pv = unpack4p(rp[it]), nx = unpack4p(rn[it]);
            const f32x4 xs = cur + rm[it] * ((pv + nx) * 0.5f - cur);
            if (it < 3) { *(u32x2*)(R + (size_t)m * RW + c) = pack4p(xs); }
            else if (it < 6) { const int ck = c - 768; *(u32x2*)(K + (size_t)m * RW + ck) = pack4p(xs);
                const f32x4 kk = xs * rk3[it - 3 < 0 ? 0 : (it - 3 > 2 ? 2 : it - 3)];
                const float ss = row16_sum_p((kk.x * kk.x + kk.y * kk.y) + (kk.z * kk.z + kk.w * kk.w));
                *(u32x2*)(KKo + (size_t)m * RW + ck) = pack4p(kk * __builtin_amdgcn_rsqf(fmaxf(ss, 1e-24f))); }
            else if (it < 9) { *(u32x2*)(V + (size_t)m * RW + c - 1536) = pack4p(xs); }
            else { f32x4 o;
                if (F.lane < 16) o = (f32x4){2.f * sigmoidf_(2.f * xs.x) - 1.f, 2.f * sigmoidf_(2.f * xs.y) - 1.f, 2.f * sigmoidf_(2.f * xs.z) - 1.f, 2.f * sigmoidf_(2.f * xs.w) - 1.f};
                else if (F.lane < 32) o = xs;
                else o = (f32x4){sigmoidf_(xs.x), sigmoidf_(xs.y), sigmoidf_(xs.z), sigmoidf_(xs.w)};
                *(u32x2*)(LR + (size_t)m * 256 + l4) = pack4p(o); }
        }
        asm volatile("" ::: "memory");
    }
}
__device__ __forceinline__ void qk_prep(const Frame& F, int layer) {
    const Args& A = *F.a;
    bf16_t* QG = (bf16_t*)(F.ws + A_QG); bf16_t* KG = (bf16_t*)(F.ws + A_KG); bf16_t* DQ = (bf16_t*)(F.ws + A_DQ); bf16_t* DK = (bf16_t*)(F.ws + A_DK);
    float* TGc = (float*)F.lds; float* TGs = TGc + 2048; float* TDc = TGs + 2048; float* TDs = TDc + 1024;
    __syncthreads();
    for (int i = F.tid; i < 2048; i += NTHREADS) { float s_, c_; { const float a_ = (float)(i >> 5) * __builtin_amdgcn_exp2f(-(float)(i & 31) * (13.287712379549449f / 32.f)); s_ = __sinf(a_); c_ = __cosf(a_); } TGc[i] = c_; TGs[i] = s_; }
    for (int i = F.tid; i < 1024; i += NTHREADS) { float s_, c_; { const float a_ = (float)(i >> 4) * __builtin_amdgcn_exp2f(-(float)(i & 15) * (13.287712379549449f / 16.f)); s_ = __sinf(a_); c_ = __cosf(a_); } TDc[i] = c_; TDs[i] = s_; }
    __syncthreads();
    const int l = F.lane, sub = l & 15, hg = l >> 4, sub8 = l & 7;
    float gq[8], gk[8];
#pragma unroll
    for (int e = 0; e < 8; ++e) { gq[e] = A.in[I_QN][layer * 128 + sub * 8 + e]; gk[e] = A.in[I_KN][layer * 128 + sub * 8 + e]; }
    for (int m = F.gw; m < TT; m += F.ngw) {
        const bool lat = m < TL; const int b = lat ? (m >> 12) : ((m - TL) >> 8), t = lat ? (m & 4095) : ((m - TL) & 255);
        const size_t kvrow = (size_t)b * KVS + (lat ? CTX + t : t);
        const int ridx = t >> 6, cidx = t & 63;
        u32x4 qraw[2], draw[3];
#pragma unroll
        for (int ps = 0; ps < 2; ++ps) { const bool isk = ps == 1 && hg >= 2;
            qraw[ps] = *(const u32x4*)(isk ? KG + kvrow * 256 + (hg - 2) * 128 + sub * 8 : QG + (size_t)m * 768 + (ps * 4 + hg) * 128 + sub * 8); }
#pragma unroll
        for (int ps = 0; ps < 3; ++ps) { const int v = ps * 8 + (l >> 3);
            draw[ps] = lat ? *(const u32x4*)(v < 12 ? DQ + (size_t)m * 768 + v * 64 + sub8 * 8 : DK + kvrow * 768 + (v - 12) * 64 + sub8 * 8) : (u32x4){0u, 0u, 0u, 0u}; }
        asm volatile("" ::: "memory");
#pragma unroll
        for (int ps = 0; ps < 2; ++ps) {
            const bool isk = ps == 1 && hg >= 2;
            bf16_t* ptr = isk ? KG + kvrow * 256 + (hg - 2) * 128 + sub * 8 : QG + (size_t)m * 768 + (ps * 4 + hg) * 128 + sub * 8;
            float x[8]; unpack8(qraw[ps], x);
            float ss = 0.f;
#pragma unroll
            for (int e = 0; e < 8; ++e) ss += x[e] * x[e];
            const float rs = rsqrtf(row16_sum_p(ss) * (1.f / 128.f) + 1e-6f);
#pragma unroll
            for (int e = 0; e < 8; ++e) x[e] *= rs * (isk ? gk[e] : gq[e]);
            if (lat) {
                const int ti = (sub < 8 ? ridx : cidx) * 32 + (sub & 3) * 8; const bool up = (sub & 4) != 0;
                const f32x4 c0 = *(const f32x4*)(TGc + ti), c1 = *(const f32x4*)(TGc + ti + 4), s0 = *(const f32x4*)(TGs + ti), s1 = *(const f32x4*)(TGs + ti + 4);
#pragma unroll
                for (int e = 0; e < 8; ++e) { const float pl_ = __int_as_float(__builtin_amdgcn_update_dpp(0, __float_as_int(x[e]), 0x104, 0xF, 0xF, true)), pr_ = __int_as_float(__builtin_amdgcn_update_dpp(0, __float_as_int(x[e]), 0x114, 0xF, 0xF, true)); const float pz = up ? pr_ : pl_; const float cc = e < 4 ? c0[e & 3] : c1[e & 3], sn = e < 4 ? s0[e & 3] : s1[e & 3];
                    x[e] = up ? pz * sn + x[e] * cc : x[e] * cc - pz * sn; }
            }
            *(u32x4*)ptr = pack8(x);
        }
        if (lat) {
#pragma unroll
            for (int ps = 0; ps < 3; ++ps) { const int v = ps * 8 + (l >> 3);
                bf16_t* ptr = v < 12 ? DQ + (size_t)m * 768 + v * 64 + sub8 * 8 : DK + kvrow * 768 + (v - 12) * 64 + sub8 * 8;
                float x[8]; unpack8(draw[ps], x);
                const int ti = (sub8 < 4 ? ridx : cidx) * 16 + (sub8 & 1) * 8; const bool up = (sub8 & 2) != 0;
                const f32x4 c0 = *(const f32x4*)(TDc + ti), c1 = *(const f32x4*)(TDc + ti + 4), s0 = *(const f32x4*)(TDs + ti), s1 = *(const f32x4*)(TDs + ti + 4);
#pragma unroll
                for (int e = 0; e < 8; ++e) { const float pz = __int_as_float(__builtin_amdgcn_update_dpp(0, __float_as_int(x[e]), 0x4E, 0xF, 0xF, true));
                    const float cc = e < 4 ? c0[e & 3] : c1[e & 3], sn = e < 4 ? s0[e & 3] : s1[e & 3];
                    x[e] = up ? pz * sn + x[e] * cc : x[e] * cc - pz * sn; }
                *(u32x4*)ptr = pack8(x);
            }
        }
    }
}
__device__ __forceinline__ float quad_sum(float v) {
    v += __int_as_float(__builtin_amdgcn_update_dpp(0, __float_as_int(v), 0xB1, 0xF, 0xF, true));
    v += __int_as_float(__builtin_amdgcn_update_dpp(0, __float_as_int(v), 0x4E, 0xF, 0xF, true));
    return v;
}
struct ScanStep { f32x4 w[2], kd[2], kk[2], b[2], r[2]; f32x2 v; };
__device__ __forceinline__ ScanStep scan_ld(const float* cb, const float* vbp, int s) {
    ScanStep d; const float* rec = cb + s * 384;
#pragma unroll
    for (int jj = 0; jj < 2; ++jj) { d.w[jj] = *(const f32x4*)(rec + jj * 4); d.kd[jj] = *(const f32x4*)(rec + 64 + jj * 4); d.kk[jj] = *(const f32x4*)(rec + 128 + jj * 4);
        d.b[jj] = *(const f32x4*)(rec + 192 + jj * 4); d.r[jj] = *(const f32x4*)(rec + 256 + jj * 4); }
    d.v = *(const f32x2*)(vbp + s * 384);
    return d;
}
__device__ __forceinline__ float oct_sum(float v) {
    v += __int_as_float(__builtin_amdgcn_update_dpp(0, __float_as_int(v), 0xB1, 0xF, 0xF, true));
    v += __int_as_float(__builtin_amdgcn_update_dpp(0, __float_as_int(v), 0x4E, 0xF, 0xF, true));
    v += __int_as_float(__builtin_amdgcn_update_dpp(0, __float_as_int(v), 0x141, 0xF, 0xF, true));
    return v;
}
__device__ __forceinline__ int scan_rowof(int g, int b, int dir) { if (g < CTX) { const int tt = dir ? (CTX - 1 - g) : g; return TL + b * CTX + tt; } const int g2 = g - CTX; const int tt = dir ? (SEQ - 1 - g2) : g2; return b * SEQ + tt; }
__device__ __forceinline__ void scan_chain(const Frame& F, int layer, int chain) {
    const Args& A = *F.a;
    const int b = chain / 24, h = (chain >> 1) % 12, dir = chain & 1;
    float* buf = (float*)F.lds;
    float* ybuf = (float*)(F.lds + 49152);
    const bf16_t* R = (const bf16_t*)(F.ws + A_R); const bf16_t* K = (const bf16_t*)(F.ws + A_K); const bf16_t* V = (const bf16_t*)(F.ws + (layer == 0 ? O_VF : A_V));
    const bf16_t* KKp = (const bf16_t*)(F.ws + A_KKN); const bf16_t* EW = (const bf16_t*)(F.ws + A_EW) + (size_t)dir * TT * RW; const bf16_t* AS = (const bf16_t*)(F.ws + A_AS) + (size_t)dir * TT * RW;
    float* YS = (float*)(F.ws + A_YS) + (size_t)dir * TT * RW;
    const bool stager = F.wave >= 4;
    const int t8 = F.tid & 255, s_st = t8 >> 4, part = t8 & 15, seg = part & 7, hrole = part >> 3;
    const int colo = h * 64 + seg * 8;
    float ka[8];
#pragma unroll
    for (int e = 0; e < 8; ++e) ka[e] = A.in[I_KA][layer * RW + colo + e];
    constexpr int NCH = (CTX + SEQ) / 16;
#define rowof(g) scan_rowof((g), b, dir)
    u32x4 z4 = {0u, 0u, 0u, 0u};
    u32x4 a0A = z4, a1A = z4, a2A = z4, a3A = z4, a0B = z4, a1B = z4, a2B = z4, a3B = z4;
#define SC_LOAD(r0, r1, r2, r3, n) do { const size_t ro_ = (size_t)rowof((n) * 16 + s_st) * RW + colo; \
        if (hrole == 0) { r0 = *(const u32x4*)(EW + ro_); r1 = *(const u32x4*)(R + ro_); r2 = *(const u32x4*)(K + ro_); r3 = *(const u32x4*)(AS + ro_); } \
        else { r0 = *(const u32x4*)(KKp + ro_); r1 = *(const u32x4*)(AS + ro_); r2 = *(const u32x4*)(V + ro_); } } while (0)
#define SC_WRITE(r0, r1, r2, r3, bi) do { float* d_ = buf + (bi) * 6144 + s_st * 384 + seg * 8; float x_[8], y_[8]; \
        if (hrole == 0) { unpack8(r0, x_); unpack8(r1, y_); float o_[8]; \
            _Pragma("unroll") for (int e = 0; e < 8; ++e) o_[e] = __expf(-x_[e]); \
            *(f32x4*)(d_) = (f32x4){o_[0], o_[1], o_[2], o_[3]}; *(f32x4*)(d_ + 4) = (f32x4){o_[4], o_[5], o_[6], o_[7]}; \
            *(f32x4*)(d_ + 256) = (f32x4){y_[0], y_[1], y_[2], y_[3]}; *(f32x4*)(d_ + 260) = (f32x4){y_[4], y_[5], y_[6], y_[7]}; \
            unpack8(r2, x_); unpack8(r3, y_); \
            _Pragma("unroll") for (int e = 0; e < 8; ++e) o_[e] = x_[e] * (1.f + (y_[e] - 1.f) * ka[e]); \
            *(f32x4*)(d_ + 64) = (f32x4){o_[0], o_[1], o_[2], o_[3]}; *(f32x4*)(d_ + 68) = (f32x4){o_[4], o_[5], o_[6], o_[7]}; } \
        else { unpack8(r0, x_); unpack8(r1, y_); \
            *(f32x4*)(d_ + 128) = (f32x4){x_[0], x_[1], x_[2], x_[3]}; *(f32x4*)(d_ + 132) = (f32x4){x_[4], x_[5], x_[6], x_[7]}; \
            *(f32x4*)(d_ + 192) = (f32x4){x_[0] * y_[0], x_[1] * y_[1], x_[2] * y_[2], x_[3] * y_[3]}; *(f32x4*)(d_ + 196) = (f32x4){x_[4] * y_[4], x_[5] * y_[5], x_[6] * y_[6], x_[7] * y_[7]}; \
            unpack8(r2, x_); \
            *(f32x4*)(d_ + 320) = (f32x4){x_[0], x_[1], x_[2], x_[3]}; *(f32x4*)(d_ + 324) = (f32x4){x_[4], x_[5], x_[6], x_[7]}; } } while (0)
    const int row_i = (F.wave & 3) * 16 + (F.lane >> 3) * 2, q = F.lane & 7;
    f32x2 S0[4], S1[4];
#pragma unroll
    for (int j = 0; j < 4; ++j) { S0[j] = (f32x2){0.f, 0.f}; S1[j] = (f32x2){0.f, 0.f}; }
    if (stager) { SC_LOAD(a0A, a1A, a2A, a3A, 0); SC_WRITE(a0A, a1A, a2A, a3A, 0); SC_LOAD(a0B, a1B, a2B, a3B, 1); SC_LOAD(a0A, a1A, a2A, a3A, 2); }
    __syncthreads();
#define SC_ITER(n, r0, r1, r2, r3) do { \
        if (!stager) { const float* cb = buf + ((n) & 1) * 6144 + q * 8; const float* vbp = buf + ((n) & 1) * 6144 + 320 + row_i; float* yb = ybuf + ((n) & 1) * 8192 + ((F.wave & 3) * 64 + F.lane) * 2; \
          ScanStep cur = scan_ld(cb, vbp, 0); \
          _Pragma("unroll") for (int hs = 0; hs < 2; ++hs) { f32x2 yreg[8]; \
          _Pragma("unroll") for (int s8 = 0; s8 < 8; ++s8) { const int s = hs * 8 + s8; \
            const ScanStep nx = scan_ld(cb, vbp, s < 15 ? s + 1 : 15); \
            f32x2 a0 = S0[0] * cur.kk[0].xy, a1 = S0[1] * cur.kk[0].zw, c0 = S1[0] * cur.kk[0].xy, c1 = S1[1] * cur.kk[0].zw; \
            a0 += S0[2] * cur.kk[1].xy; a1 += S0[3] * cur.kk[1].zw; c0 += S1[2] * cur.kk[1].xy; c1 += S1[3] * cur.kk[1].zw; \
            a0 += a1; c0 += c1; \
            const float nsa0 = -oct_sum(a0.x + a0.y), nsa1 = -oct_sum(c0.x + c0.y); \
            const float v0 = cur.v.x, v1 = cur.v.y; \
            f32x2 y0 = {0.f, 0.f}, y1 = {0.f, 0.f}, z0 = {0.f, 0.f}, z1 = {0.f, 0.f}; \
            _Pragma("unroll") for (int jj = 0; jj < 2; ++jj) { \
                S0[2 * jj] = S0[2 * jj] * cur.w[jj].xy + (cur.kd[jj].xy * v0 + cur.b[jj].xy * nsa0); \
                S0[2 * jj + 1] = S0[2 * jj + 1] * cur.w[jj].zw + (cur.kd[jj].zw * v0 + cur.b[jj].zw * nsa0); \
                S1[2 * jj] = S1[2 * jj] * cur.w[jj].xy + (cur.kd[jj].xy * v1 + cur.b[jj].xy * nsa1); \
                S1[2 * jj + 1] = S1[2 * jj + 1] * cur.w[jj].zw + (cur.kd[jj].zw * v1 + cur.b[jj].zw * nsa1); \
                y0 += S0[2 * jj] * cur.r[jj].xy; y1 += S0[2 * jj + 1] * cur.r[jj].zw; \
                z0 += S1[2 * jj] * cur.r[jj].xy; z1 += S1[2 * jj + 1] * cur.r[jj].zw; } \
            y0 += y1; z0 += z1; \
            yreg[s8] = (f32x2){y0.x + y0.y, z0.x + z0.y}; \
            cur = nx; } \
          _Pragma("unroll") for (int s8 = 0; s8 < 8; ++s8) *(f32x2*)(yb + (hs * 8 + s8) * 512) = yreg[s8]; } } \
        else { if ((n) + 1 < NCH) SC_WRITE(r0, r1, r2, r3, ((n) + 1) & 1); \
               if ((n) + 3 < NCH) SC_LOAD(r0, r1, r2, r3, (n) + 3); } \
        __syncthreads(); \
        if (stager) { const int s = t8 >> 4, i4 = (t8 & 15) * 4; const float* yb = ybuf + ((n) & 1) * 8192 + s * 512 + (i4 >> 1) * 16; \
          f32x4 o_ = {0.f, 0.f, 0.f, 0.f}; \
          _Pragma("unroll") for (int qq = 0; qq < 4; ++qq) { const f32x4 pa_ = *(const f32x4*)(yb + qq * 4), pb_ = *(const f32x4*)(yb + 16 + qq * 4); \
            o_.x += pa_.x + pa_.z; o_.y += pa_.y + pa_.w; o_.z += pb_.x + pb_.z; o_.w += pb_.y + pb_.w; } \
          *(f32x4*)(YS + (size_t)rowof((n) * 16 + s) * RW + h * 64 + i4) = o_; } } while (0)
    for (int n = 0; n < NCH; n += 2) { SC_ITER(n, a0B, a1B, a2B, a3B); SC_ITER(n + 1, a0A, a1A, a2A, a3A); }
    __syncthreads();
#undef SC_ITER
#undef SC_LOAD
#undef SC_WRITE
#undef rowof
}
__device__ __forceinline__ void ph_mix(const Frame& F, int layer, int rep) {
#ifndef PROBE_SUB
#define PROBE_SUB 0
#endif
    if (!(rep == 1 && PROBE_SUB == 2))
    for (int ch = blockIdx.x; ch < 96; ch += gridDim.x) scan_chain(F, layer, ch);
    unsigned* qbase = (unsigned*)(F.ws + O_CTL) + 64 * (16 + (layer * 2 + rep) * 8);
    volatile unsigned* misc = (volatile unsigned*)(F.lds + MISC_OFF);
    const int NK = (rep == 1 && PROBE_SUB == 1) ? 0 : (layer == 0 ? 144 + 9 : 144);
    const bf16_t* QG = (const bf16_t*)(F.ws + A_QG); const bf16_t* KG = (const bf16_t*)(F.ws + A_KG); const bf16_t* VG = (const bf16_t*)(F.ws + A_VG);
    const bf16_t* DQ = (const bf16_t*)(F.ws + A_DQ); const bf16_t* DK = (const bf16_t*)(F.ws + A_DK); const bf16_t* DV = (const bf16_t*)(F.ws + A_DV);
    bf16_t* YG = (bf16_t*)(F.ws + A_YG); bf16_t* OD = (bf16_t*)(F.ws + A_OD);
    const int x0 = (int)(xb_xcc_id() & 7u);
    int qi = 0;
    for (;;) {
        __syncthreads();
        if (F.tid == 0) { int qq = qi; unsigned uu = 0xFFFFFFFFu;
            while (qq < 8) { const int x = (x0 + qq) & 7; const unsigned k = atomicAdd(qbase + 64 * x, 1u); if ((int)k < NK) { uu = ((unsigned)x << 16) | k; break; } ++qq; }
            misc[0] = uu; misc[1] = (unsigned)qq; }
        __syncthreads();
        const unsigned uu = misc[0]; qi = (int)misc[1];
        if (uu == 0xFFFFFFFFu) break;
        const int x = (int)(uu >> 16), k = (int)(uu & 0xFFFFu);
        const bool isctx = k >= 144;
        const int g = x + 8 * (isctx ? (k - 144) : (k >> 4)), qb = k & 15;
        const bf16_t *qp, *kp, *vp; size_t orow; int kind, seq, oh;
        if (g < 24) { const int b = g / 6, hq = g % 6; orow = isctx ? (size_t)TL + b * CTX : (size_t)b * SEQ + qb * 256; kind = 0; oh = hq;
            qp = QG + orow * 768 + hq * 128; kp = KG + (size_t)b * KVS * 256 + (hq / 3) * 128; vp = VG + (size_t)b * KVS * 256 + (hq / 3) * 128; }
        else { const int d = g - 24, b = d / 12, h = (d >> 1) % 6, mp = d & 1; orow = isctx ? (size_t)TL + b * CTX : (size_t)b * SEQ + qb * 256; kind = 1 + mp; oh = h;
            qp = DQ + orow * 768 + (h * 2 + mp) * 64; kp = DK + (size_t)b * KVS * 768 + (h * 2 + mp) * 64; vp = DV + (size_t)b * KVS * 768 + h * 128; }
        seq = isctx ? CTX : KVS;
        if (kind == 0) att::attn_body<128, 256, bf16_t>(qp, kp, vp, YG + orow * 768 + oh * 128, seq, 0.088388347648318440f, F.lds);
        if (kind != 0) att::attn_body<64, 768, bf16_t>(qp, kp, vp, OD + (size_t)(kind - 1) * TT * 768 + orow * 768 + oh * 128, seq, 0.125f, F.lds);
    }
}
__device__ __forceinline__ float row16_sum(float v) {
    v += __int_as_float(__builtin_amdgcn_update_dpp(0, __float_as_int(v), 0xB1, 0xF, 0xF, true));
    v += __int_as_float(__builtin_amdgcn_update_dpp(0, __float_as_int(v), 0x4E, 0xF, 0xF, true));
    v += __int_as_float(__builtin_amdgcn_update_dpp(0, __float_as_int(v), 0x141, 0xF, 0xF, true));
    v += __int_as_float(__builtin_amdgcn_update_dpp(0, __float_as_int(v), 0x140, 0xF, 0xF, true));
    return v;
}
__device__ __forceinline__ f32x4 unpack4(u32x2 w) { return (f32x4){bf2f(w.x & 0xffffu), __uint_as_float(w.x & 0xffff0000u), bf2f(w.y & 0xffffu), __uint_as_float(w.y & 0xffff0000u)}; }
__device__ __forceinline__ u32x2 pack4(f32x4 v) { u32x2 w; w.x = cvt_pk_bf16(v.x, v.y); w.y = cvt_pk_bf16(v.z, v.w); return w; }
__device__ __forceinline__ void ph_post(const Frame& F, int layer) {
    const Args& A = *F.a; const int l = F.lane;
    const int nrows = layer == 0 ? TT : TL;
    const bf16_t* R = (const bf16_t*)(F.ws + A_R); const bf16_t* K = (const bf16_t*)(F.ws + A_K); const bf16_t* V = (const bf16_t*)(F.ws + (layer == 0 ? O_VF : A_V));
    const bf16_t* AS0 = (const bf16_t*)(F.ws + A_AS); const bf16_t* AS1 = AS0 + (size_t)TT * RW; const bf16_t* G = (const bf16_t*)(F.ws + A_G);
    const float* YS0 = (const float*)(F.ws + A_YS); const float* YS1 = YS0 + (size_t)TT * RW;
    const bf16_t* OD0 = (const bf16_t*)(F.ws + A_OD); const bf16_t* OD1 = OD0 + (size_t)TT * 768;
    bf16_t* YR = (bf16_t*)(F.ws + A_YR); bf16_t* YD = (bf16_t*)(F.ws + A_YD);
    const float* lnw = A.in[I_LNW] + layer * RW; const float* lnb = A.in[I_LNB] + layer * RW; const float* kaw = A.in[I_KA] + layer * RW; const float* rk = A.in[I_RK] + layer * RW;
    const float lam_init = 0.8f - 0.6f * expf(-0.3f * (float)layer);
    const float s1 = wave_sum(A.in[I_LQ1][layer * 64 + l] * A.in[I_LK1][layer * 64 + l]), s2 = wave_sum(A.in[I_LQ2][layer * 64 + l] * A.in[I_LK2][layer * 64 + l]);
    const float lam = expf(s1) - expf(s2) + lam_init;
    const int sub = l & 15, hg = l >> 4;
    const f32x4 sg0 = *(const f32x4*)(A.in[I_SUBLN] + layer * 128 + sub * 8) * (1.f - lam_init), sg1 = *(const f32x4*)(A.in[I_SUBLN] + layer * 128 + sub * 8 + 4) * (1.f - lam_init);
    for (int m = F.gw; m < nrows; m += F.ngw) {
        const size_t ro = (size_t)m * RW;
        f32x4 ly0[3], ly1[3], lw[3], lb[3], lka[3], lrk[3]; u32x2 la0[3], la1[3], lk[3], lr[3], lv[3], lg[3]; u32x4 ld0[2], ld1[2];
#pragma unroll
        for (int it = 0; it < 3; ++it) { const int c = (it * 4 + hg) * 64 + sub * 4;
            ly0[it] = *(const f32x4*)(YS0 + ro + c); ly1[it] = *(const f32x4*)(YS1 + ro + c);
            la0[it] = *(const u32x2*)(AS0 + ro + c); la1[it] = *(const u32x2*)(AS1 + ro + c); lk[it] = *(const u32x2*)(K + ro + c);
            lr[it] = *(const u32x2*)(R + ro + c); lv[it] = *(const u32x2*)(V + ro + c); lg[it] = *(const u32x2*)(G + ro + c);
            lw[it] = *(const f32x4*)(lnw + c); lb[it] = *(const f32x4*)(lnb + c); lka[it] = *(const f32x4*)(kaw + c); lrk[it] = *(const f32x4*)(rk + c); }
#pragma unroll
        for (int ps = 0; ps < 2; ++ps) { const int head = ps * 4 + hg; const int c = (head < 6 ? head : 0) * 128 + sub * 8;
            ld0[ps] = *(const u32x4*)(OD0 + ro + c); ld1[ps] = *(const u32x4*)(OD1 + ro + c); }
        asm volatile("" ::: "memory");
#pragma unroll
        for (int it = 0; it < 3; ++it) { const int c = (it * 4 + hg) * 64 + sub * 4;
            const f32x4 y = ly0[it] + ly1[it];
            const f32x4 a0 = unpack4(la0[it]), a1 = unpack4(la1[it]), k = unpack4(lk[it]), r = unpack4(lr[it]), v = unpack4(lv[it]), g = unpack4(lg[it]);
            const f32x4 w4 = lw[it], b4 = lb[it], ka4 = lka[it], rk4 = lrk[it];
            const float mean = row16_sum((y.x + y.y) + (y.z + y.w)) * (1.f / 64.f);
            const f32x4 d = y - mean;
            const float var = row16_sum((d.x * d.x + d.y * d.y) + (d.z * d.z + d.w * d.w)) * (1.f / 64.f);
            const f32x4 yn = d * rsqrtf(var + 64e-5f) * w4 + b4;
            const f32x4 kd = k * ((a0 + a1 - 2.f) * ka4 + 2.f);
            const f32x4 pr = r * kd * rk4;
            const float bs = row16_sum((pr.x + pr.y) + (pr.z + pr.w));
            *(u32x2*)(YR + ro + c) = pack4((yn + v * bs) * g); }
#pragma unroll
        for (int ps = 0; ps < 2; ++ps) { const int head = ps * 4 + hg;
            if (head < 6) { const int c = head * 128 + sub * 8;
                float pa_[8], pb_[8]; unpack8(ld0[ps], pa_); unpack8(ld1[ps], pb_);
                const f32x4 o0 = (f32x4){pa_[0], pa_[1], pa_[2], pa_[3]} - (f32x4){pb_[0], pb_[1], pb_[2], pb_[3]} * lam, o1 = (f32x4){pa_[4], pa_[5], pa_[6], pa_[7]} - (f32x4){pb_[4], pb_[5], pb_[6], pb_[7]} * lam;
                const float ss = row16_sum(((o0.x * o0.x + o0.y * o0.y) + (o0.z * o0.z + o0.w * o0.w)) + ((o1.x * o1.x + o1.y * o1.y) + (o1.z * o1.z + o1.w * o1.w)));
                const float rs = rsqrtf(ss * (1.f / 128.f) + 1e-5f);
                const f32x4 r0 = o0 * rs * sg0, r1 = o1 * rs * sg1;
                u32x4 w; w.x = cvt_pk_bf16(r0.x, r0.y); w.y = cvt_pk_bf16(r0.z, r0.w); w.z = cvt_pk_bf16(r1.x, r1.y); w.w = cvt_pk_bf16(r1.z, r1.w);
                *(u32x4*)(YD + ro + c) = w; } }
        asm volatile("" ::: "memory");
    }
}
__device__ __forceinline__ void conv_act(const Frame& F, int layer, int nrows) {
    const Args& A = *F.a;
    const bf16_t* U = (const bf16_t*)(F.ws + A_U); bf16_t* ACT = (bf16_t*)(F.ws + A_ACT);
    const float* cw = A.in[I_CW] + (size_t)layer * 3 * FF2; const float* cbias = A.in[I_CB] + (size_t)layer * FF2;
    constexpr int NCK = FF / 8;
    const int nitems = (nrows / 16) * NCK;
    for (int it = blockIdx.x * NTHREADS + F.tid; it < nitems; it += gridDim.x * NTHREADS) {
        const int rg = it / NCK, ck = it % NCK, r0 = rg * 16, c = ck * 8;
        const bool lat = r0 < TL; const int t0 = lat ? (r0 & 4095) : ((r0 - TL) & 255), len = lat ? SEQ : CTX;
        float wv[3][8], wg[3][8], bv[8], bg[8];
#pragma unroll
        for (int e = 0; e < 8; ++e) { bv[e] = cbias[c + e]; bg[e] = cbias[FF + c + e];
#pragma unroll
            for (int k = 0; k < 3; ++k) { wv[k][e] = cw[(size_t)k * FF2 + c + e]; wg[k][e] = cw[(size_t)k * FF2 + FF + c + e]; } }
        float pv[8], pg[8], cv[8], cg[8], nv[8], ng[8];
        const bf16_t* up = U + (size_t)r0 * FF2 + c;
        if (t0 > 0) { unpack8(*(const u32x4*)(up - FF2), pv); unpack8(*(const u32x4*)(up - FF2 + FF), pg); }
        else {
#pragma unroll
            for (int e = 0; e < 8; ++e) { pv[e] = 0.f; pg[e] = 0.f; } }
        unpack8(*(const u32x4*)(up), cv); unpack8(*(const u32x4*)(up + FF), cg);
#pragma unroll 1
        for (int i = 0; i < 16; ++i) {
            if (t0 + i + 1 < len) { unpack8(*(const u32x4*)(up + (size_t)(i + 1) * FF2), nv); unpack8(*(const u32x4*)(up + (size_t)(i + 1) * FF2 + FF), ng); }
            else {
#pragma unroll
                for (int e = 0; e < 8; ++e) { nv[e] = 0.f; ng[e] = 0.f; } }
            float o[8];
#pragma unroll
            for (int e = 0; e < 8; ++e) { const float a = pv[e] * wv[0][e] + cv[e] * wv[1][e] + nv[e] * wv[2][e] + bv[e]; const float g = pg[e] * wg[0][e] + cg[e] * wg[1][e] + ng[e] * wg[2][e] + bg[e];
                o[e] = a * g * sigmoidf_(g); pv[e] = cv[e]; pg[e] = cg[e]; cv[e] = nv[e]; cg[e] = ng[e]; }
            *(u32x4*)(ACT + (size_t)(r0 + i) * FF + c) = pack8(o);
        }
    }
}

enum { S_INIT = 0, S_NORM1, S_IN, S_PREP, S_LR, S_VRES, S_MIX, S_POST, S_GATE, S_MERGE, S_OUT, S_NORM2, S_UP, S_CONV, S_DOWN, S_NEXT, S_FINAL };
constexpr int NPH = 28;
__host__ __device__ inline int phase_code(int p) {
    if (p < 2) return p;
    if (p < 15) { const int s = p - 2; return (s < 3 ? S_IN + s : S_MIX + (s - 3)); }
    { const int s = p - 15; return 256 | (s < 3 ? S_IN + s : S_MIX + (s - 3)); }
}

#ifndef PROBE_MASK
#define PROBE_MASK 0
#endif
__host__ __device__ inline int stage_of_phase(int b) { int code = phase_code(b); int st = code & 255; if ((code >> 8) == 1 && st == S_NEXT) st = S_FINAL; return st; }
__host__ __device__ inline int expand_phase(int p, int& rep) {
    if (PROBE_MASK == 0) { rep = 0; return p; }
    int q = 0;
    for (int b = 0; b < NPH; ++b) { const int n = ((PROBE_MASK >> stage_of_phase(b)) & 1) ? 2 : 1; if (p < q + n) { rep = p - q; return b; } q += n; }
    rep = 0; return NPH - 1;
}
__global__ void __launch_bounds__(NTHREADS, 2) mega_fwd(Args args) {
    extern __shared__ __attribute__((aligned(16))) unsigned char lds_raw[];
    const Args& A = args;
    volatile LAS unsigned* MISC = (volatile LAS unsigned*)((LAS unsigned char*)lds_raw + MISC_OFF);
    if (threadIdx.x < 32) MISC[threadIdx.x] = 0u;
    __syncthreads();
    if ((threadIdx.x & 63) == 0) MISC[16 + (threadIdx.x >> 6)] = (unsigned)__builtin_amdgcn_s_getreg((1 << 11) | (4 << 6) | 4) & 3u;
    __syncthreads();
    if (threadIdx.x == 0) {
        unsigned seen = 0u, nr = 0u;
        for (int w = 0; w < 8; ++w) { const unsigned sd = MISC[16 + w]; if (!((seen >> sd) & 1u) && nr < 4u) { seen |= 1u << sd; MISC[24 + w] = nr++; } else MISC[24 + w] = 0xFFFFFFFFu; }
        for (int w = 0; w < 8; ++w) if (MISC[24 + w] == 0xFFFFFFFFu && nr < 4u) MISC[24 + w] = nr++;
    }
    __syncthreads();
    XcdBarrier bar; bar.bar = (unsigned*)(args.ws + O_CTL) + 4096; bar.x = 0; bar.st = nullptr;
    if (args.ph_hi - args.ph_lo > 1) bar = xcd_barrier_post((unsigned*)(args.ws + O_CTL) + 4096, MISC + 8);
    for (int p = args.ph_lo; p < args.ph_hi; ++p) {
        int rep = 0; int code = phase_code(expand_phase(p, rep)); const int layer = code >> 8; int st = code & 255;
        if (layer == 1 && st == S_NEXT) st = S_FINAL;
        const bool last = layer == 1;
        const int Mrows = last ? TL : TT;
        const int tid_ = lthread();
        size_t zoff_ = 0; asm volatile("" : "+s"(zoff_)); unsigned char* ws_ = args.ws + zoff_;
        Frame F; F.a = &args; F.ws = ws_; F.lds = (char*)lds_raw; F.tid = tid_; F.lane = F.tid & 63; F.wave = __builtin_amdgcn_readfirstlane(F.tid >> 6);
        F.gw = blockIdx.x * NWAVES + F.wave; F.ngw = gridDim.x * NWAVES;
        float* XC = (float*)(F.ws + O_XC);
        const float* MODB = (const float*)(F.ws + O_MOD);
        const float* mod = MODB + (size_t)layer * 5 * MODW;
        int njobs = 0;
        switch (st) {
        case S_INIT: adaln(F); convert_weights(F, 0); break;
        case S_NORM1: norm_rows(F, A.in[I_X], A.in[I_CTX], A.in[I_NORM1], mod, 0, 2048, TT); break;
        case S_PREP: rwkv_prep(F, layer); qk_prep(F, layer); break;
        case S_MIX: ph_mix(F, layer, rep); break;
        case S_POST: ph_post(F, layer); break;
        case S_NORM2: norm_rows(F, A.out, XC, A.in[I_NORM2] + layer * DM, mod, 3 * 2048, 4 * 2048, Mrows); break;
        case S_CONV: conv_act(F, layer, Mrows); break;
        case S_NEXT: convert_weights(F, 1); norm_rows(F, A.out, XC, A.in[I_NORM1] + DM, MODB + (size_t)5 * MODW, 0, 2048, TT); break;
        case S_FINAL: final_norm(F); break;
        case S_LR: njobs = layer == 1 ? 2 : 1; break;
        case S_MERGE: njobs = 3; break;
        default: njobs = 1; break;
        }
        for (int j = 0; j < njobs; ++j) {
            pg8::Gemm g; Epi e{}; e.ws = F.ws; e.layer = layer;
            switch (st) {
            case S_IN: e.mode = EM_ROUTE; g = pg8::Gemm{(const bf16_t*)(F.ws + O_H), (const bf16_t*)(F.ws + W_IN), TT, 6144, 2048}; break;
            case S_LR:
                if (j == 0) { e.mode = EM_LR; e.p0 = A.in[I_W0] + layer * 2 * RW; e.p1 = A.in[I_A0] + layer * 2 * RW; g = pg8::Gemm{(const bf16_t*)(F.ws + A_LR), (const bf16_t*)(F.ws + W_LR), TT, 3840, 256}; }
                else { e.mode = EM_VRES; e.p0 = A.in[I_V0]; g = pg8::Gemm{(const bf16_t*)(F.ws + A_YS), (const bf16_t*)(F.ws + W_V12), TT, 768, 768}; }
                break;
            case S_GATE: e.mode = EM_SIGMOID; e.O = (bf16_t*)(F.ws + A_GATES); e.ldc = 6144;
                g = pg8::Gemm{(const bf16_t*)(F.ws + O_H), (const bf16_t*)(F.ws + W_IN) + (size_t)6144 * 2048, Mrows, 6144, 2048}; break;
            case S_MERGE: e.mode = EM_MERGE; e.aux = j;
                g = pg8::Gemm{(const bf16_t*)(F.ws + (j == 0 ? A_YR : (j == 1 ? A_YG : A_YD))), (const bf16_t*)(F.ws + W_BR) + (size_t)j * 2048 * 768, Mrows, 2048, 768}; break;
            case S_OUT: e.mode = EM_RESID; e.aux = 2 * 2048; e.gmod = mod;
                e.xin_l = layer == 0 ? A.in[I_X] : A.out; e.xin_c = layer == 0 ? A.in[I_CTX] : XC; e.xout_l = A.out; e.xout_c = XC;
                g = pg8::Gemm{(const bf16_t*)(F.ws + O_H), (const bf16_t*)(F.ws + W_OUT), Mrows, 2048, 2048}; break;
            case S_UP: e.mode = EM_BF16; e.O = (bf16_t*)(F.ws + A_U); e.ldc = FF2;
                g = pg8::Gemm{(const bf16_t*)(F.ws + O_H), (const bf16_t*)(F.ws + W_UP), Mrows, FF2, 2048}; break;
            default: e.mode = EM_RESID; e.aux = 5 * 2048; e.gmod = mod; e.xin_l = A.out; e.xin_c = XC; e.xout_l = A.out; e.xout_c = XC;
                g = pg8::Gemm{(const bf16_t*)(F.ws + A_ACT), (const bf16_t*)(F.ws + W_DOWN), Mrows, 2048, FF}; break;
            }
            pg8::StaticOrder S; S.init(g.M, g.N, (int)gridDim.x, (int)blockIdx.x);
            pg8::gemm_phase<Epi, pg8::StaticOrder, true, true>((LAS unsigned char*)lds_raw, g, S, e);
            __syncthreads();
        }
        if (p + 1 < args.ph_hi) { if (args.ph_hi > 1000) { __threadfence(); cg::this_grid().sync(); }
            xcd_barrier(bar); }
    }
}

extern "C" void kernel_launch(void* const* d_in, const int* in_sizes, int n_in, void* d_out, int out_size, void* d_ws, size_t ws_size, hipStream_t stream) {
    static int grid = 0;
    if (grid == 0) {
        if (n_in != N_IN || out_size != TL * DM || ws_size < WS_NEED) { fprintf(stderr, "kernel_launch: unexpected shapes n_in %d out %d ws %zu (need %zu)\n", n_in, out_size, ws_size, (size_t)WS_NEED); grid = -1; return; }
        int dev = 0, cus = 0, per_cu = 0;
        hipGetDevice(&dev); hipDeviceGetAttribute(&cus, hipDeviceAttributeMultiprocessorCount, dev);
        if (hipFuncSetAttribute((const void*)mega_fwd, hipFuncAttributeMaxDynamicSharedMemorySize, LDS_BYTES) != hipSuccess) { fprintf(stderr, "kernel_launch: hipFuncSetAttribute failed\n"); grid = -1; return; }
        hipOccupancyMaxActiveBlocksPerMultiprocessor(&per_cu, (const void*)mega_fwd, NTHREADS, LDS_BYTES);
        (void)hipGetLastError();
        if (per_cu < 1) { fprintf(stderr, "kernel_launch: occupancy query says %d blocks/CU\n", per_cu); per_cu = 1; }
        grid = cus;
        if (grid > 256) grid = 256;
    }
    if (grid < 0) return;
    hipMemsetAsync((char*)d_ws + O_CTL, 0, CTL_BYTES, stream);
    Args a{};
    for (int i = 0; i < N_IN; ++i) a.in[i] = (const float*)d_in[i];
    a.out = (float*)d_out; a.ws = (unsigned char*)d_ws;
#if MK_ONE_LAUNCH
    { int nph = 0; for (int b = 0; b < NPH; ++b) nph += ((PROBE_MASK >> stage_of_phase(b)) & 1) ? 2 : 1; a.ph_lo = 0; a.ph_hi = nph; }
    void* kargs[] = {&a};
    hipError_t e = hipLaunchCooperativeKernel((const void*)mega_fwd, dim3(grid), dim3(NTHREADS), kargs, LDS_BYTES, stream);
    if (e != hipSuccess) fprintf(stderr, "kernel_launch: cooperative launch failed: %s\n", hipGetErrorString(e));
#else
    for (int p = 0; p < NPH; ++p) { a.ph_lo = p; a.ph_hi = p + 1; hipLaunchKernelGGL(mega_fwd, dim3(grid), dim3(NTHREADS), LDS_BYTES, stream, a); }
#endif
}
```
